# Optimizing an MI355X kernel written in HIP

```python
import math
import jax, jax.numpy as jnp
from jax import lax
import numpy as np

D_MODEL = 1024
BATCH = 8
SEQ = 2048
DEPTH = 1

RMS_EPS = 1e-5
ATTN_HEADS = 16
ATTN_KV_HEADS = 2
HEAD_DIM = 64
WINDOW = 128
Q_DIM = ATTN_HEADS * HEAD_DIM
KV_DIM = ATTN_KV_HEADS * HEAD_DIM
SSM_EXPAND = 2
D_INNER = SSM_EXPAND * D_MODEL
SSM_HEAD_DIM = 64
SSM_HEADS = D_INNER // SSM_HEAD_DIM
SSM_GROUPS = 4
D_STATE = 128
CONV_WIDTH = 4
CHUNK = 128
XBC_DIM = D_INNER + 2 * SSM_GROUPS * D_STATE
IN_COLS = Q_DIM + 2 * KV_DIM + D_INNER + XBC_DIM + SSM_HEADS
IN_SPLITS = (Q_DIM, Q_DIM + KV_DIM, Q_DIM + 2 * KV_DIM, Q_DIM + 2 * KV_DIM + D_INNER, Q_DIM + 2 * KV_DIM + D_INNER + XBC_DIM)
N_BRANCHES = 2
MEM_TOKENS = 256
CROSS_HEADS = 4
CROSS_HEAD_DIM = D_MODEL // CROSS_HEADS
N_EXPERTS = 32
TOP_K = 4
D_EXPERT = D_MODEL
SWIGLU_LIMIT = 7.0
SWIGLU_ALPHA = 1.702

kernel_name = "hybrid_swa_ssd_moe_block"


def rmsnorm(x, w):
    xf = x.astype(jnp.float32)
    y = xf * lax.rsqrt(jnp.mean(xf * xf, axis=-1, keepdims=True) + RMS_EPS)
    return (y * w.astype(jnp.float32)).astype(x.dtype)


def alibi_slopes(n_heads):
    return jnp.exp2(-8.0 * jnp.arange(1, n_heads + 1, dtype=jnp.float32) / n_heads)


def sliding_window_attention(q, k, v, sinks):
    bsz, seq, _ = q.shape
    nb = seq // WINDOW
    grp = ATTN_HEADS // ATTN_KV_HEADS
    qb = q.reshape(bsz, nb, WINDOW, ATTN_KV_HEADS, grp, HEAD_DIM)
    kb = k.reshape(bsz, nb, WINDOW, ATTN_KV_HEADS, HEAD_DIM)
    vb = v.reshape(bsz, nb, WINDOW, ATTN_KV_HEADS, HEAD_DIM)

    def with_prev(t):
        prev = jnp.concatenate([jnp.zeros_like(t[:, :1]), t[:, :-1]], axis=1)
        return jnp.concatenate([prev, t], axis=2)

    kk, vv = with_prev(kb), with_prev(vb)
    scores = jnp.einsum('bnqkgd,bnskd->bnkgqs', qb, kk).astype(jnp.float32) * (HEAD_DIM ** -0.5)
    qi = jnp.arange(WINDOW)[:, None]
    kj = jnp.arange(2 * WINDOW)[None, :]
    dist = qi + WINDOW - kj
    in_window = (dist >= 0) & (dist < WINDOW)
    has_prev = (jnp.arange(nb)[:, None, None] > 0) | (kj >= WINDOW)[None]
    mask = in_window[None] & has_prev
    slopes = alibi_slopes(ATTN_HEADS).reshape(ATTN_KV_HEADS, grp)
    bias = -slopes[:, :, None, None] * dist.astype(jnp.float32)[None, None]
    scores = jnp.where(mask[None, :, None, None], scores + bias, -jnp.inf)
    sink = sinks.astype(jnp.float32).reshape(ATTN_KV_HEADS, grp)[:, :, None, None]
    m = jnp.maximum(jnp.max(scores, axis=-1, keepdims=True), sink)
    p = jnp.exp(scores - m)
    probs = p / (jnp.sum(p, axis=-1, keepdims=True) + jnp.exp(sink - m))
    out = jnp.einsum('bnkgqs,bnskd->bnqkgd', probs.astype(v.dtype), vv)
    return out.reshape(bsz, seq, Q_DIM)


def causal_dwconv(u, w):
    ch = u.shape[-1]
    return lax.conv_general_dilated(u, w[:, None, :].astype(u.dtype), window_strides=(1,),
                                    padding=[(CONV_WIDTH - 1, 0)],
                                    dimension_numbers=('NWC', 'WIO', 'NWC'),
                                    feature_group_count=ch)


def ssd_chunked(xs, dt, a_heads, bm, cm):
    b, seq = xs.shape[0], xs.shape[1]
    nc = seq // CHUNK
    rep = SSM_HEADS // SSM_GROUPS
    x = xs.astype(jnp.float32).reshape(b, nc, CHUNK, SSM_GROUPS, rep, SSM_HEAD_DIM)
    dtc = dt.reshape(b, nc, CHUNK, SSM_GROUPS, rep)
    bc = bm.astype(jnp.float32).reshape(b, nc, CHUNK, SSM_GROUPS, D_STATE)
    cc = cm.astype(jnp.float32).reshape(b, nc, CHUNK, SSM_GROUPS, D_STATE)
    a = jnp.transpose(dtc * a_heads.reshape(SSM_GROUPS, rep), (0, 3, 4, 1, 2))
    a_cum = jnp.cumsum(a, axis=-1)
    xdt = x * dtc[..., None]
    causal = jnp.tril(jnp.ones((CHUNK, CHUNK), dtype=bool))
    seg = a_cum[..., :, None] - a_cum[..., None, :]
    lmat = jnp.exp(jnp.where(causal, seg, -jnp.inf))
    cb = jnp.einsum('bclgn,bcsgn->bgcls', cc, bc)
    y_diag = jnp.einsum('bgcls,bgrcls,bcsgrp->bclgrp', cb, lmat, xdt)
    decay_states = jnp.exp(a_cum[..., -1:] - a_cum)
    states = jnp.einsum('bclgn,bgrcl,bclgrp->cbgrpn', bc, decay_states, xdt)
    chunk_decay = jnp.moveaxis(jnp.exp(a_cum[..., -1]), -1, 0)

    def step(carry, inp):
        st, dec = inp
        return carry * dec[..., None, None] + st, carry

    _, prev = lax.scan(step, jnp.zeros(states.shape[1:], jnp.float32), (states, chunk_decay))
    y_off = jnp.einsum('bclgn,cbgrpn,bgrcl->bclgrp', cc, prev, jnp.exp(a_cum))
    y = (y_diag + y_off).reshape(b, seq, SSM_HEADS, SSM_HEAD_DIM)
    return y.astype(xs.dtype)


def mamba2_mixer(z, xbc, dt_raw, conv_w, conv_b, dt_bias, a_log, d_skip, norm_w):
    bsz, seq, _ = z.shape
    xbc = jax.nn.silu(causal_dwconv(xbc, conv_w) + conv_b)
    xs, bm, cm = jnp.split(xbc, [D_INNER, D_INNER + SSM_GROUPS * D_STATE], axis=-1)
    xs = xs.reshape(bsz, seq, SSM_HEADS, SSM_HEAD_DIM)
    bm = bm.reshape(bsz, seq, SSM_GROUPS, D_STATE)
    cm = cm.reshape(bsz, seq, SSM_GROUPS, D_STATE)
    dt = jax.nn.softplus(dt_raw.astype(jnp.float32) + dt_bias.astype(jnp.float32))
    a_heads = -jnp.exp(a_log.astype(jnp.float32))
    y = ssd_chunked(xs, dt, a_heads, bm, cm) + xs * d_skip[:, None]
    y = y.reshape(bsz, seq, D_INNER) * jax.nn.silu(z)
    yf = y.astype(jnp.float32).reshape(bsz, seq, SSM_GROUPS, D_INNER // SSM_GROUPS)
    yf = yf * lax.rsqrt(jnp.mean(yf * yf, axis=-1, keepdims=True) + RMS_EPS)
    return (yf.reshape(bsz, seq, D_INNER) * norm_w.astype(jnp.float32)).astype(z.dtype)


def cross_attention(hn, mn, w_cq, w_ckv, w_co):
    bsz, seq, _ = hn.shape
    q = (hn @ w_cq).reshape(bsz, seq, CROSS_HEADS, CROSS_HEAD_DIM)
    k, v = jnp.split(mn @ w_ckv, 2, axis=-1)
    k = k.reshape(bsz, -1, CROSS_HEADS, CROSS_HEAD_DIM)
    v = v.reshape(bsz, -1, CROSS_HEADS, CROSS_HEAD_DIM)
    s = jnp.einsum('bthd,bmhd->bhtm', q, k).astype(jnp.float32) * (CROSS_HEAD_DIM ** -0.5)
    p = jax.nn.softmax(s, axis=-1)
    o = jnp.einsum('bhtm,bmhd->bthd', p.astype(v.dtype), v).reshape(bsz, seq, D_MODEL)
    return o @ w_co


def moe_ffn(u, w_router, b_router, w_gu, b_gu, w_dn, b_dn):
    bsz, seq, _ = u.shape
    t = u.reshape(-1, D_MODEL)
    logits = (t @ w_router + b_router).astype(jnp.float32)
    top_v, top_i = lax.top_k(logits, TOP_K)
    top_w = jax.nn.softmax(top_v, axis=-1)
    gate = jnp.sum(jax.nn.one_hot(top_i, N_EXPERTS, dtype=jnp.float32) * top_w[..., None], axis=1)
    gate = gate.astype(t.dtype)
    y = jnp.zeros_like(t)
    for e in range(N_EXPERTS):
        gu = t @ w_gu[e] + b_gu[e]
        g, up = jnp.split(gu, 2, axis=-1)
        g = jnp.minimum(g, SWIGLU_LIMIT)
        up = jnp.clip(up, -SWIGLU_LIMIT, SWIGLU_LIMIT)
        act = (up + 1.0) * (g * jax.nn.sigmoid(SWIGLU_ALPHA * g))
        y = y + gate[:, e:e + 1] * (act @ w_dn[e] + b_dn[e])
    return y.reshape(bsz, seq, D_MODEL)


def setup_inputs(seed: int = 0) -> dict:
    key = jax.random.key(seed)
    ks = iter(jax.random.split(key, 40))
    f32 = jnp.float32
    L = DEPTH

    def dense(shape, fan_in):
        return jax.random.normal(next(ks), shape, f32) * (fan_in ** -0.5)

    def gain(shape):
        return 1.0 + 0.02 * jax.random.normal(next(ks), shape, f32)

    def small(shape, scale=0.01):
        return scale * jax.random.normal(next(ks), shape, f32)

    x = jax.random.normal(next(ks), (BATCH, SEQ, D_MODEL), f32)
    mem = jax.random.normal(next(ks), (BATCH, MEM_TOKENS, D_MODEL), f32)
    dt0 = jnp.exp(jax.random.uniform(next(ks), (L, SSM_HEADS), f32, math.log(1e-3), math.log(1e-1)))
    dt_bias = dt0 + jnp.log(-jnp.expm1(-dt0))
    a_log = jnp.log(jax.random.uniform(next(ks), (L, SSM_HEADS), f32, 1.0, 16.0))
    return {
        "x": x,
        "mem": mem,
        "norm_mix_w": gain((L, D_MODEL)),
        "w_in": dense((L, D_MODEL, IN_COLS), D_MODEL),
        "w_gate": dense((L, D_MODEL, N_BRANCHES * D_MODEL), D_MODEL),
        "b_gate": small((L, N_BRANCHES * D_MODEL), 0.1),
        "attn_sinks": small((L, ATTN_HEADS), 0.5),
        "conv_w": dense((L, CONV_WIDTH, XBC_DIM), CONV_WIDTH),
        "conv_b": small((L, XBC_DIM), 0.02),
        "dt_bias": dt_bias,
        "a_log": a_log,
        "d_skip": gain((L, SSM_HEADS)),
        "ssm_norm_w": gain((L, D_INNER)),
        "w_attn_o": dense((L, Q_DIM, D_MODEL), Q_DIM),
        "w_ssm_o": dense((L, D_INNER, D_MODEL), D_INNER),
        "w_out": dense((L, D_MODEL, D_MODEL), D_MODEL),
        "norm_cross_w": gain((L, D_MODEL)),
        "norm_mem_w": gain((L, D_MODEL)),
        "w_cq": dense((L, D_MODEL, D_MODEL), D_MODEL),
        "w_ckv": dense((L, D_MODEL, 2 * D_MODEL), D_MODEL),
        "w_co": dense((L, D_MODEL, D_MODEL), D_MODEL),
        "norm_ffn_w": gain((L, D_MODEL)),
        "w_router": dense((L, D_MODEL, N_EXPERTS), D_MODEL),
        "b_router": small((L, N_EXPERTS), 0.01),
        "w_gu": dense((L, N_EXPERTS, D_MODEL, 2 * D_EXPERT), D_MODEL),
        "b_gu": small((L, N_EXPERTS, 2 * D_EXPERT), 0.01),
        "w_dn": dense((L, N_EXPERTS, D_EXPERT, D_MODEL), D_EXPERT),
        "b_dn": small((L, N_EXPERTS, D_MODEL), 0.01),
        "final_norm_w": gain((D_MODEL,)),
    }


def reference(x, mem, norm_mix_w, w_in, w_gate, b_gate, attn_sinks, conv_w, conv_b, dt_bias, a_log, d_skip,
              ssm_norm_w, w_attn_o, w_ssm_o, w_out, norm_cross_w, norm_mem_w, w_cq, w_ckv, w_co,
              norm_ffn_w, w_router, b_router, w_gu, b_gu, w_dn, b_dn, final_norm_w):
    bsz, seq, _ = x.shape
    h = x
    for l in range(DEPTH):
        u = rmsnorm(h, norm_mix_w[l])
        q, k, v, z, xbc, dt_raw = jnp.split(u @ w_in[l], IN_SPLITS, axis=-1)
        attn = sliding_window_attention(q, k, v, attn_sinks[l])
        ssm = mamba2_mixer(z, xbc, dt_raw, conv_w[l], conv_b[l], dt_bias[l], a_log[l], d_skip[l], ssm_norm_w[l])
        gates = jax.nn.sigmoid(u @ w_gate[l] + b_gate[l]).reshape(bsz, seq, N_BRANCHES, D_MODEL)
        merged = gates[..., 0, :] * (attn @ w_attn_o[l]) + gates[..., 1, :] * (ssm @ w_ssm_o[l])
        h = h + merged @ w_out[l]
        h = h + cross_attention(rmsnorm(h, norm_cross_w[l]), rmsnorm(mem, norm_mem_w[l]), w_cq[l], w_ckv[l], w_co[l])
        h = h + moe_ffn(rmsnorm(h, norm_ffn_w[l]), w_router[l], b_router[l], w_gu[l], b_gu[l], w_dn[l], b_dn[l])
    return rmsnorm(h, final_norm_w)
```

```cpp
#define HYB 6
#define MK_ONE_LAUNCH 1
#include <hip/hip_runtime.h>
#include <cstdio>
#include <cstdint>
#define GAS __attribute__((address_space(1)))
#define LAS __attribute__((address_space(3)))
typedef unsigned short bf16;
typedef unsigned v4u __attribute__((ext_vector_type(4)));
typedef unsigned v2u __attribute__((ext_vector_type(2)));
typedef float f32x4 __attribute__((ext_vector_type(4)));
typedef float f32x2 __attribute__((ext_vector_type(2)));
typedef short bf16x8 __attribute__((ext_vector_type(8)));
typedef short s16x4 __attribute__((ext_vector_type(4)));
typedef GAS unsigned gu32;
#define RLX_AGENT __ATOMIC_RELAXED, __HIP_MEMORY_SCOPE_AGENT
#define LDS_WAIT() asm volatile("s_waitcnt lgkmcnt(0)" ::: "memory")
#define VM_WAIT() asm volatile("s_waitcnt vmcnt(0)" ::: "memory")
__device__ __forceinline__ unsigned f2bf(float f) { unsigned u = __builtin_bit_cast(unsigned, f); return (u + 0x7fffu + ((u >> 16) & 1u)) >> 16; }
__device__ __forceinline__ unsigned pk2(float lo, float hi) { return f2bf(lo) | (f2bf(hi) << 16); }
__device__ __forceinline__ float bf2f(unsigned short b) { return __uint_as_float((unsigned)b << 16); }
__device__ __forceinline__ float bflo(unsigned w) { return __uint_as_float(w << 16); }
__device__ __forceinline__ float bfhi(unsigned w) { return __uint_as_float(w & 0xffff0000u); }
typedef __bf16 bf16x2_t __attribute__((ext_vector_type(2)));
__device__ __forceinline__ unsigned cvt_pk_bf16(float lo, float hi) { const f32x2 v = {lo, hi}; const bf16x2_t b = __builtin_convertvector(v, bf16x2_t); return __builtin_bit_cast(unsigned, b); }
__device__ __forceinline__ float wave_sum(float v) {
#pragma unroll
    for (int o = 1; o < 64; o <<= 1) v += __shfl_xor(v, o);
    return v;
}
#define XB_TMO      128
#define XB_XCNT(j)  (256  + 64 * (j))
#define XB_XSUB(j)  (1280 + 64 * (j))
#define XB_XGEN(j)  (2304 + 64 * (j))
#define XB_TOP      3328
#define XB_TOPGEN   3392
#define XCD_BAR_WORDS 3456
#define XB_SPIN_CAP (1u << 18)

__device__ __forceinline__ unsigned xb_ld(unsigned* p)              { return __hip_atomic_load(p, __ATOMIC_RELAXED, __HIP_MEMORY_SCOPE_AGENT); }
__device__ __forceinline__ unsigned xb_add(unsigned* p, unsigned v) { return __hip_atomic_fetch_add(p, v, __ATOMIC_RELAXED, __HIP_MEMORY_SCOPE_AGENT); }
__device__ __forceinline__ unsigned xb_xcc_id() { return (unsigned)__builtin_amdgcn_s_getreg((3 << 11) | 20) & 0xFu; }
#define XB_SPIN(cond, bar) do { unsigned _sp = 0; while (cond) { __builtin_amdgcn_s_sleep(1); \
    if ((++_sp & 255u) == 0u) { if (xb_ld(&(bar)[XB_TMO])) break; if (_sp > XB_SPIN_CAP) { atomicAdd(&(bar)[XB_TMO], 1u); break; } } } } while (0)

struct XcdBarrier {
    unsigned* bar; unsigned x;
    volatile LAS unsigned* st;
};

__device__ __forceinline__ XcdBarrier xcd_barrier_post(unsigned* bar, volatile LAS unsigned* st) {
    XcdBarrier b; b.bar = bar; b.x = xb_xcc_id(); b.st = st;
    if (threadIdx.x == 0) (void)xb_add(&bar[XB_XCNT(b.x)], 1u);
    return b;
}
__device__ __forceinline__ void xcd_barrier_complete(unsigned* bar, unsigned x, unsigned& nloc, unsigned& nx) {
    const unsigned G = gridDim.x * gridDim.y * gridDim.z;
    unsigned sum, cnt, mine, sp = 0u;
    for (;;) {
        sum = 0u; cnt = 0u; mine = 0u;
#pragma unroll
        for (unsigned j = 0; j < 16; ++j) { const unsigned c = xb_ld(&bar[XB_XCNT(j)]); sum += c; cnt += (c > 0u) ? 1u : 0u; mine = (j == x) ? c : mine; }
        if (sum == G) break;
        __builtin_amdgcn_s_sleep(1);
        if ((++sp & 255u) == 0u) { if (xb_ld(&bar[XB_TMO])) break; if (sp > XB_SPIN_CAP) { atomicAdd(&bar[XB_TMO], 1u); break; } }
    }
    nloc = mine > 0u ? mine : 1u; nx = cnt > 0u ? cnt : 1u;
}

__device__ __forceinline__ void xcd_barrier(const XcdBarrier& b) {
    asm volatile("s_waitcnt vmcnt(0)" ::: "memory");
    __syncthreads();
    if (threadIdx.x == 0) {
        unsigned* bar = b.bar;
        __builtin_amdgcn_s_waitcnt(0);
        unsigned nloc = b.st[0], nx = b.st[1];
        if (nloc == 0u) { xcd_barrier_complete(bar, b.x, nloc, nx); b.st[0] = nloc; b.st[1] = nx; }
        const unsigned old = xb_add(&bar[XB_XSUB(b.x)], 1u);
        const unsigned gen = old / nloc;
        if (old + 1u == (gen + 1u) * nloc) {
            __builtin_amdgcn_fence(__ATOMIC_RELEASE, "agent");
            asm volatile("s_waitcnt vmcnt(0)" ::: "memory");
            const unsigned og = xb_add(&bar[XB_TOP], 1u);
            const unsigned tg = og / nx;
            if (og + 1u == (tg + 1u) * nx) xb_add(&bar[XB_TOPGEN], 1u);
            else XB_SPIN(xb_ld(&bar[XB_TOPGEN]) == tg, bar);
            __builtin_amdgcn_fence(__ATOMIC_ACQUIRE, "agent");
            xb_add(&bar[XB_XGEN(b.x)], 1u);
            asm volatile("s_waitcnt vmcnt(0)" ::: "memory");
        } else {
            XB_SPIN(xb_ld(&bar[XB_XGEN(b.x)]) == gen, bar);
            __builtin_amdgcn_fence(__ATOMIC_ACQUIRE, "agent");
            asm volatile("s_waitcnt vmcnt(0)" ::: "memory");
        }
    }
    __syncthreads();
}
namespace pg8 {
constexpr int BM = 256, BK = 64, HALF = 128, HTB = HALF * BK * 2  , STAGE_BYTES = 8 * HTB, NXCD = 8, WGM = 8;
__host__ __device__ __forceinline__ int lds_byte(int r, int c) { const int st = (r >> 4) * 2 + (c >> 5), rr = r & 15, cc = c & 31, ob = rr * 64 + cc * 2; return st * 1024 + (ob ^ (((ob >> 9) & 1) << 5)); }
__host__ __device__ __forceinline__ void stage_rc(int b, int& R, int& C) { const int st = b / 1024, sb = b % 1024, swz = sb ^ (((sb >> 9) & 1) << 5); R = (st >> 1) * 16 + swz / 64; C = (st & 1) * 32 + (swz % 64) / 2; }
__host__ __device__ __forceinline__ int perm32(int rho) { const int n = rho >> 4, i = rho & 15; return 8 * (i >> 2) + 4 * n + (i & 3); }

struct Unit { int pm, pn, e, p0; };
typedef int v8i __attribute__((ext_vector_type(8))); typedef int v4i __attribute__((ext_vector_type(4)));
__device__ __forceinline__ v8i cat_frag(bf16x8 a, bf16x8 b) { const v4i x = __builtin_bit_cast(v4i, a), y = __builtin_bit_cast(v4i, b); return (v8i){x[0], x[1], x[2], x[3], y[0], y[1], y[2], y[3]}; }
__device__ __forceinline__ unsigned pk4_fp8(float a, float b, float c, float d) {
    a = __builtin_amdgcn_fmed3f(a, -448.f, 448.f); b = __builtin_amdgcn_fmed3f(b, -448.f, 448.f); c = __builtin_amdgcn_fmed3f(c, -448.f, 448.f); d = __builtin_amdgcn_fmed3f(d, -448.f, 448.f);
    int w = 0; w = __builtin_amdgcn_cvt_pk_fp8_f32(a, b, w, false); w = __builtin_amdgcn_cvt_pk_fp8_f32(c, d, w, true); return (unsigned)w; }
constexpr float W8_SCALE = 32.f;

__device__ __forceinline__ bool static_deal(int i, int G, int c, int nM, int nN, int& pm, int& pn) {
    const int nwg = nM * nN; const long L = (long)i * G + c; if (L >= nwg) return false;
    int wgid = (int)L; { const int q = nwg / NXCD, r = nwg % NXCD, xcd = wgid % NXCD, off = wgid / NXCD; wgid = (xcd < r ? xcd * (q + 1) : r * (q + 1) + (xcd - r) * q) + off; }
    const int nig = WGM * nN, gid = wgid / nig, fm = gid * WGM, gsz = (nM - fm) < WGM ? (nM - fm) : WGM;
    pm = fm + ((wgid % nig) % gsz); pn = (wgid % nig) / gsz; return true;
}
struct SchedLin {
    int nM, nN, G, c, lda; const bf16* Bt; int K; int es = 2;
    __device__ __forceinline__ bool next(int i, Unit& u) const { u.e = 0; u.p0 = 0; return static_deal(i, G, c, nM, nN, u.pm, u.pn); }
    __device__ __forceinline__ void a_fetch(const Unit& u, int (&raw)[2][2]) const {
        int R[2], C[2]; stage_rc((int)threadIdx.x * 16, R[0], C[0]); stage_rc((int)threadIdx.x * 16 + 8192, R[1], C[1]);
#pragma unroll
        for (int h = 0; h < 2; ++h)
#pragma unroll
            for (int i = 0; i < 2; ++i) raw[h][i] = u.pm * BM + h * HALF + R[i];
    }
    __device__ __forceinline__ void a_finish(const Unit& u, const int (&raw)[2][2], unsigned (&o)[2][2]) const {
        int R[2], C[2]; stage_rc((int)threadIdx.x * 16, R[0], C[0]); stage_rc((int)threadIdx.x * 16 + 8192, R[1], C[1]);
#pragma unroll
        for (int h = 0; h < 2; ++h)
#pragma unroll
            for (int i = 0; i < 2; ++i) o[h][i] = (unsigned)(raw[h][i] * lda * es + C[i] * 2);
    }
    __device__ __forceinline__ int b_off(const Unit& u) const { return u.pn * BM * K * es; }
    __device__ __forceinline__ const void* bt() const { return Bt; }
};
struct SchedMoe {
    int nM, nN, G, c, lda; const void* Bt; int K; size_t bstride; bool gather; int es;
    const LAS int* tile_e; const LAS int* tile_p0; const LAS int* cnt_s; const int* rowmap;
    __device__ __forceinline__ bool next(int i, Unit& u) const { if (!static_deal(i, G, c, nM, nN, u.pm, u.pn)) return false; u.e = tile_e[u.pm]; u.p0 = tile_p0[u.pm]; return true; }
    __device__ __forceinline__ void a_fetch(const Unit& u, int (&raw)[2][2]) const {
        int R[2], C[2]; stage_rc((int)threadIdx.x * 16, R[0], C[0]); stage_rc((int)threadIdx.x * 16 + 8192, R[1], C[1]);
        const int ce = cnt_s[u.e];
#pragma unroll
        for (int h = 0; h < 2; ++h)
#pragma unroll
            for (int i = 0; i < 2; ++i) {
                if (gather) { const int pos = u.p0 + h * HALF + R[i]; raw[h][i] = pos < ce ? rowmap[2 * (u.e * 16384 + pos)] : 0; }
                else raw[h][i] = u.pm * BM + h * HALF + R[i]; }
    }
    __device__ __forceinline__ void a_finish(const Unit& u, const int (&raw)[2][2], unsigned (&o)[2][2]) const {
        int R[2], C[2]; stage_rc((int)threadIdx.x * 16, R[0], C[0]); stage_rc((int)threadIdx.x * 16 + 8192, R[1], C[1]);
#pragma unroll
        for (int h = 0; h < 2; ++h)
#pragma unroll
            for (int i = 0; i < 2; ++i) o[h][i] = (unsigned)(raw[h][i] * lda * es + C[i] * 2);
    }
    __device__ __forceinline__ int b_off(const Unit& u) const { return u.e * (int)bstride + u.pn * BM * K * es; }
    __device__ __forceinline__ const void* bt() const { return Bt; }
};

template <class Epi, class Sched, bool ALIGN_EPI, int ES = 2, bool I8 = false>
__device__ __forceinline__ void gemm_phase(LAS unsigned char* lds, const char* Abase, const int K, const Sched& S, const Epi& E) {
    const int tid = threadIdx.x, wid = __builtin_amdgcn_readfirstlane(tid >> 6), lane = tid & 63, wr = wid >> 2, wc = wid & 3, fr = lane & 15, fq = lane >> 4;
    const int nt = K * ES / (BK * 2);
    unsigned voffB[2];
#pragma unroll
    for (int i = 0; i < 2; ++i) { int R, C; stage_rc(tid * 16 + i * 8192, R, C); const int Rb = Epi::PERM ? ((R & ~31) + perm32(R & 31)) : R; voffB[i] = (unsigned)(Rb * K * ES + C * 2); }
    const int kstep = BK * 2;
    const int hstep = HALF * K * ES;
    const unsigned ldsw = (unsigned)wid * 1024u;
    const int aoff = lds_byte(wr * 64 + fr, fq * 8), boff = lds_byte(wc * 32 + fr, fq * 8);
    const __amdgpu_buffer_rsrc_t rsA = __builtin_amdgcn_make_buffer_rsrc((void*)Abase, (short)0, 0x7ffff000, 0x00020000);
    const __amdgpu_buffer_rsrc_t rsB = __builtin_amdgcn_make_buffer_rsrc((void*)S.bt(), (short)0, 0x7ffff000, 0x00020000);
#define PG8_SA(b, h) (((b) * 2 + (h)) * HTB)
#define PG8_SB(b, h) ((4 + (b) * 2 + (h)) * HTB)
#define PG8_STAGE_A(bufoff, soff, voff) do { _Pragma("unroll") for (int _i = 0; _i < 2; ++_i) \
        __builtin_amdgcn_raw_ptr_buffer_load_lds(rsA, (LAS unsigned*)(lds + (bufoff) + ldsw + _i * 8192), 16, (int)(voff)[_i], (soff), 0, 0); } while (0)
#define PG8_STAGE_B(bufoff, soff) do { _Pragma("unroll") for (int _i = 0; _i < 2; ++_i) \
        __builtin_amdgcn_raw_ptr_buffer_load_lds(rsB, (LAS unsigned*)(lds + (bufoff) + ldsw + _i * 8192), 16, (int)voffB[_i], (soff), 0, 0); } while (0)
#define PG8_LDA(dst, b, h) do { _Pragma("unroll") for (int m = 0; m < 4; ++m) _Pragma("unroll") for (int k = 0; k < 2; ++k) dst[m][k] = *(const LAS bf16x8*)(lds + PG8_SA(b, h) + aoff + m * 2048 + k * 1024); } while (0)
#define PG8_LDB(dst, b, h) do { _Pragma("unroll") for (int n = 0; n < 2; ++n) _Pragma("unroll") for (int k = 0; k < 2; ++k) dst[n][k] = *(const LAS bf16x8*)(lds + PG8_SB(b, h) + boff + n * 2048 + k * 1024); } while (0)
#define PG8_MMA(ai, bj, At, Bt) do { __builtin_amdgcn_s_setprio(1); _Pragma("unroll") for (int m = 0; m < 4; ++m) _Pragma("unroll") for (int n = 0; n < 2; ++n) { \
        if constexpr (I8) { _Pragma("unroll") for (int k = 0; k < 2; ++k) acc[ai][bj][m][n] = __builtin_bit_cast(f32x4, __builtin_amdgcn_mfma_i32_16x16x64_i8(__builtin_bit_cast(v4i, Bt[n][k]), __builtin_bit_cast(v4i, At[m][k]), __builtin_bit_cast(v4i, acc[ai][bj][m][n]), 0, 0, 0)); } \
        else if constexpr (ES == 2) { _Pragma("unroll") for (int k = 0; k < 2; ++k) acc[ai][bj][m][n] = __builtin_amdgcn_mfma_f32_16x16x32_bf16(Bt[n][k], At[m][k], acc[ai][bj][m][n], 0, 0, 0); } \
        else acc[ai][bj][m][n] = __builtin_amdgcn_mfma_scale_f32_16x16x128_f8f6f4(cat_frag(Bt[n][0], Bt[n][1]), cat_frag(At[m][0], At[m][1]), acc[ai][bj][m][n], 0, 0, 0, 0x7f7f7f7f, 0, 0x7f7f7f7f); } \
        __builtin_amdgcn_s_setprio(0); } while (0)
#define PG8_WAIT_V(n) asm volatile("s_waitcnt vmcnt(" #n ")" ::: "memory")
#define PG8_WAIT_L(n) asm volatile("s_waitcnt lgkmcnt(" #n ")" ::: "memory")
#define PG8_BAR __builtin_amdgcn_s_barrier()
#define PG8_SCHED __builtin_amdgcn_sched_barrier(0)
    Unit cur, nxt; int ui = 0;
    if (!S.next(0, cur)) return;
    f32x4 acc[2][2][4][2];
#pragma unroll
    for (int a = 0; a < 2; ++a)
#pragma unroll
        for (int b = 0; b < 2; ++b)
#pragma unroll
            for (int m = 0; m < 4; ++m)
#pragma unroll
                for (int n = 0; n < 2; ++n) acc[a][b][m][n] = (f32x4){0.f, 0.f, 0.f, 0.f};
    bf16x8 At[4][2], B0[2][2], B1[2][2];
    unsigned cao[2][2], nao[2][2];
    { int raw[2][2]; S.a_fetch(cur, raw); S.a_finish(cur, raw, cao); }
    int cB = S.b_off(cur);
    bool has_next = S.next(1, nxt); int nB = cB;
    if (has_next) { int raw[2][2]; S.a_fetch(nxt, raw); S.a_finish(nxt, raw, nao); nB = S.b_off(nxt); }
    else {
#pragma unroll
        for (int h = 0; h < 2; ++h)
#pragma unroll
            for (int i = 0; i < 2; ++i) nao[h][i] = cao[h][i]; }
    if constexpr (Epi::NSEG > 1) E.unit_begin(cur, tid);
    PG8_STAGE_B(PG8_SB(0, 0), cB); PG8_STAGE_B(PG8_SB(0, 1), cB + hstep); PG8_STAGE_A(PG8_SA(0, 0), 0, cao[0]); PG8_STAGE_A(PG8_SA(0, 1), 0, cao[1]);
    if (wr == 1) PG8_BAR;
    PG8_WAIT_V(2); PG8_BAR;
    PG8_STAGE_B(PG8_SB(1, 0), cB + kstep); PG8_STAGE_A(PG8_SA(1, 0), kstep, cao[0]); PG8_STAGE_B(PG8_SB(1, 1), cB + hstep + kstep);
    PG8_WAIT_V(6); PG8_BAR;
    for (;;) {
        int t = 0;
#pragma unroll 1
        for (int seg = 0; seg < Epi::NSEG; ++seg) {
        const int t_end = (Epi::NSEG == 1) ? nt : Epi::MID_T + Epi::SEG_STEP * seg;
#pragma unroll 1
        for (; t < t_end; t += 2) {
            const bool last = (t == nt - 2);
            const int a1 = (t + 1) * kstep;
            const int a2 = last ? 0 : (t + 2) * kstep; const int b2 = last ? nB : cB + (t + 2) * kstep;
            const int a3 = a2 + kstep; const int b3 = b2 + kstep;
            PG8_LDB(B0, 0, 0); PG8_LDB(B1, 0, 1); PG8_SCHED; PG8_LDA(At, 0, 0); PG8_STAGE_A(PG8_SA(1, 1), a1, cao[1]);
            if (last) {
#pragma unroll
                for (int h = 0; h < 2; ++h)
#pragma unroll
                    for (int i = 0; i < 2; ++i) cao[h][i] = nao[h][i]; }
            PG8_WAIT_V(8); PG8_WAIT_L(0); PG8_BAR; PG8_MMA(0, 0, At, B0); PG8_MMA(0, 1, At, B1); PG8_BAR; PG8_SCHED;
            PG8_LDA(At, 0, 1); PG8_STAGE_B(PG8_SB(0, 0), b2); PG8_STAGE_B(PG8_SB(0, 1), b2 + hstep); PG8_STAGE_A(PG8_SA(0, 0), a2, cao[0]);
            PG8_WAIT_V(8); PG8_WAIT_L(0); PG8_BAR; PG8_MMA(1, 0, At, B0); PG8_MMA(1, 1, At, B1); PG8_BAR; PG8_SCHED;
            PG8_LDB(B0, 1, 0); PG8_LDB(B1, 1, 1); PG8_SCHED; PG8_LDA(At, 1, 0); PG8_STAGE_A(PG8_SA(0, 1), a2, cao[1]);
            PG8_WAIT_V(8); PG8_WAIT_L(0); PG8_BAR; PG8_MMA(0, 0, At, B0); PG8_MMA(0, 1, At, B1); PG8_BAR; PG8_SCHED;
            PG8_LDA(At, 1, 1); PG8_STAGE_B(PG8_SB(1, 0), b3); PG8_STAGE_B(PG8_SB(1, 1), b3 + hstep); PG8_STAGE_A(PG8_SA(1, 0), a3, cao[0]);
            PG8_WAIT_V(8); PG8_WAIT_L(0); PG8_BAR; PG8_MMA(1, 0, At, B0); PG8_MMA(1, 1, At, B1); PG8_BAR; PG8_SCHED;
        }
        if constexpr (Epi::NSEG > 1) { E.mid(acc, cur, seg, wr, wc, fr, fq); }
        }
        if constexpr (ALIGN_EPI) { if (wr == 0) PG8_BAR; }
        Unit nn; const bool hnn = has_next && S.next(ui + 2, nn); int nraw[2][2];
        if (hnn) S.a_fetch(nn, nraw);
        E(acc, cur, wr, wc, fr, fq);
#ifdef MK_EPI2
        if constexpr (Epi::NSEG == 1 && Epi::PERM) { asm volatile("" ::: "memory"); E(acc, cur, wr, wc, fr, fq); }
#endif
        if (!has_next) break;
#pragma unroll
        for (int a = 0; a < 2; ++a)
#pragma unroll
            for (int b = 0; b < 2; ++b)
#pragma unroll
                for (int m = 0; m < 4; ++m)
#pragma unroll
                    for (int n = 0; n < 2; ++n) acc[a][b][m][n] = (f32x4){0.f, 0.f, 0.f, 0.f};
        cur = nxt; cB = nB; ++ui;
        has_next = hnn;
        if (hnn) { S.a_finish(nn, nraw, nao); nB = S.b_off(nn); nxt = nn; }
        else {
#pragma unroll
            for (int h = 0; h < 2; ++h)
#pragma unroll
                for (int i = 0; i < 2; ++i) nao[h][i] = cao[h][i]; }
        if constexpr (Epi::NSEG > 1) { PG8_BAR; E.unit_begin(cur, tid); }
        if constexpr (ALIGN_EPI) { if (wr == 1) PG8_BAR; }
    }
    PG8_WAIT_V(0);
    if constexpr (!ALIGN_EPI) { if (wr == 0) PG8_BAR; }
    PG8_BAR;
#undef PG8_SA
#undef PG8_SB
#undef PG8_STAGE_A
#undef PG8_STAGE_B
#undef PG8_LDA
#undef PG8_LDB
#undef PG8_MMA
#undef PG8_WAIT_V
#undef PG8_WAIT_L
#undef PG8_BAR
#undef PG8_SCHED
}

__device__ __forceinline__ float fsigmoid(float v) { return __builtin_amdgcn_rcpf(1.f + __builtin_amdgcn_exp2f(-1.4426950408889634f * v)); }
__device__ __forceinline__ float row_rstd(const float* ssq, int row) {
    const f32x4* p = (const f32x4*)(ssq + (size_t)row * 16); const f32x4 a = p[0], b = p[1], c = p[2], d = p[3];
    const float s = ((a.x + a.y) + (a.z + a.w)) + ((b.x + b.y) + (b.z + b.w)) + ((c.x + c.y) + (c.z + c.w)) + ((d.x + d.y) + (d.z + d.w));
    return 1.0f / sqrtf(s * (1.0f / 1024.0f) + 1e-5f);
}
template <bool I8> struct EpiP1 {
    static constexpr bool PERM = true; static constexpr int MID_T = 0, NSEG = 1, SEG_STEP = 0;
    bf16* O; int ldc; float* DT; const float* b_gate; const float* usc; const float* csc;
    __device__ __forceinline__ static f32x4 val(const f32x4& a, const f32x4& cs, float rs) {
        if constexpr (I8) { const v4i i = __builtin_bit_cast(v4i, a); return (f32x4){(float)i[0], (float)i[1], (float)i[2], (float)i[3]} * cs * rs; } else return a; }
    __device__ __forceinline__ void operator()(const f32x4 (&acc)[2][2][4][2], const Unit& u, int wr, int wc, int fr, int fq) const {
        int row0 = u.pm * BM + wr * 64 + fr; asm volatile("" : "+v"(row0));
        const int col0 = u.pn * BM + wc * 32 + 8 * fq;
        f32x4 cs[2][2]; float rsv[8];
#pragma unroll
        for (int bj = 0; bj < 2; ++bj)
#pragma unroll
            for (int n = 0; n < 2; ++n) cs[bj][n] = I8 ? *(const f32x4*)(csc + col0 + bj * HALF + 4 * n) : (f32x4){1.f, 1.f, 1.f, 1.f};
#pragma unroll
        for (int i = 0; i < 8; ++i) rsv[i] = I8 ? usc[row0 + (i >> 2) * HALF + (i & 3) * 16] : 1.f;
        if (u.pn == 33) {
            if (wc == 0) {
#pragma unroll
                for (int ai = 0; ai < 2; ++ai)
#pragma unroll
                    for (int m = 0; m < 4; ++m)
#pragma unroll
                        for (int n = 0; n < 2; ++n) *(f32x4*)(DT + (size_t)(row0 + ai * HALF + m * 16) * 32 + 8 * fq + 4 * n) = val(acc[ai][0][m][n], cs[0][n], rsv[ai * 4 + m]); }
            return; }
        const bool act = u.pn >= 25, zt = u.pn >= 5 && u.pn < 13;
        f32x4 bv[2][2];
#pragma unroll
        for (int bj = 0; bj < 2; ++bj)
#pragma unroll
            for (int n = 0; n < 2; ++n) bv[bj][n] = act ? *(const f32x4*)(b_gate + (col0 - 6400) + bj * HALF + 4 * n) : (f32x4){0.f, 0.f, 0.f, 0.f};
#pragma unroll
        for (int ai = 0; ai < 2; ++ai)
#pragma unroll
            for (int m = 0; m < 4; ++m) { bf16* rowp = O + (size_t)(row0 + ai * HALF + m * 16) * ldc + col0; const float rs = rsv[ai * 4 + m];
#pragma unroll
                for (int bj = 0; bj < 2; ++bj) { f32x4 v0 = val(acc[ai][bj][m][0], cs[bj][0], rs) + bv[bj][0], v1 = val(acc[ai][bj][m][1], cs[bj][1], rs) + bv[bj][1];
                    if (act) {
#pragma unroll
                        for (int k = 0; k < 4; ++k) { v0[k] = fsigmoid(v0[k]); v1[k] = fsigmoid(v1[k]); } }
                    if (zt) {
#pragma unroll
                        for (int k = 0; k < 4; ++k) { v0[k] = v0[k] * fsigmoid(v0[k]); v1[k] = v1[k] * fsigmoid(v1[k]); } }
                    v4u w; w.x = cvt_pk_bf16(v0[0], v0[1]); w.y = cvt_pk_bf16(v0[2], v0[3]); w.z = cvt_pk_bf16(v1[0], v1[1]); w.w = cvt_pk_bf16(v1[2], v1[3]);
                    *(v4u*)(rowp + bj * HALF) = w; } }
    }
};
struct EpiBf16S {
    static constexpr bool PERM = true; static constexpr int MID_T = 0, NSEG = 1, SEG_STEP = 0;
    bf16* O; int ldc; const float* ssq; float sc;
    __device__ __forceinline__ void operator()(const f32x4 (&acc)[2][2][4][2], const Unit& u, int wr, int wc, int fr, int fq) const {
        int row0 = u.pm * BM + wr * 64 + fr; asm volatile("" : "+v"(row0)); const int col0 = u.pn * BM + wc * 32 + 8 * fq;
#pragma unroll
        for (int ai = 0; ai < 2; ++ai)
#pragma unroll
            for (int m = 0; m < 4; ++m) { const int row = row0 + ai * HALF + m * 16; const float rs = (ssq ? row_rstd(ssq, row) : 1.f) * sc; bf16* rowp = O + (size_t)row * ldc + col0;
#pragma unroll
                for (int bj = 0; bj < 2; ++bj) { const f32x4 v0 = acc[ai][bj][m][0] * rs, v1 = acc[ai][bj][m][1] * rs;
                    v4u w; w.x = cvt_pk_bf16(v0[0], v0[1]); w.y = cvt_pk_bf16(v0[2], v0[3]); w.z = cvt_pk_bf16(v1[0], v1[1]); w.w = cvt_pk_bf16(v1[2], v1[3]);
                    *(v4u*)(rowp + bj * HALF) = w; } }
    }
};
struct EpiI8 {
    static constexpr bool PERM = true; static constexpr int MID_T = 0, NSEG = 1, SEG_STEP = 0;
    bf16* O; int ldc; const float* usc; const float* csc;
    __device__ __forceinline__ void operator()(const f32x4 (&acc)[2][2][4][2], const Unit& u, int wr, int wc, int fr, int fq) const {
        int row0 = u.pm * BM + wr * 64 + fr; asm volatile("" : "+v"(row0)); const int col0 = u.pn * BM + wc * 32 + 8 * fq;
        f32x4 cs[2][2];
#pragma unroll
        for (int bj = 0; bj < 2; ++bj)
#pragma unroll
            for (int n = 0; n < 2; ++n) cs[bj][n] = *(const f32x4*)(csc + col0 + bj * HALF + 4 * n);
#pragma unroll
        for (int ai = 0; ai < 2; ++ai)
#pragma unroll
            for (int m = 0; m < 4; ++m) { const int row = row0 + ai * HALF + m * 16; const float rs = usc[row]; bf16* rowp = O + (size_t)row * ldc + col0;
#pragma unroll
                for (int bj = 0; bj < 2; ++bj) { const v4i i0 = __builtin_bit_cast(v4i, acc[ai][bj][m][0]), i1 = __builtin_bit_cast(v4i, acc[ai][bj][m][1]);
                    const f32x4 v0 = (f32x4){(float)i0[0], (float)i0[1], (float)i0[2], (float)i0[3]} * cs[bj][0] * rs, v1 = (f32x4){(float)i1[0], (float)i1[1], (float)i1[2], (float)i1[3]} * cs[bj][1] * rs;
                    v4u w; w.x = cvt_pk_bf16(v0[0], v0[1]); w.y = cvt_pk_bf16(v0[2], v0[3]); w.z = cvt_pk_bf16(v1[0], v1[1]); w.w = cvt_pk_bf16(v1[2], v1[3]);
                    *(v4u*)(rowp + bj * HALF) = w; } }
    }
};
template <int ES, bool O8> struct EpiG2 {
    static constexpr bool PERM = true; static constexpr int MID_T = 16 * ES / 2, NSEG = 5, SEG_STEP = 8 * ES / 2;
    const bf16* gates; int ldg; void* O; int ldc; const float* ssqg; float sc; LAS float* ftab;
    __device__ __forceinline__ void unit_begin(const Unit& u, int tid) const {
        if (tid < 256) { const f32x4 sq = *(const f32x4*)(ssqg + (size_t)(u.pm * BM + tid) * 4);
            const float q0 = sq[0] * (1.f / 512.f) + 1e-5f, q1 = sq[1] * (1.f / 512.f) + 1e-5f, q2 = sq[2] * (1.f / 512.f) + 1e-5f, q3 = sq[3] * (1.f / 512.f) + 1e-5f;
            ftab[tid] = sqrtf(q0); ftab[256 + tid] = sqrtf(q1 / q0); ftab[512 + tid] = sqrtf(q2 / q1); ftab[768 + tid] = sqrtf(q3 / q2); ftab[1024 + tid] = sc / sqrtf(q3); }
    }
    __device__ __forceinline__ void mid(f32x4 (&acc)[2][2][4][2], const Unit& u, int seg, int wr, int wc, int fr, int fq) const {
        int row0 = u.pm * BM + wr * 64 + fr; asm volatile("" : "+v"(row0)); const int col0 = u.pn * BM + wc * 32 + 8 * fq;
        float rf[8];
#pragma unroll
        for (int i = 0; i < 8; ++i) rf[i] = ftab[seg * 256 + wr * 64 + fr + (i >> 2) * HALF + (i & 3) * 16];
        const bool gh = seg == 0 || seg == 4;
        v4u ga[4][2][2], gb[4][2][2];
#define G2_LOAD(pr) do { _Pragma("unroll") for (int mm = 0; mm < 2; ++mm) _Pragma("unroll") for (int bj = 0; bj < 2; ++bj) { \
            const bf16* gp = gates + (size_t)(row0 + ((pr) >> 1) * HALF + (2 * ((pr) & 1) + mm) * 16) * ldg + col0 + bj * HALF; gb[pr][mm][bj] = *(const v4u*)(gp + 1024); ga[pr][mm][bj] = gb[pr][mm][bj]; if (seg == 0) ga[pr][mm][bj] = *(const v4u*)gp; } } while (0)
#pragma unroll
        for (int pr = 0; pr < 4; ++pr) { const int ai = pr >> 1, m0 = 2 * (pr & 1);
            f32x4 fa[2][2], fb[2][2];
#pragma unroll
            for (int mm = 0; mm < 2; ++mm)
#pragma unroll
                for (int bj = 0; bj < 2; ++bj) { const float f = rf[ai * 4 + m0 + mm]; fa[mm][bj] = (f32x4){f, f, f, f}; fb[mm][bj] = fa[mm][bj]; }
            if (gh) { G2_LOAD(pr);
#pragma unroll
                for (int mm = 0; mm < 2; ++mm)
#pragma unroll
                    for (int bj = 0; bj < 2; ++bj) { const v4u a = ga[pr][mm][bj], b = gb[pr][mm][bj];
                        f32x4 x0, x1; x0[0] = bflo(b.x); x0[1] = bfhi(b.x); x0[2] = bflo(b.y); x0[3] = bfhi(b.y); x1[0] = bflo(b.z); x1[1] = bfhi(b.z); x1[2] = bflo(b.w); x1[3] = bfhi(b.w);
                        if (seg == 0) { f32x4 y0, y1; y0[0] = bflo(a.x); y0[1] = bfhi(a.x); y0[2] = bflo(a.y); y0[3] = bfhi(a.y); y1[0] = bflo(a.z); y1[1] = bfhi(a.z); y1[2] = bflo(a.w); y1[3] = bfhi(a.w);
#pragma unroll
                            for (int k = 0; k < 4; ++k) { x0[k] = y0[k] * __builtin_amdgcn_rcpf(x0[k]); x1[k] = y1[k] * __builtin_amdgcn_rcpf(x1[k]); } }
                        fa[mm][bj] *= x0; fb[mm][bj] *= x1; }
            }
#pragma unroll
            for (int mm = 0; mm < 2; ++mm)
#pragma unroll
                for (int bj = 0; bj < 2; ++bj) { acc[ai][bj][m0 + mm][0] *= fa[mm][bj]; acc[ai][bj][m0 + mm][1] *= fb[mm][bj]; }
            asm volatile("" : "+v"(acc[ai][0][m0][0]), "+v"(acc[ai][0][m0][1]), "+v"(acc[ai][1][m0][0]), "+v"(acc[ai][1][m0][1]), "+v"(acc[ai][0][m0 + 1][0]), "+v"(acc[ai][0][m0 + 1][1]), "+v"(acc[ai][1][m0 + 1][0]), "+v"(acc[ai][1][m0 + 1][1]) :: "memory");
        }
#undef G2_LOAD
    }
    __device__ __forceinline__ void operator()(const f32x4 (&acc)[2][2][4][2], const Unit& u, int wr, int wc, int fr, int fq) const {
        int row0 = u.pm * BM + wr * 64 + fr; asm volatile("" : "+v"(row0)); const int col0 = u.pn * BM + wc * 32 + 8 * fq;
#pragma unroll
        for (int ai = 0; ai < 2; ++ai)
#pragma unroll
            for (int m = 0; m < 4; ++m) { const size_t ro = (size_t)(row0 + ai * HALF + m * 16) * ldc + col0;
#pragma unroll
                for (int bj = 0; bj < 2; ++bj) { const f32x4 v0 = acc[ai][bj][m][0], v1 = acc[ai][bj][m][1];
                    if constexpr (O8) *(v2u*)((unsigned char*)O + ro + bj * HALF) = (v2u){pk4_fp8(v0[0], v0[1], v0[2], v0[3]), pk4_fp8(v1[0], v1[1], v1[2], v1[3])};
                    else { v4u w; w.x = cvt_pk_bf16(v0[0], v0[1]); w.y = cvt_pk_bf16(v0[2], v0[3]); w.z = cvt_pk_bf16(v1[0], v1[1]); w.w = cvt_pk_bf16(v1[2], v1[3]);
                        *(v4u*)((bf16*)O + ro + bj * HALF) = w; } } }
    }
};
template <bool BASE16> struct EpiRes {
    static constexpr bool PERM = true; static constexpr int MID_T = 0, NSEG = 1, SEG_STEP = 0;
    const void* base; bf16* H; bf16* HB; const float* nw; float* ssq; unsigned char* T8; float sc;
    __device__ __forceinline__ void operator()(const f32x4 (&acc)[2][2][4][2], const Unit& u, int wr, int wc, int fr, int fq) const {
        int row0 = u.pm * BM + wr * 64 + fr; asm volatile("" : "+v"(row0)); const int col0 = u.pn * BM + wc * 32 + 8 * fq;
        f32x4 wv[2][2];
#pragma unroll
        for (int bj = 0; bj < 2; ++bj)
#pragma unroll
            for (int n = 0; n < 2; ++n) wv[bj][n] = *(const f32x4*)(nw + col0 + bj * HALF + 4 * n);
#pragma unroll
        for (int ai = 0; ai < 2; ++ai)
#pragma unroll
            for (int m = 0; m < 4; ++m) { const int row = row0 + ai * HALF + m * 16; const size_t off = (size_t)row * 1024 + col0; float s = 0.f;
#pragma unroll
                for (int bj = 0; bj < 2; ++bj) { f32x4 h0, h1;
                    if constexpr (BASE16) { const v4u b = *(const v4u*)((const bf16*)base + off + bj * HALF);
                        h0 = (f32x4){bflo(b.x), bfhi(b.x), bflo(b.y), bfhi(b.y)}; h1 = (f32x4){bflo(b.z), bfhi(b.z), bflo(b.w), bfhi(b.w)}; }
                    else { h0 = *(const f32x4*)((const float*)base + off + bj * HALF); h1 = *(const f32x4*)((const float*)base + off + bj * HALF + 4); }
                    h0 += acc[ai][bj][m][0] * sc; h1 += acc[ai][bj][m][1] * sc;
                    s += ((h0[0] * h0[0] + h0[1] * h0[1]) + (h0[2] * h0[2] + h0[3] * h0[3])) + ((h1[0] * h1[0] + h1[1] * h1[1]) + (h1[2] * h1[2] + h1[3] * h1[3]));
                    *(v4u*)(H + off + bj * HALF) = (v4u){cvt_pk_bf16(h0[0], h0[1]), cvt_pk_bf16(h0[2], h0[3]), cvt_pk_bf16(h1[0], h1[1]), cvt_pk_bf16(h1[2], h1[3])};
                    const f32x4 w0 = h0 * wv[bj][0], w1 = h1 * wv[bj][1];
                    if (HB) *(v4u*)(HB + off + bj * HALF) = (v4u){cvt_pk_bf16(w0[0], w0[1]), cvt_pk_bf16(w0[2], w0[3]), cvt_pk_bf16(w1[0], w1[1]), cvt_pk_bf16(w1[2], w1[3])};
                    if (T8) *(v2u*)(T8 + off + bj * HALF) = (v2u){pk4_fp8(w0[0], w0[1], w0[2], w0[3]), pk4_fp8(w1[0], w1[1], w1[2], w1[3])}; }
                s += __shfl_xor(s, 16); s += __shfl_xor(s, 32);
                if (fq == 0) ssq[(size_t)row * 16 + u.pn * 4 + wc] = s;
                if (m == 3) asm volatile("" ::: "memory"); }
    }
};
struct EpiGU {
    static constexpr bool PERM = true; static constexpr int MID_T = 0, NSEG = 1, SEG_STEP = 0;
    unsigned char* ACT8; const float* b_gu; const int* rowmap; const LAS int* cnt_s;
    __device__ __forceinline__ void operator()(const f32x4 (&acc)[2][2][4][2], const Unit& u, int wr, int wc, int fr, int fq) const {
        int r0 = wr * 64 + fr; asm volatile("" : "+v"(r0)); const int cc = wc * 32 + 8 * fq; const int ce = cnt_s[u.e];
        const float* bg = b_gu + (size_t)u.e * 2048 + u.pn * 128 + cc;
        f32x4 bgv[2], buv[2];
#pragma unroll
        for (int n = 0; n < 2; ++n) { bgv[n] = *(const f32x4*)(bg + 4 * n); buv[n] = *(const f32x4*)(bg + 1024 + 4 * n); }
        float rsv[8];
#pragma unroll
        for (int i = 0; i < 8; ++i) { const int pos = u.p0 + r0 + (i >> 2) * HALF + (i & 3) * 16; rsv[i] = pos < ce ? __int_as_float(rowmap[2 * (u.e * 16384 + pos) + 1]) * (1.f / W8_SCALE) : 0.f; }
#pragma unroll
        for (int ai = 0; ai < 2; ++ai)
#pragma unroll
            for (int m = 0; m < 4; ++m) { const int rt = r0 + ai * HALF + m * 16; const float rs = rsv[ai * 4 + m]; unsigned w[2];
#pragma unroll
                for (int n = 0; n < 2; ++n) { f32x4 g = acc[ai][0][m][n] * rs + bgv[n], up = acc[ai][1][m][n] * rs + buv[n]; float a[4];
#pragma unroll
                    for (int k = 0; k < 4; ++k) { const float gg = fminf(g[k], 7.f), uu = fminf(fmaxf(up[k], -7.f), 7.f); a[k] = (uu + 1.f) * (gg * fsigmoid(1.702f * gg)); }
                    w[n] = pk4_fp8(a[0], a[1], a[2], a[3]); }
                *(v2u*)(ACT8 + (size_t)(u.pm * BM + rt) * 1024 + u.pn * 128 + cc) = (v2u){w[0], w[1]}; }
    }
};
struct EpiDN {
    static constexpr bool PERM = true; static constexpr int MID_T = 0, NSEG = 1, SEG_STEP = 0;
    unsigned char* Y; const float* b_dn;
    __device__ __forceinline__ void operator()(const f32x4 (&acc)[2][2][4][2], const Unit& u, int wr, int wc, int fr, int fq) const {
        int row0 = u.pm * BM + wr * 64 + fr; asm volatile("" : "+v"(row0)); const int col0 = u.pn * BM + wc * 32 + 8 * fq;
        f32x4 bv[2][2];
#pragma unroll
        for (int bj = 0; bj < 2; ++bj)
#pragma unroll
            for (int n = 0; n < 2; ++n) bv[bj][n] = *(const f32x4*)(b_dn + (size_t)u.e * 1024 + col0 + bj * HALF + 4 * n);
#pragma unroll
        for (int ai = 0; ai < 2; ++ai)
#pragma unroll
            for (int m = 0; m < 4; ++m) { unsigned char* rowp = Y + (size_t)(row0 + ai * HALF + m * 16) * 1024 + col0;
#pragma unroll
                for (int bj = 0; bj < 2; ++bj) { const f32x4 v0 = acc[ai][bj][m][0] * (1.f / W8_SCALE) + bv[bj][0], v1 = acc[ai][bj][m][1] * (1.f / W8_SCALE) + bv[bj][1];
                    *(v2u*)(rowp + bj * HALF) = (v2u){pk4_fp8(v0[0], v0[1], v0[2], v0[3]), pk4_fp8(v1[0], v1[1], v1[2], v1[3])}; } }
    }
};
}
#ifndef FP8_G2
#define FP8_G2 0
#endif
#ifndef FP8_G3
#define FP8_G3 0
#endif
#ifndef FP8_G4
#define FP8_G4 1
#endif
#ifndef FP8_G6
#define FP8_G6 1
#endif
#ifndef I8_G1
#define I8_G1 1
#endif
#ifndef MK_SUBREP
#define MK_SUBREP 0
#endif
constexpr int NWAVES = 8;
constexpr int M_TOK = 16384, SEQ = 2048, NBATCH = 8, DM = 1024;
constexpr int P1C = 8448;
constexpr int C_Q = 0, C_K = 1024, C_V = 1152, C_Z = 1280, C_X = 3328, C_G = 6400;
constexpr int N1 = 8704;
constexpr size_t MiB = 1u << 20;
constexpr size_t WS_CTL = 0, CTL_ZERO_BYTES = 1 * MiB;
constexpr size_t WS_W1T = 1 * MiB, WS_WCKV = 18 * MiB, WS_WCAT = 22 * MiB, WS_WOUT = 28 * MiB, WS_WCQ = 30 * MiB, WS_WCO = 32 * MiB, WS_WR = 34 * MiB, WS_WGU = 35 * MiB, WS_WDN = 163 * MiB;
constexpr size_t WS_P1 = 228 * MiB, WS_DT = 492 * MiB, WS_KVC = 494 * MiB, WS_ACAT = 502 * MiB, WS_ST = 598 * MiB, WS_PREV = 662 * MiB, WS_U = 726 * MiB, WS_MN = 758 * MiB;
constexpr size_t WS_H1 = 762 * MiB, WS_HB = 826 * MiB, WS_MISC = 858 * MiB;
constexpr size_t WS_T8 = WS_ACAT  , WS_MERGED = WS_U, WS_QC = WS_ST, WS_OC = WS_ST + 32 * MiB, WS_H2 = WS_PREV, WS_T = WS_HB, WS_ACT = WS_P1, WS_Y = WS_P1 + 144 * MiB;
constexpr size_t WS_SSQ1 = WS_MISC, WS_SSQ2 = WS_MISC + 1 * MiB, WS_TOKE = WS_MISC + 2 * MiB, WS_TOKP = WS_TOKE + 256 * 1024, WS_TOKW = WS_TOKP + 256 * 1024, WS_CDEC = WS_TOKW + 256 * 1024, WS_ROWMAP = WS_MISC + 3 * MiB  , WS_SSQG = WS_MISC + 7 * MiB, WS_USC = WS_MISC + 7 * MiB + 512 * 1024  , WS_CSC = WS_MISC + 7 * MiB + 768 * 1024  , WS_MSC = WS_MISC + 7 * MiB + 832 * 1024  , WS_KSC = WS_MISC + 7 * MiB + 896 * 1024  ;
constexpr size_t WS_NAIVE = 880 * MiB;
constexpr int CW_TMO = 0, CW_BAR = 4096, CW_CNT = 16384;
constexpr int SCR_BYTES = 139264;
constexpr int TAB_OFF = SCR_BYTES;
constexpr int LDS_BYTES = SCR_BYTES + 16384;
constexpr int TAB_MISC = TAB_OFF;
constexpr int TAB_DT = TAB_OFF + 1024, TAB_ACUM = TAB_OFF + 1024 + 4096;
constexpr int TAB_TE = TAB_OFF + 1024, TAB_TP0 = TAB_TE + 1280, TAB_CNT = TAB_TP0 + 1280, TAB_TB = TAB_CNT + 128, TAB_NT = TAB_TB + 128;

typedef const float* fptr_t;
struct Frame {
    LAS unsigned char* lds; gu32* ctl; int tid, lane, wave, vcu, G;
    unsigned char* ws;
    const __attribute__((address_space(4))) fptr_t* in;
    float* out;
};
enum { I_X = 0, I_MEM, I_NMIXW, I_WIN, I_WGATE, I_BGATE, I_SINKS, I_CONVW, I_CONVB, I_DTB, I_ALOG, I_DSKIP, I_SSMNW, I_WAO, I_WSO, I_WOUT, I_NCW, I_NMW, I_WCQ, I_WCKV, I_WCO, I_NFW, I_WR, I_BR, I_WGU, I_BGU, I_WDN, I_BDN, I_FNW };

__device__ __forceinline__ void tr_item(const float* W, int ldw, int k0, int n0, bf16* dst, int ldt, LAS float* scr, int lane, const float* kscale = nullptr) {
    f32x4 t[8]; const int rr = lane >> 3, c4 = (lane & 7) * 4;
#pragma unroll
    for (int i = 0; i < 8; ++i) { t[i] = *(const GAS f32x4*)(W + (size_t)(k0 + 8 * i + rr) * ldw + n0 + c4); if (kscale) t[i] *= kscale[k0 + 8 * i + rr]; }
#pragma unroll
    for (int i = 0; i < 8; ++i) { LAS float* d = scr + (8 * i + rr) * 33 + c4; d[0] = t[i][0]; d[1] = t[i][1]; d[2] = t[i][2]; d[3] = t[i][3]; }
    LDS_WAIT(); asm volatile("" ::: "memory");
    const int c = lane & 7;
#pragma unroll
    for (int j = 0; j < 4; ++j) { const int n = (lane >> 3) + 8 * j; const LAS float* s = scr + (8 * c) * 33 + n;
        v4u o; o.x = pk2(s[0 * 33], s[1 * 33]); o.y = pk2(s[2 * 33], s[3 * 33]); o.z = pk2(s[4 * 33], s[5 * 33]); o.w = pk2(s[6 * 33], s[7 * 33]);
        *(GAS v4u*)(dst + (size_t)n * ldt + 8 * c) = o; }
    LDS_WAIT(); asm volatile("" ::: "memory");
}
__device__ __forceinline__ void tr_item8(const float* W, int ldw, int k0, int n0, unsigned char* dst, int ldt, LAS float* scr, int lane, float sc, const float* kscale = nullptr) {
    f32x4 t[8]; const int rr = lane >> 3, c4 = (lane & 7) * 4;
#pragma unroll
    for (int i = 0; i < 8; ++i) t[i] = *(const GAS f32x4*)(W + (size_t)(k0 + 8 * i + rr) * ldw + n0 + c4);
#pragma unroll
    for (int i = 0; i < 8; ++i) { LAS float* d = scr + (8 * i + rr) * 33 + c4; const float f = kscale ? sc * kscale[k0 + 8 * i + rr] : sc; d[0] = t[i][0] * f; d[1] = t[i][1] * f; d[2] = t[i][2] * f; d[3] = t[i][3] * f; }
    LDS_WAIT(); asm volatile("" ::: "memory");
    const int n = lane >> 1, hf = lane & 1; const LAS float* s = scr + (32 * hf) * 33 + n;
    unsigned o[8];
#pragma unroll
    for (int j = 0; j < 8; ++j) o[j] = pg8::pk4_fp8(s[(4 * j) * 33], s[(4 * j + 1) * 33], s[(4 * j + 2) * 33], s[(4 * j + 3) * 33]);
    GAS v4u* dp = (GAS v4u*)(dst + (size_t)n * ldt + 32 * hf);
    dp[0] = (v4u){o[0], o[1], o[2], o[3]}; dp[1] = (v4u){o[4], o[5], o[6], o[7]};
    LDS_WAIT(); asm volatile("" ::: "memory");
}
__device__ __forceinline__ void rms_row_to_bf16(const float* xrow, const float* w, bf16* orow, int lane) {
    const GAS f32x4* xr = (const GAS f32x4*)xrow + lane; const GAS f32x4* wr_ = (const GAS f32x4*)w + lane;
    f32x4 v[4]; float s = 0.f;
#pragma unroll
    for (int j = 0; j < 4; ++j) { v[j] = xr[64 * j]; s += (v[j].x * v[j].x + v[j].y * v[j].y) + (v[j].z * v[j].z + v[j].w * v[j].w); }
    const float rstd = 1.f / sqrtf(wave_sum(s) * (1.f / 1024.f) + 1e-5f);
    GAS unsigned long long* o8 = (GAS unsigned long long*)orow + lane;
#pragma unroll
    for (int j = 0; j < 4; ++j) { const f32x4 g = wr_[64 * j]; o8[64 * j] = (unsigned long long)pk2(v[j].x * rstd * g.x, v[j].y * rstd * g.y) | ((unsigned long long)pk2(v[j].z * rstd * g.z, v[j].w * rstd * g.w) << 32); }
}
__device__ __forceinline__ unsigned pk4_i8(float a, float b, float c, float d) {
    return ((unsigned)(int)a & 0xffu) | (((unsigned)(int)b & 0xffu) << 8) | (((unsigned)(int)c & 0xffu) << 16) | ((unsigned)(int)d << 24); }
__device__ __forceinline__ void rms_row_to_i8(const float* xrow, const float* w, unsigned char* orow, float* osc, int lane) {
    const GAS f32x4* xr = (const GAS f32x4*)xrow + lane; const GAS f32x4* wr_ = (const GAS f32x4*)w + lane;
    f32x4 v[4]; float s = 0.f;
#pragma unroll
    for (int j = 0; j < 4; ++j) { v[j] = xr[64 * j]; s += (v[j].x * v[j].x + v[j].y * v[j].y) + (v[j].z * v[j].z + v[j].w * v[j].w); }
    const float rstd = 1.f / sqrtf(wave_sum(s) * (1.f / 1024.f) + 1e-5f); float mx = 0.f;
#pragma unroll
    for (int j = 0; j < 4; ++j) { const f32x4 g = wr_[64 * j]; v[j] = v[j] * rstd * g; mx = fmaxf(fmaxf(fmaxf(fabsf(v[j].x), fabsf(v[j].y)), fmaxf(fabsf(v[j].z), fabsf(v[j].w))), mx); }
#pragma unroll
    for (int o = 1; o < 64; o <<= 1) mx = fmaxf(mx, __shfl_xor(mx, o));
    const float isc = mx > 0.f ? 127.f / mx : 0.f;
#pragma unroll
    for (int j = 0; j < 4; ++j) ((GAS unsigned*)orow)[lane + 64 * j] = pk4_i8(rintf(v[j].x * isc), rintf(v[j].y * isc), rintf(v[j].z * isc), rintf(v[j].w * isc));
    if (lane == 0) *osc = mx * (1.f / 127.f);
}
__device__ __forceinline__ void w1t_colblock_i8(Frame& F, const float* W, int ldw, int n0, unsigned char* dst  , float* csc  ) {
    LAS float* scr = (LAS float*)(F.lds + F.wave * 16384); LAS float* cmax = (LAS float*)(F.lds + TAB_OFF + 1024);
    const int lane = F.lane, rr = lane >> 3, c4 = (lane & 7) * 4, kb0 = 2 * F.wave;
    f32x4 t[2][8]; f32x4 mx = (f32x4){0.f, 0.f, 0.f, 0.f};
#pragma unroll
    for (int b = 0; b < 2; ++b)
#pragma unroll
        for (int i = 0; i < 8; ++i) t[b][i] = *(const GAS f32x4*)(W + (size_t)(64 * (kb0 + b) + 8 * i + rr) * ldw + n0 + c4);
#pragma unroll
    for (int b = 0; b < 2; ++b)
#pragma unroll
        for (int i = 0; i < 8; ++i) { mx[0] = fmaxf(mx[0], fabsf(t[b][i][0])); mx[1] = fmaxf(mx[1], fabsf(t[b][i][1])); mx[2] = fmaxf(mx[2], fabsf(t[b][i][2])); mx[3] = fmaxf(mx[3], fabsf(t[b][i][3])); }
#pragma unroll
    for (int o = 8; o < 64; o <<= 1) { mx[0] = fmaxf(mx[0], __shfl_xor(mx[0], o)); mx[1] = fmaxf(mx[1], __shfl_xor(mx[1], o)); mx[2] = fmaxf(mx[2], __shfl_xor(mx[2], o)); mx[3] = fmaxf(mx[3], __shfl_xor(mx[3], o)); }
    if (lane < 8) *(LAS f32x4*)(cmax + F.wave * 32 + c4) = mx;
    LDS_WAIT(); __syncthreads();
#pragma unroll
    for (int wv = 0; wv < 8; ++wv) { const f32x4 o = *(const LAS f32x4*)(cmax + wv * 32 + c4); mx[0] = fmaxf(mx[0], o[0]); mx[1] = fmaxf(mx[1], o[1]); mx[2] = fmaxf(mx[2], o[2]); mx[3] = fmaxf(mx[3], o[3]); }
    f32x4 isc;
#pragma unroll
    for (int k = 0; k < 4; ++k) isc[k] = mx[k] > 0.f ? 127.f / mx[k] : 0.f;
    if (F.wave == 0 && lane < 8) *(f32x4*)(csc + c4) = mx * (1.f / 127.f);
#pragma unroll
    for (int b = 0; b < 2; ++b) {
#pragma unroll
        for (int i = 0; i < 8; ++i) { LAS float* d = scr + (8 * i + rr) * 33 + c4; d[0] = rintf(t[b][i][0] * isc[0]); d[1] = rintf(t[b][i][1] * isc[1]); d[2] = rintf(t[b][i][2] * isc[2]); d[3] = rintf(t[b][i][3] * isc[3]); }
        LDS_WAIT(); asm volatile("" ::: "memory");
        { const int n = lane >> 1, hf = lane & 1; const LAS float* sp = scr + (32 * hf) * 33 + n; unsigned o[8];
#pragma unroll
          for (int j = 0; j < 8; ++j) o[j] = pk4_i8(sp[(4 * j) * 33], sp[(4 * j + 1) * 33], sp[(4 * j + 2) * 33], sp[(4 * j + 3) * 33]);
          GAS v4u* dp = (GAS v4u*)(dst + (size_t)n * 1024 + 64 * (kb0 + b) + 32 * hf); dp[0] = (v4u){o[0], o[1], o[2], o[3]}; dp[1] = (v4u){o[4], o[5], o[6], o[7]}; }
        LDS_WAIT(); asm volatile("" ::: "memory");
    }
    __syncthreads();
}
__device__ __forceinline__ void p0_prologue(Frame& F) {
    LAS float* scr = (LAS float*)(F.lds + F.wave * 16384);
    const int gw = F.vcu * NWAVES + F.wave, NGW = F.G * NWAVES;
    bf16* W1T = (bf16*)(F.ws + WS_W1T); bf16* WCAT = (bf16*)(F.ws + WS_WCAT);
    constexpr int I1 = 16 * 200, I2 = 16, I3 = 16 * 64, I4 = 16 * 64, I5 = 16 * 32, I6 = 32 * 32, I7 = 16 * 32, I10 = 16, I11 = 32 * 16 * 64, I12 = 32 * 16 * 32;
    constexpr int NITEMS = (I8_G1 ? 0 : I1 + I2 + I3 + I4) + I5 + I6 + 3 * I7 + I10 + I11 + I12;
    for (int it = gw; it < NITEMS; it += NGW) {
        int r = it;
        if (I8_G1) r += I1 + I2 + I3;
        if (r < I1) { const int kb = r / 200, nb = r % 200; tr_item(F.in[I_WIN], 6432, 64 * kb, 32 * nb, W1T + (size_t)(32 * nb) * 1024 + 64 * kb, 1024, scr, F.lane); continue; } r -= I1;
        if (r < I2) { const int kb = r; tr_item(F.in[I_WIN], 6432, 64 * kb, 6400, W1T + (size_t)8448 * 1024 + 64 * kb, 1024, scr, F.lane); continue; } r -= I2;
        if (r < I3) { const int kb = r / 64, nb = r % 64; tr_item(F.in[I_WGATE], 2048, 64 * kb, 32 * nb, W1T + (size_t)(6400 + 32 * nb) * 1024 + 64 * kb, 1024, scr, F.lane); continue; } r -= I3;
        if (I8_G1) r += I4;
        if (r < I4) { const int kb = r / 64, nb = r % 64; tr_item(F.in[I_WCKV], 2048, 64 * kb, 32 * nb, (bf16*)(F.ws + WS_WCKV) + (size_t)(32 * nb) * 1024 + 64 * kb, 1024, scr, F.lane); continue; } r -= I4;
        if (r < I5) { const int kb = r / 32, nb = r % 32;
            if (FP8_G2) tr_item8(F.in[I_WAO], 1024, 64 * kb, 32 * nb, (unsigned char*)WCAT + (size_t)(32 * nb) * 3072 + 64 * kb, 3072, scr, F.lane, pg8::W8_SCALE);
            else tr_item(F.in[I_WAO], 1024, 64 * kb, 32 * nb, WCAT + (size_t)(32 * nb) * 3072 + 64 * kb, 3072, scr, F.lane);
            continue; } r -= I5;
        if (r < I6) { const int kb = r / 32, nb = r % 32;
            if (FP8_G2) tr_item8(F.in[I_WSO], 1024, 64 * kb, 32 * nb, (unsigned char*)WCAT + (size_t)(32 * nb) * 3072 + 1024 + 64 * kb, 3072, scr, F.lane, pg8::W8_SCALE, F.in[I_SSMNW]);
            else tr_item(F.in[I_WSO], 1024, 64 * kb, 32 * nb, WCAT + (size_t)(32 * nb) * 3072 + 1024 + 64 * kb, 3072, scr, F.lane, F.in[I_SSMNW]);
            continue; } r -= I6;
        if (r < I7) { const int kb = r / 32, nb = r % 32;
            if (FP8_G3) tr_item8(F.in[I_WOUT], 1024, 64 * kb, 32 * nb, (unsigned char*)(F.ws + WS_WOUT) + (size_t)(32 * nb) * 1024 + 64 * kb, 1024, scr, F.lane, pg8::W8_SCALE);
            else tr_item(F.in[I_WOUT], 1024, 64 * kb, 32 * nb, (bf16*)(F.ws + WS_WOUT) + (size_t)(32 * nb) * 1024 + 64 * kb, 1024, scr, F.lane);
            continue; } r -= I7;
        if (r < I7) { const int kb = r / 32, nb = r % 32;
            if (FP8_G4) tr_item8(F.in[I_WCQ], 1024, 64 * kb, 32 * nb, (unsigned char*)(F.ws + WS_WCQ) + (size_t)(32 * nb) * 1024 + 64 * kb, 1024, scr, F.lane, pg8::W8_SCALE);
            else tr_item(F.in[I_WCQ], 1024, 64 * kb, 32 * nb, (bf16*)(F.ws + WS_WCQ) + (size_t)(32 * nb) * 1024 + 64 * kb, 1024, scr, F.lane);
            continue; } r -= I7;
        if (r < I7) { const int kb = r / 32, nb = r % 32;
            if (FP8_G6) tr_item8(F.in[I_WCO], 1024, 64 * kb, 32 * nb, (unsigned char*)(F.ws + WS_WCO) + (size_t)(32 * nb) * 1024 + 64 * kb, 1024, scr, F.lane, pg8::W8_SCALE);
            else tr_item(F.in[I_WCO], 1024, 64 * kb, 32 * nb, (bf16*)(F.ws + WS_WCO) + (size_t)(32 * nb) * 1024 + 64 * kb, 1024, scr, F.lane);
            continue; } r -= I7;
        if (r < I10) { const int kb = r; tr_item(F.in[I_WR], 32, 64 * kb, 0, (bf16*)(F.ws + WS_WR) + 64 * kb, 1024, scr, F.lane); continue; } r -= I10;
        if (r < I11) { const int e = r / 1024, rr = r % 1024, kb = rr / 64, nb = rr % 64; const int n0 = 32 * nb, up = n0 >= 1024 ? 1 : 0, j = n0 & 1023, drow = (j >> 7) * 256 + up * 128 + (j & 127);
            tr_item8(F.in[I_WGU] + (size_t)e * 1024 * 2048, 2048, 64 * kb, n0, (unsigned char*)(F.ws + WS_WGU) + (size_t)e * 2048 * 1024 + (size_t)drow * 1024 + 64 * kb, 1024, scr, F.lane, pg8::W8_SCALE); continue; } r -= I11;
        { const int e = r / 512, rr = r % 512, kb = rr / 32, nb = rr % 32;
            tr_item8(F.in[I_WDN] + (size_t)e * 1024 * 1024, 1024, 64 * kb, 32 * nb, (unsigned char*)(F.ws + WS_WDN) + (size_t)e * 1024 * 1024 + (size_t)(32 * nb) * 1024 + 64 * kb, 1024, scr, F.lane, pg8::W8_SCALE); }
    }
    if (I8_G1) {
        unsigned char* W8 = (unsigned char*)(F.ws + WS_W1T); float* csc = (float*)(F.ws + WS_CSC);
        __syncthreads();
        for (int task = F.vcu; task < 265 + 64; task += F.G) {
            if (task >= 265) { const int nb = task - 265; w1t_colblock_i8(F, F.in[I_WCKV], 2048, 32 * nb, (unsigned char*)(F.ws + WS_WCKV) + (size_t)(32 * nb) * 1024, (float*)(F.ws + WS_KSC) + 32 * nb); }
            else if (task < 201) { const int drow = task < 200 ? 32 * task : 8448; w1t_colblock_i8(F, F.in[I_WIN], 6432, 32 * task, W8 + (size_t)drow * 1024, csc + drow); }
            else { const int nb = task - 201; w1t_colblock_i8(F, F.in[I_WGATE], 2048, 32 * nb, W8 + (size_t)(6400 + 32 * nb) * 1024, csc + 6400 + 32 * nb); } }
        for (int i = F.vcu * 512 + F.tid; i < 14336; i += F.G * 512) ((GAS v4u*)(W8 + (size_t)8480 * 1024))[i] = (v4u){0u, 0u, 0u, 0u};
        for (int i = F.vcu * 512 + F.tid; i < 224; i += F.G * 512) csc[8480 + i] = 0.f;
        for (int m = gw; m < M_TOK; m += NGW) rms_row_to_i8(F.in[I_X] + (size_t)m * DM, F.in[I_NMIXW], (unsigned char*)(F.ws + WS_U) + (size_t)m * DM, (float*)(F.ws + WS_USC) + m, F.lane);
    } else {
    for (int i = F.vcu * 512 + F.tid; i < 28672; i += F.G * 512) ((GAS v4u*)(W1T + (size_t)8480 * 1024))[i] = (v4u){0u, 0u, 0u, 0u};
    for (int m = gw; m < M_TOK; m += NGW) rms_row_to_bf16(F.in[I_X] + (size_t)m * DM, F.in[I_NMIXW], (bf16*)(F.ws + WS_U) + (size_t)m * DM, F.lane);
    }
    for (int m = gw; m < NBATCH * 256; m += NGW) {
        if (I8_G1) rms_row_to_i8(F.in[I_MEM] + (size_t)m * DM, F.in[I_NMW], (unsigned char*)(F.ws + WS_MN) + (size_t)m * DM, (float*)(F.ws + WS_MSC) + m, F.lane);
        else rms_row_to_bf16(F.in[I_MEM] + (size_t)m * DM, F.in[I_NMW], (bf16*)(F.ws + WS_MN) + (size_t)m * DM, F.lane); }
}

__device__ __forceinline__ s16x4 tr_read(const LAS unsigned char* p) { return __builtin_bit_cast(s16x4, __builtin_amdgcn_ds_read_tr16_b64_v4i16((LAS s16x4*)p)); }
__device__ __forceinline__ bf16x8 cat8(s16x4 a, s16x4 b) { return (bf16x8){a[0], a[1], a[2], a[3], b[0], b[1], b[2], b[3]}; }
__device__ __forceinline__ bf16x8 pack8(f32x4 a, f32x4 b) { v4u w; w.x = cvt_pk_bf16(a[0], a[1]); w.y = cvt_pk_bf16(a[2], a[3]); w.z = cvt_pk_bf16(b[0], b[1]); w.w = cvt_pk_bf16(b[2], b[3]); return __builtin_bit_cast(bf16x8, w); }
#define MFMA16(a, b, c) __builtin_amdgcn_mfma_f32_16x16x32_bf16((a), (b), (c), 0, 0, 0)
#define WG_BAR() do { asm volatile("s_waitcnt vmcnt(0) lgkmcnt(0)" ::: "memory"); __builtin_amdgcn_s_barrier(); asm volatile("" ::: "memory"); } while (0)
constexpr float LOG2E = 1.4426950408889634f;

constexpr int SWA_STR = 144, SWA_IMG = 272 * SWA_STR;
__device__ __forceinline__ void swa_phase(Frame& F) {
    const bf16* P1 = (const bf16*)(F.ws + WS_P1); bf16* ACAT = (bf16*)(F.ws + WS_ACAT);
    LAS unsigned char* Kimg = F.lds; LAS unsigned char* Vimg = F.lds + SWA_IMG;
    const int lane = F.lane, w = F.wave, q = lane & 15, g = lane >> 4;
    for (int u = F.vcu; u < 256; u += F.G) {
        const int b = u >> 5, kvh = (u >> 4) & 1, n = u & 15;
        for (int pc = F.tid; pc < 2 * 272 * 8; pc += 512) {
            const int img = pc >= 272 * 8 ? 1 : 0, p2 = pc - img * 272 * 8, row = p2 >> 3, ch = p2 & 7; const int s = (n - 1) * 128 + row;
            v4u v = (v4u){0u, 0u, 0u, 0u};
            if (row < 256 && s >= 0) v = *(const GAS v4u*)(P1 + (size_t)(b * SEQ + s) * P1C + (img ? C_V : C_K) + kvh * 64 + ch * 8);
            *(LAS v4u*)((img ? Vimg : Kimg) + row * SWA_STR + ch * 16) = v; }
        WG_BAR();
        const int h = kvh * 8 + w; const float slope2 = exp2f(-0.5f * (float)(h + 1)) * LOG2E, sink2 = F.in[I_SINKS][h] * LOG2E;
        f32x4 bias[9];
#pragma unroll
        for (int j = 0; j < 9; ++j)
#pragma unroll
            for (int r = 0; r < 4; ++r) { const int dist = 128 + q - 16 * j - 4 * g - r; const float bv = -slope2 * (float)dist;
                bias[j][r] = (j == 0) ? (dist < 128 ? bv : -INFINITY) : ((j == 8) ? (dist >= 0 ? bv : -INFINITY) : bv); }
        __builtin_amdgcn_sched_barrier(0);
        bf16x8 qn[2];
#pragma unroll
        for (int ks = 0; ks < 2; ++ks) qn[ks] = *(const GAS bf16x8*)(P1 + (size_t)(b * SEQ + n * 128 + q) * P1C + C_Q + h * 64 + 32 * ks + 8 * g);
        __builtin_amdgcn_sched_barrier(0);
#pragma unroll 1
        for (int i = 0; i < 8; ++i) {
            const int t0 = b * SEQ + n * 128 + 16 * i;
            bf16x8 qf[2]; qf[0] = qn[0]; qf[1] = qn[1];
            { const int tn = i < 7 ? t0 + 16 : t0;
#pragma unroll
              for (int ks = 0; ks < 2; ++ks) qn[ks] = *(const GAS bf16x8*)(P1 + (size_t)(tn + q) * P1C + C_Q + h * 64 + 32 * ks + 8 * g); }
            f32x4 s[10];
#pragma unroll
            for (int j = 0; j < 9; ++j) { s[j] = (f32x4){0.f, 0.f, 0.f, 0.f};
#pragma unroll
                for (int ks = 0; ks < 2; ++ks) { const bf16x8 kf = *(const LAS bf16x8*)(Kimg + (16 * (i + j) + q) * SWA_STR + (32 * ks + 8 * g) * 2); s[j] = MFMA16(kf, qf[ks], s[j]); } }
            s[9] = (f32x4){0.f, 0.f, 0.f, 0.f};
            __builtin_amdgcn_sched_barrier(0);
            float mx = sink2;
#pragma unroll
            for (int j = 0; j < 9; ++j) { const bool dead = (n == 0) && (i + j < 8);
#pragma unroll
                for (int r = 0; r < 4; ++r) { const float v = dead ? -INFINITY : s[j][r] * (0.125f * LOG2E) + bias[j][r]; s[j][r] = v; mx = fmaxf(mx, v); } }
            mx = fmaxf(mx, __shfl_xor(mx, 16)); mx = fmaxf(mx, __shfl_xor(mx, 32));
            float sum = 0.f;
#pragma unroll
            for (int j = 0; j < 9; ++j)
#pragma unroll
                for (int r = 0; r < 4; ++r) { const float p = __builtin_amdgcn_exp2f(s[j][r] - mx); s[j][r] = p; sum += p; }
            sum += __shfl_xor(sum, 16); sum += __shfl_xor(sum, 32); sum += __builtin_amdgcn_exp2f(sink2 - mx);
            const float inv = 1.f / sum;
            __builtin_amdgcn_sched_barrier(0);
            f32x4 o[4];
#pragma unroll
            for (int dt = 0; dt < 4; ++dt) o[dt] = (f32x4){0.f, 0.f, 0.f, 0.f};
#pragma unroll
            for (int kk = 0; kk < 5; ++kk) { const bf16x8 pf = pack8(s[2 * kk], s[2 * kk + 1]);
                const LAS unsigned char* vb = Vimg + (16 * (i + 2 * kk) + 4 * g + (q >> 2)) * SWA_STR + (4 * (q & 3)) * 2;
#pragma unroll
                for (int dt = 0; dt < 4; ++dt) { const bf16x8 vf = cat8(tr_read(vb + dt * 32), tr_read(vb + dt * 32 + 16 * SWA_STR)); o[dt] = MFMA16(vf, pf, o[dt]); } }
#pragma unroll
            for (int dt = 0; dt < 4; ++dt) {
                if (FP8_G2) *(GAS unsigned*)((unsigned char*)ACAT + (size_t)(t0 + q) * 3072 + h * 64 + 16 * dt + 4 * g) = pg8::pk4_fp8(o[dt][0] * inv, o[dt][1] * inv, o[dt][2] * inv, o[dt][3] * inv);
                else { v2u wv; wv.x = cvt_pk_bf16(o[dt][0] * inv, o[dt][1] * inv); wv.y = cvt_pk_bf16(o[dt][2] * inv, o[dt][3] * inv);
                    *(GAS v2u*)(ACAT + (size_t)(t0 + q) * 3072 + h * 64 + 16 * dt + 4 * g) = wv; } }
        }
        WG_BAR();
    }
}

__device__ __forceinline__ void ssd_tables(Frame& F, int b, int c, int g) {
    const float* DT = (const float*)(F.ws + WS_DT); LAS float* dt_s = (LAS float*)(F.lds + TAB_DT); LAS float* ac_s = (LAS float*)(F.lds + TAB_ACUM);
    const int hh = F.wave, h = 8 * g + hh, lane = F.lane; const float A = -expf(F.in[I_ALOG][h]) * LOG2E, dtb = F.in[I_DTB][h];
    const int tok = b * SEQ + c * 128 + 2 * lane;
    float d0 = DT[(size_t)tok * 32 + h] + dtb, d1 = DT[(size_t)(tok + 1) * 32 + h] + dtb;
    d0 = d0 > 20.f ? d0 : log1pf(expf(d0)); d1 = d1 > 20.f ? d1 : log1pf(expf(d1));
    const float a0 = d0 * A, a1 = d1 * A; float run = a0 + a1;
#pragma unroll
    for (int o = 1; o < 64; o <<= 1) { const float t = __shfl_up(run, o); if (lane >= o) run += t; }
    dt_s[hh * 128 + 2 * lane] = d0; dt_s[hh * 128 + 2 * lane + 1] = d1; ac_s[hh * 128 + 2 * lane] = run - a1; ac_s[hh * 128 + 2 * lane + 1] = run;
}
template <int NR>
__device__ __forceinline__ void conv_load(const bf16* P1, int b, int s0, int c0, v4u (&x)[NR + 3]) {
    const bf16* base = P1 + (size_t)(b * SEQ) * P1C + C_X + c0;
#pragma unroll
    for (int i = 0; i < NR + 3; ++i) { const int ss = s0 - 3 + i; x[i] = (v4u){0u, 0u, 0u, 0u}; if (ss >= 0) x[i] = *(const GAS v4u*)(base + (size_t)ss * P1C); }
}
template <int NR, class Emit>
__device__ __forceinline__ void conv_apply(const v4u (&x)[NR + 3], const float* cw, const float* cb, int c0, Emit&& emit) {
    float wt[4][8], bs[8];
    { const f32x4 b0 = *(const f32x4*)(cb + c0), b1 = *(const f32x4*)(cb + c0 + 4); bs[0] = b0[0]; bs[1] = b0[1]; bs[2] = b0[2]; bs[3] = b0[3]; bs[4] = b1[0]; bs[5] = b1[1]; bs[6] = b1[2]; bs[7] = b1[3]; }
#pragma unroll
    for (int j = 0; j < 4; ++j) { const f32x4 w0 = *(const f32x4*)(cw + j * 3072 + c0), w1 = *(const f32x4*)(cw + j * 3072 + c0 + 4);
        wt[j][0] = w0[0]; wt[j][1] = w0[1]; wt[j][2] = w0[2]; wt[j][3] = w0[3]; wt[j][4] = w1[0]; wt[j][5] = w1[1]; wt[j][6] = w1[2]; wt[j][7] = w1[3]; }
#pragma unroll
    for (int r = 0; r < NR; ++r) { float a[8];
#pragma unroll
        for (int k = 0; k < 8; ++k) a[k] = bs[k];
#pragma unroll
        for (int j = 0; j < 4; ++j) { const v4u xv = x[r + j];
            a[0] += wt[j][0] * bflo(xv.x); a[1] += wt[j][1] * bfhi(xv.x); a[2] += wt[j][2] * bflo(xv.y); a[3] += wt[j][3] * bfhi(xv.y); a[4] += wt[j][4] * bflo(xv.z); a[5] += wt[j][5] * bfhi(xv.z); a[6] += wt[j][6] * bflo(xv.w); a[7] += wt[j][7] * bfhi(xv.w); }
#pragma unroll
        for (int k = 0; k < 8; ++k) a[k] = a[k] * pg8::fsigmoid(a[k]);
        emit(r, a); }
}
template <int NR, class Emit>
__device__ __forceinline__ void conv_rows(const bf16* P1, const float* cw, const float* cb, int b, int s0, int c0, Emit&& emit) {
    v4u x[NR + 3]; conv_load<NR>(P1, b, s0, c0, x); conv_apply<NR>(x, cw, cb, c0, emit);
}
__device__ __forceinline__ v4u pack8u(const float (&v)[8], float sc) { return (v4u){cvt_pk_bf16(v[0] * sc, v[1] * sc), cvt_pk_bf16(v[2] * sc, v[3] * sc), cvt_pk_bf16(v[4] * sc, v[5] * sc), cvt_pk_bf16(v[6] * sc, v[7] * sc)}; }

constexpr int SB_STR = 272, SX_STR = 528;
__device__ __forceinline__ void ssd_states_phase(Frame& F) {
    const bf16* P1 = (const bf16*)(F.ws + WS_P1); bf16* ST = (bf16*)(F.ws + WS_ST); float* CDEC = (float*)(F.ws + WS_CDEC);
    const float* cw = F.in[I_CONVW]; const float* cb = F.in[I_CONVB];
    LAS unsigned char* Bimg = F.lds; LAS unsigned char* Ximg = F.lds + 128 * SB_STR;
    LAS float* dt_s = (LAS float*)(F.lds + TAB_DT); LAS float* ac_s = (LAS float*)(F.lds + TAB_ACUM);
    const int lane = F.lane, w = F.wave, q = lane & 15, g4 = lane >> 4;
    for (int u = F.vcu; u < 512; u += F.G) {
        const int b = u >> 6, c = (u >> 2) & 15, g = u & 3;
        if (c == 15) continue;
        ssd_tables(F, b, c, g);
        { const int ch = F.tid & 15, l0 = (F.tid >> 4) * 4;
          conv_rows<4>(P1, cw, cb, b, c * 128 + l0, 2048 + 128 * g + 8 * ch, [&](int r, const float (&v)[8]) { *(LAS v4u*)(Bimg + (l0 + r) * SB_STR + ch * 16) = pack8u(v, 1.f); }); }
        WG_BAR();
        if (F.tid < 8) CDEC[(b * 16 + c) * 32 + 8 * g + F.tid] = __builtin_amdgcn_exp2f(ac_s[F.tid * 128 + 127]);
#pragma unroll 1
        for (int half = 0; half < 2; ++half) {
            { const int ch = F.tid & 31, l0 = (F.tid >> 5) * 8, hh = half * 4 + (ch >> 3); const float aend = ac_s[hh * 128 + 127];
              conv_rows<8>(P1, cw, cb, b, c * 128 + l0, 512 * g + 256 * half + 8 * ch, [&](int r, const float (&v)[8]) {
                  const float sc = dt_s[hh * 128 + l0 + r] * __builtin_amdgcn_exp2f(aend - ac_s[hh * 128 + l0 + r]);
                  *(LAS v4u*)(Ximg + (l0 + r) * SX_STR + ch * 16) = pack8u(v, sc); }); }
            WG_BAR();
            const int hl = w >> 1, nt0 = (w & 1) * 4;
            f32x4 acc[4][4];
#pragma unroll
            for (int a = 0; a < 4; ++a)
#pragma unroll
                for (int p = 0; p < 4; ++p) acc[a][p] = (f32x4){0.f, 0.f, 0.f, 0.f};
#pragma unroll
            for (int ks = 0; ks < 4; ++ks) {
                const int lrow = 32 * ks + 8 * g4 + (q >> 2);
                bf16x8 bf[4], xf[4];
#pragma unroll
                for (int a = 0; a < 4; ++a) { const LAS unsigned char* p = Bimg + lrow * SB_STR + (16 * (nt0 + a) + 4 * (q & 3)) * 2; bf[a] = cat8(tr_read(p), tr_read(p + 4 * SB_STR)); }
#pragma unroll
                for (int p4 = 0; p4 < 4; ++p4) { const LAS unsigned char* p = Ximg + lrow * SX_STR + (64 * hl + 16 * p4 + 4 * (q & 3)) * 2; xf[p4] = cat8(tr_read(p), tr_read(p + 4 * SX_STR)); }
#pragma unroll
                for (int a = 0; a < 4; ++a)
#pragma unroll
                    for (int p4 = 0; p4 < 4; ++p4) acc[a][p4] = MFMA16(bf[a], xf[p4], acc[a][p4]);
            }
            bf16* stp = ST + ((size_t)((b * 16 + c) * 32 + 8 * g + half * 4 + hl)) * 8192;
#pragma unroll
            for (int a = 0; a < 4; ++a)
#pragma unroll
                for (int p4 = 0; p4 < 4; ++p4) { v2u wv; wv.x = cvt_pk_bf16(acc[a][p4][0], acc[a][p4][1]); wv.y = cvt_pk_bf16(acc[a][p4][2], acc[a][p4][3]);
                    *(GAS v2u*)(stp + (16 * p4 + q) * 128 + 16 * (nt0 + a) + 4 * g4) = wv; }
            WG_BAR();
        }
    }
}
__device__ __forceinline__ void ssd_scan_phase(Frame& F) {
    const bf16* ST = (const bf16*)(F.ws + WS_ST); bf16* PREV = (bf16*)(F.ws + WS_PREV); const float* CDEC = (const float*)(F.ws + WS_CDEC);
    for (int it = F.vcu * 512 + F.tid; it < 8 * 32 * 1024; it += F.G * 512) {
        const int b = it >> 15, h = (it >> 10) & 31, e8 = it & 1023; float carry[8];
#pragma unroll
        for (int k = 0; k < 8; ++k) carry[k] = 0.f;
#pragma unroll 5
        for (int c = 0; c < 16; ++c) { const size_t off = ((size_t)((b * 16 + c) * 32 + h)) * 8192 + e8 * 8;
            *(GAS v4u*)(PREV + off) = (v4u){cvt_pk_bf16(carry[0], carry[1]), cvt_pk_bf16(carry[2], carry[3]), cvt_pk_bf16(carry[4], carry[5]), cvt_pk_bf16(carry[6], carry[7])};
            if (c < 15) { const float dec = CDEC[(b * 16 + c) * 32 + h]; const v4u s = *(const GAS v4u*)(ST + off);
                carry[0] = carry[0] * dec + bflo(s.x); carry[1] = carry[1] * dec + bfhi(s.x); carry[2] = carry[2] * dec + bflo(s.y); carry[3] = carry[3] * dec + bfhi(s.y);
                carry[4] = carry[4] * dec + bflo(s.z); carry[5] = carry[5] * dec + bfhi(s.z); carry[6] = carry[6] * dec + bflo(s.w); carry[7] = carry[7] * dec + bfhi(s.w); } }
    }
}
constexpr int SXF_STR = 1040;
__device__ __forceinline__ void ssd_out_phase(Frame& F) {
    const bf16* P1 = (const bf16*)(F.ws + WS_P1); const bf16* PREV = (const bf16*)(F.ws + WS_PREV); bf16* ACAT = (bf16*)(F.ws + WS_ACAT);
    const float* cw = F.in[I_CONVW]; const float* cb = F.in[I_CONVB];
    LAS unsigned char* Bimg = F.lds; LAS unsigned char* Cimg = F.lds + 128 * SB_STR; LAS unsigned char* Ximg = F.lds;
    LAS float* dt_s = (LAS float*)(F.lds + TAB_DT); LAS float* ac_s = (LAS float*)(F.lds + TAB_ACUM);
    const int lane = F.lane, w = F.wave, q = lane & 15, g4 = lane >> 4;
    for (int u = F.vcu; u < 512; u += F.G) {
        const int b = u >> 6, c = (u >> 2) & 15, g = u & 3;
        ssd_tables(F, b, c, g);
        { const int ch = F.tid & 31, l0 = (F.tid >> 5) * 8; LAS unsigned char* img = ch >= 16 ? Cimg : Bimg;
          conv_rows<8>(P1, cw, cb, b, c * 128 + l0, 2048 + (ch >= 16 ? 512 : 0) + 128 * g + 8 * (ch & 15), [&](int r, const float (&v)[8]) { *(LAS v4u*)(img + (l0 + r) * SB_STR + (ch & 15) * 16) = pack8u(v, 1.f); }); }
        const int xch = F.tid & 63, xl0 = (F.tid >> 6) * 16;
        v4u x0[11]; conv_load<8>(P1, b, c * 128 + xl0, 512 * g + 8 * xch, x0);
        const int lq = 16 * w + q; const int tok = b * SEQ + c * 128 + lq;
        const bf16* pvb = PREV + ((size_t)((b * 16 + c) * 32 + 8 * g)) * 8192 + q * 128 + 8 * g4;
        const bf16* zb = P1 + (size_t)tok * P1C + C_Z + 512 * g + 4 * g4;
        asm volatile("s_waitcnt lgkmcnt(0)" ::: "memory"); __builtin_amdgcn_s_barrier(); asm volatile("" ::: "memory");
        bf16x8 cfr[4];
#pragma unroll
        for (int ks = 0; ks < 4; ++ks) cfr[ks] = *(const LAS bf16x8*)(Cimg + (16 * w + q) * SB_STR + (32 * ks + 8 * g4) * 2);
        f32x4 cbt[8];
#pragma unroll
        for (int st = 0; st < 8; ++st) { cbt[st] = (f32x4){0.f, 0.f, 0.f, 0.f};
            if (st <= w) {
#pragma unroll
                for (int ks = 0; ks < 4; ++ks) { const bf16x8 bfr = *(const LAS bf16x8*)(Bimg + (16 * st + q) * SB_STR + (32 * ks + 8 * g4) * 2); cbt[st] = MFMA16(bfr, cfr[ks], cbt[st]); } } }
        asm volatile("s_waitcnt lgkmcnt(0)" ::: "memory"); __builtin_amdgcn_s_barrier(); asm volatile("" ::: "memory");
        conv_apply<8>(x0, cw, cb, 512 * g + 8 * xch, [&](int r, const float (&v)[8]) { *(LAS v4u*)(Ximg + (xl0 + r) * SXF_STR + xch * 16) = pack8u(v, 1.f); });
        conv_rows<8>(P1, cw, cb, b, c * 128 + xl0 + 8, 512 * g + 8 * xch, [&](int r, const float (&v)[8]) { *(LAS v4u*)(Ximg + (xl0 + 8 + r) * SXF_STR + xch * 16) = pack8u(v, 1.f); });
        bf16x8 pfc[16]; v2u zc[4];
#pragma unroll
        for (int ks = 0; ks < 4; ++ks)
#pragma unroll
            for (int p4 = 0; p4 < 4; ++p4) pfc[ks * 4 + p4] = *(const GAS bf16x8*)(pvb + (16 * p4) * 128 + 32 * ks);
#pragma unroll
        for (int p4 = 0; p4 < 4; ++p4) zc[p4] = *(const GAS v2u*)(zb + 16 * p4);
        asm volatile("s_waitcnt lgkmcnt(0)" ::: "memory"); __builtin_amdgcn_s_barrier(); asm volatile("" ::: "memory");
        float ssq = 0.f;
#pragma unroll 1
        for (int hh = 0; hh < 8; ++hh) {
            const int h = 8 * g + hh; const float al = ac_s[hh * 128 + lq];
            const int hn = hh < 7 ? hh + 1 : 7;
            v2u zn[4];
#pragma unroll
            for (int p4 = 0; p4 < 4; ++p4) zn[p4] = *(const GAS v2u*)(zb + 64 * hn + 16 * p4);
            f32x4 y[4];
#pragma unroll
            for (int p4 = 0; p4 < 4; ++p4) y[p4] = (f32x4){0.f, 0.f, 0.f, 0.f};
#pragma unroll
            for (int ks = 0; ks < 4; ++ks)
#pragma unroll
                for (int p4 = 0; p4 < 4; ++p4) y[p4] = MFMA16(pfc[ks * 4 + p4], cfr[ks], y[p4]);
#pragma unroll
            for (int ks = 0; ks < 4; ++ks)
#pragma unroll
                for (int p4 = 0; p4 < 4; ++p4) pfc[ks * 4 + p4] = *(const GAS bf16x8*)(pvb + (size_t)hn * 8192 + (16 * p4) * 128 + 32 * ks);
            __builtin_amdgcn_sched_barrier(0);
            const float ea = __builtin_amdgcn_exp2f(al);
#pragma unroll
            for (int p4 = 0; p4 < 4; ++p4) y[p4] *= ea;
#pragma unroll
            for (int kk = 0; kk < 4; ++kk) {
                if (2 * kk <= w) {
                    f32x4 m0, m1;
                    { const int st = 2 * kk; const f32x4 as = *(const LAS f32x4*)(ac_s + hh * 128 + 16 * st + 4 * g4), ds = *(const LAS f32x4*)(dt_s + hh * 128 + 16 * st + 4 * g4);
#pragma unroll
                        for (int r = 0; r < 4; ++r) { const int s = 16 * st + 4 * g4 + r; m0[r] = s <= lq ? cbt[st][r] * __builtin_amdgcn_exp2f(al - as[r]) * ds[r] : 0.f; } }
                    { const int st = 2 * kk + 1; const f32x4 as = *(const LAS f32x4*)(ac_s + hh * 128 + 16 * st + 4 * g4), ds = *(const LAS f32x4*)(dt_s + hh * 128 + 16 * st + 4 * g4);
#pragma unroll
                        for (int r = 0; r < 4; ++r) { const int s = 16 * st + 4 * g4 + r; m1[r] = (st <= w && s <= lq) ? cbt[st][r] * __builtin_amdgcn_exp2f(al - as[r]) * ds[r] : 0.f; } }
                    const bf16x8 mf = pack8(m0, m1);
                    const LAS unsigned char* xb = Ximg + (32 * kk + 4 * g4 + (q >> 2)) * SXF_STR + (64 * hh + 4 * (q & 3)) * 2;
#pragma unroll
                    for (int p4 = 0; p4 < 4; ++p4) { const bf16x8 xf = cat8(tr_read(xb + p4 * 32), tr_read(xb + p4 * 32 + 16 * SXF_STR)); y[p4] = MFMA16(xf, mf, y[p4]); }
                }
            }
            const float Dh = F.in[I_DSKIP][h];
#pragma unroll
            for (int p4 = 0; p4 < 4; ++p4) { const int ch = 64 * hh + 16 * p4 + 4 * g4;
                const v2u xv = *(const LAS v2u*)(Ximg + lq * SXF_STR + ch * 2); const v2u zv = zc[p4];
                const float v0 = (y[p4][0] + bflo(xv.x) * Dh) * bflo(zv.x), v1 = (y[p4][1] + bfhi(xv.x) * Dh) * bfhi(zv.x), v2 = (y[p4][2] + bflo(xv.y) * Dh) * bflo(zv.y), v3 = (y[p4][3] + bfhi(xv.y) * Dh) * bfhi(zv.y);
                ssq += (v0 * v0 + v1 * v1) + (v2 * v2 + v3 * v3);
                if (FP8_G2) *(GAS unsigned*)((unsigned char*)ACAT + (size_t)tok * 3072 + 1024 + 512 * g + ch) = pg8::pk4_fp8(v0, v1, v2, v3);
                else { v2u o; o.x = cvt_pk_bf16(v0, v1); o.y = cvt_pk_bf16(v2, v3);
                    *(GAS v2u*)(ACAT + (size_t)tok * 3072 + 1024 + 512 * g + ch) = o; } }
#pragma unroll
            for (int p4 = 0; p4 < 4; ++p4) zc[p4] = zn[p4];
        }
        ssq += __shfl_xor(ssq, 16); ssq += __shfl_xor(ssq, 32);
        if (g4 == 0) ((float*)(F.ws + WS_SSQG))[(size_t)tok * 4 + g] = ssq;
        WG_BAR();
    }
}

constexpr int CX_STR = 528;
__device__ __forceinline__ void cross_units(Frame& F, int u_begin, int u_end, int u_step) {
    const bf16* QC = (const bf16*)(F.ws + WS_QC); const bf16* KVC = (const bf16*)(F.ws + WS_KVC); bf16* OC = (bf16*)(F.ws + WS_OC);
    LAS unsigned char* img = F.lds; const int lane = F.lane, w = F.wave, q = lane & 15, g = lane >> 4;
    for (int u = u_begin; u < u_end; u += u_step) {
        const int b = u >> 6, hd = (u >> 4) & 3, qb = u & 15; const int t0 = b * SEQ + qb * 128 + 16 * w;
#pragma unroll 1
        for (int pb = 0; pb < 2; ++pb) { v4u tmp[8];
#pragma unroll
            for (int i = 0; i < 8; ++i) { const int pc = F.tid + 512 * (pb * 8 + i), row = pc >> 5, ch = pc & 31; tmp[i] = *(const GAS v4u*)(KVC + (size_t)(b * 256 + row) * 2048 + hd * 256 + ch * 8); }
#pragma unroll
            for (int i = 0; i < 8; ++i) { const int pc = F.tid + 512 * (pb * 8 + i), row = pc >> 5, ch = pc & 31; *(LAS v4u*)(img + row * CX_STR + ch * 16) = tmp[i]; } }
        bf16x8 qf[8];
#pragma unroll
        for (int ks = 0; ks < 8; ++ks) qf[ks] = *(const GAS bf16x8*)(QC + (size_t)(t0 + q) * 1024 + hd * 256 + 32 * ks + 8 * g);
        WG_BAR();
        f32x4 s[16];
#pragma unroll
        for (int kt = 0; kt < 16; ++kt) { s[kt] = (f32x4){0.f, 0.f, 0.f, 0.f};
#pragma unroll
            for (int ks = 0; ks < 8; ++ks) { const bf16x8 kf = *(const LAS bf16x8*)(img + (16 * kt + q) * CX_STR + (32 * ks + 8 * g) * 2); s[kt] = MFMA16(kf, qf[ks], s[kt]); } }
        float mx = -INFINITY;
#pragma unroll
        for (int kt = 0; kt < 16; ++kt)
#pragma unroll
            for (int r = 0; r < 4; ++r) { s[kt][r] *= 0.0625f * LOG2E; mx = fmaxf(mx, s[kt][r]); }
        mx = fmaxf(mx, __shfl_xor(mx, 16)); mx = fmaxf(mx, __shfl_xor(mx, 32));
        float sum = 0.f;
#pragma unroll
        for (int kt = 0; kt < 16; ++kt)
#pragma unroll
            for (int r = 0; r < 4; ++r) { const float p = __builtin_amdgcn_exp2f(s[kt][r] - mx); s[kt][r] = p; sum += p; }
        sum += __shfl_xor(sum, 16); sum += __shfl_xor(sum, 32);
        const float inv = 1.f / sum;
        bf16x8 pf[8];
#pragma unroll
        for (int kk = 0; kk < 8; ++kk) pf[kk] = pack8(s[2 * kk], s[2 * kk + 1]);
        WG_BAR();
#pragma unroll 1
        for (int pb = 0; pb < 2; ++pb) { v4u tmp[8];
#pragma unroll
            for (int i = 0; i < 8; ++i) { const int pc = F.tid + 512 * (pb * 8 + i), row = pc >> 5, ch = pc & 31; tmp[i] = *(const GAS v4u*)(KVC + (size_t)(b * 256 + row) * 2048 + 1024 + hd * 256 + ch * 8); }
#pragma unroll
            for (int i = 0; i < 8; ++i) { const int pc = F.tid + 512 * (pb * 8 + i), row = pc >> 5, ch = pc & 31; *(LAS v4u*)(img + row * CX_STR + ch * 16) = tmp[i]; } }
        WG_BAR();
#pragma unroll 1
        for (int dh = 0; dh < 2; ++dh) {
            f32x4 o[8];
#pragma unroll
            for (int d = 0; d < 8; ++d) o[d] = (f32x4){0.f, 0.f, 0.f, 0.f};
#pragma unroll
            for (int kk = 0; kk < 8; ++kk) { const LAS unsigned char* vb = img + (32 * kk + 4 * g + (q >> 2)) * CX_STR + (128 * dh + 4 * (q & 3)) * 2;
#pragma unroll
                for (int d = 0; d < 8; ++d) { const bf16x8 vf = cat8(tr_read(vb + d * 32), tr_read(vb + d * 32 + 16 * CX_STR)); o[d] = MFMA16(vf, pf[kk], o[d]); } }
#pragma unroll
            for (int d = 0; d < 8; ++d) {
                if (FP8_G6) *(GAS unsigned*)((unsigned char*)OC + (size_t)(t0 + q) * 1024 + hd * 256 + 128 * dh + 16 * d + 4 * g) = pg8::pk4_fp8(o[d][0] * inv, o[d][1] * inv, o[d][2] * inv, o[d][3] * inv);
                else { v2u wv; wv.x = cvt_pk_bf16(o[d][0] * inv, o[d][1] * inv); wv.y = cvt_pk_bf16(o[d][2] * inv, o[d][3] * inv);
                    *(GAS v2u*)(OC + (size_t)(t0 + q) * 1024 + hd * 256 + 128 * dh + 16 * d + 4 * g) = wv; } }
        }
        WG_BAR();
    }
}

__device__ __forceinline__ void router_phase(Frame& F) {
    const bf16* T = (const bf16*)(F.ws + WS_T); const bf16* WR = (const bf16*)(F.ws + WS_WR); const float* ssq = (const float*)(F.ws + WS_SSQ2);
    int* tok_e = (int*)(F.ws + WS_TOKE); int* tok_p = (int*)(F.ws + WS_TOKP); float* tok_w = (float*)(F.ws + WS_TOKW); int* rowmap = (int*)(F.ws + WS_ROWMAP);
    LAS int* hist = (LAS int*)(F.lds + TAB_TE); LAS int* base = hist + 32;
    const int lane = F.lane, q = lane & 15, g = lane >> 4;
    for (int tb = F.vcu; tb * 4 < M_TOK / 16; tb += F.G) {
        if (F.tid < 32) hist[F.tid] = 0;
        __syncthreads();
        const int tile = tb * 4 + F.wave; const bool live = F.wave < 4;
        int ei[4] = {0, 0, 0, 0}, lp[4] = {0, 0, 0, 0}; float wv[4] = {0.f, 0.f, 0.f, 0.f}; float rs = 0.f; const int t0 = tile * 16;
        if (live) {
            f32x4 a0 = (f32x4){0.f, 0.f, 0.f, 0.f}, a1 = a0;
#pragma unroll 8
            for (int ks = 0; ks < 32; ++ks) { const bf16x8 tf = *(const GAS bf16x8*)(T + (size_t)(t0 + q) * 1024 + 32 * ks + 8 * g);
                const bf16x8 w0 = *(const GAS bf16x8*)(WR + (size_t)q * 1024 + 32 * ks + 8 * g), w1 = *(const GAS bf16x8*)(WR + (size_t)(16 + q) * 1024 + 32 * ks + 8 * g);
                a0 = MFMA16(w0, tf, a0); a1 = MFMA16(w1, tf, a1); }
            rs = pg8::row_rstd(ssq, t0 + q); const float* br = F.in[I_BR];
            float lv[8];
#pragma unroll
            for (int r = 0; r < 4; ++r) { lv[r] = a0[r] * rs + br[4 * g + r]; lv[4 + r] = a1[r] * rs + br[16 + 4 * g + r]; }
            float ev[4];
#pragma unroll
            for (int k = 0; k < 4; ++k) {
                float bv = -INFINITY; int bi = 0;
#pragma unroll
                for (int r = 0; r < 8; ++r) { const int e = (r < 4 ? 0 : 16) + 4 * g + (r & 3); if (lv[r] > bv) { bv = lv[r]; bi = e; } }
#pragma unroll
                for (int o = 16; o <= 32; o <<= 1) { const float ov = __shfl_xor(bv, o); const int oi = __shfl_xor(bi, o); if (ov > bv || (ov == bv && oi < bi)) { bv = ov; bi = oi; } }
                ei[k] = bi; ev[k] = bv;
#pragma unroll
                for (int r = 0; r < 8; ++r) { const int e = (r < 4 ? 0 : 16) + 4 * g + (r & 3); if (e == bi) lv[r] = -INFINITY; }
            }
            float sum = 0.f;
#pragma unroll
            for (int k = 0; k < 4; ++k) { wv[k] = expf(ev[k] - ev[0]); sum += wv[k]; }
            const float inv = 1.f / sum;
#pragma unroll
            for (int k = 0; k < 4; ++k) wv[k] *= inv;
            if (g == 0) {
#pragma unroll
                for (int k = 0; k < 4; ++k) lp[k] = __hip_atomic_fetch_add(hist + ei[k], 1, __ATOMIC_RELAXED, __HIP_MEMORY_SCOPE_WORKGROUP); }
        }
        __syncthreads();
        if (F.tid < 32) { const int hcnt = hist[F.tid]; base[F.tid] = hcnt > 0 ? (int)__hip_atomic_fetch_add((unsigned*)(F.ctl + CW_CNT + 64 * F.tid), (unsigned)hcnt, RLX_AGENT) : 0; }
        __syncthreads();
        if (live && g == 0) { const int tok = t0 + q;
#pragma unroll
            for (int k = 0; k < 4; ++k) { const int pos = base[ei[k]] + lp[k];
                *(int2*)(rowmap + 2 * (ei[k] * 16384 + pos)) = make_int2(tok, __float_as_int(rs)); tok_e[tok * 4 + k] = ei[k]; tok_p[tok * 4 + k] = pos; tok_w[tok * 4 + k] = wv[k]; } }
        __syncthreads();
    }
}
__device__ __forceinline__ int moe_tables(Frame& F) {
    LAS int* tile_e = (LAS int*)(F.lds + TAB_TE); LAS int* tile_p0 = (LAS int*)(F.lds + TAB_TP0); LAS int* cnt_s = (LAS int*)(F.lds + TAB_CNT); LAS int* tb = (LAS int*)(F.lds + TAB_TB); LAS int* ntp = (LAS int*)(F.lds + TAB_NT);
    __syncthreads();
    if (F.tid < 32) cnt_s[F.tid] = (int)__hip_atomic_load((unsigned*)(F.ctl + CW_CNT + 64 * F.tid), RLX_AGENT);
    __syncthreads();
    if (F.tid == 0) { int j = 0; for (int e = 0; e < 32; ++e) { tb[e] = j; const int c = cnt_s[e]; for (int p = 0; p < c && j < 320; p += 256) { tile_e[j] = e; tile_p0[j] = p; ++j; } } ntp[0] = j; }
    __syncthreads();
    return ntp[0];
}
__device__ __forceinline__ void combine_phase(Frame& F) {
    const bf16* H2 = (const bf16*)(F.ws + WS_H2); const unsigned char* Y = (const unsigned char*)(F.ws + WS_Y);
    const int* tok_e = (const int*)(F.ws + WS_TOKE); const int* tok_p = (const int*)(F.ws + WS_TOKP); const float* tok_w = (const float*)(F.ws + WS_TOKW);
    LAS int* tb = (LAS int*)(F.lds + TAB_TB); const float* fw = F.in[I_FNW];
    const int lane = F.lane; const int gw = F.vcu * NWAVES + F.wave, NGW = F.G * NWAVES;
    constexpr int NT = 4;
    for (int tok0 = NT * gw; tok0 < M_TOK; tok0 += NT * NGW) {
        f32x4 v[NT][4]; size_t slot[NT][4]; float wk[NT][4];
#pragma unroll
        for (int t = 0; t < NT; ++t)
#pragma unroll
            for (int k = 0; k < 4; ++k) { const int tok = tok0 + t; const int e = tok_e[tok * 4 + k]; slot[t][k] = (size_t)tb[e] * 256 + tok_p[tok * 4 + k]; wk[t][k] = tok_w[tok * 4 + k]; }
        v2u hv[NT][4]; unsigned y[NT][4][4];
#pragma unroll
        for (int t = 0; t < NT; ++t)
#pragma unroll
            for (int j = 0; j < 4; ++j) hv[t][j] = *(const GAS v2u*)(H2 + (size_t)(tok0 + t) * 1024 + 4 * lane + 256 * j);
#pragma unroll
        for (int t = 0; t < NT; ++t)
#pragma unroll
            for (int k = 0; k < 4; ++k)
#pragma unroll
                for (int j = 0; j < 4; ++j) y[t][k][j] = *(const GAS unsigned*)(Y + slot[t][k] * 1024 + 4 * lane + 256 * j);
#pragma unroll
        for (int t = 0; t < NT; ++t) {
#pragma unroll
            for (int j = 0; j < 4; ++j) v[t][j] = (f32x4){bflo(hv[t][j].x), bfhi(hv[t][j].x), bflo(hv[t][j].y), bfhi(hv[t][j].y)};
#pragma unroll
            for (int k = 0; k < 4; ++k)
#pragma unroll
                for (int j = 0; j < 4; ++j) { const f32x2 lo = __builtin_amdgcn_cvt_pk_f32_fp8((int)y[t][k][j], false), hi = __builtin_amdgcn_cvt_pk_f32_fp8((int)y[t][k][j], true);
                    v[t][j][0] += wk[t][k] * lo[0]; v[t][j][1] += wk[t][k] * lo[1]; v[t][j][2] += wk[t][k] * hi[0]; v[t][j][3] += wk[t][k] * hi[1]; } }
#pragma unroll
        for (int t = 0; t < NT; ++t) { float s = 0.f;
#pragma unroll
            for (int j = 0; j < 4; ++j) s += (v[t][j][0] * v[t][j][0] + v[t][j][1] * v[t][j][1]) + (v[t][j][2] * v[t][j][2] + v[t][j][3] * v[t][j][3]);
            const float rstd = 1.f / sqrtf(wave_sum(s) * (1.f / 1024.f) + 1e-5f);
#pragma unroll
            for (int j = 0; j < 4; ++j) { const f32x4 g = *(const f32x4*)(fw + 4 * lane + 256 * j); *(GAS f32x4*)(F.out + (size_t)(tok0 + t) * 1024 + 4 * lane + 256 * j) = v[t][j] * rstd * g; } }
    }
}
#ifndef MK_NPH
#define MK_NPH 14
#endif
struct Args { const float* in[29]; float* out; unsigned char* ws; int ph_lo, ph_hi; };
__global__ void __launch_bounds__(NWAVES * 64, 2) mega_fwd(Args args) {
    extern __shared__ __attribute__((aligned(16))) unsigned char lds_raw[];
    Frame F;
    F.lds = (LAS unsigned char*)lds_raw;
    F.tid = threadIdx.x; F.lane = F.tid & 63; F.wave = __builtin_amdgcn_readfirstlane(F.tid >> 6);
    F.G = gridDim.x; { const int bx = blockIdx.x; F.vcu = (F.G % 8 == 0) ? (bx % 8) * (F.G / 8) + bx / 8 : bx; }
    F.ws = args.ws; F.ctl = (gu32*)(args.ws + WS_CTL); F.out = args.out;
    F.in = (const __attribute__((address_space(4))) fptr_t*)__builtin_amdgcn_kernarg_segment_ptr();
    for (int u = F.tid; u < (LDS_BYTES - TAB_OFF) / 4; u += NWAVES * 64) ((LAS unsigned*)(F.lds + TAB_OFF))[u] = 0u;
    __syncthreads();
    const int lo = args.ph_lo, hi = args.ph_hi;
    XcdBarrier bar; bar.bar = (unsigned*)(F.ctl + CW_BAR); bar.x = 0; bar.st = nullptr;
    if (hi - lo > 1) bar = xcd_barrier_post((unsigned*)(F.ctl + CW_BAR), (volatile LAS unsigned*)(F.lds + TAB_MISC) + 8);
#ifndef MK_PHMASK
#define MK_PHMASK 0x3fff
#endif
#define IN(k) (((MK_PHMASK >> (k)) & 1) && lo <= (k) && (k) < hi)
#define SEAM(k) do { if (IN(k) && IN((k) + 1)) xcd_barrier(bar); } while (0)
    const int c = (int)blockIdx.x;

    if (IN(0)) { p0_prologue(F); } SEAM(0);
    if (IN(1)) {
        { constexpr int ES = I8_G1 ? 1 : 2; typedef pg8::EpiP1<I8_G1 != 0> EpiT;
          pg8::SchedLin S{M_TOK / 256, N1 / 256, F.G, c, DM, (const bf16*)(F.ws + WS_W1T), DM, ES};
          EpiT E{(bf16*)(F.ws + WS_P1), P1C, (float*)(F.ws + WS_DT), F.in[I_BGATE], (const float*)(F.ws + WS_USC), (const float*)(F.ws + WS_CSC)};
          pg8::gemm_phase<EpiT, pg8::SchedLin, true, ES, I8_G1 != 0>(F.lds, (const char*)(F.ws + WS_U), DM, S, E); }
        if (I8_G1) { pg8::SchedLin S{NBATCH * 256 / 256, 2048 / 256, F.G, (c + 128) % F.G, DM, (const bf16*)(F.ws + WS_WCKV), DM, 1};
          pg8::EpiI8 E{(bf16*)(F.ws + WS_KVC), 2048, (const float*)(F.ws + WS_MSC), (const float*)(F.ws + WS_KSC)};
          pg8::gemm_phase<pg8::EpiI8, pg8::SchedLin, true, 1, true>(F.lds, (const char*)(F.ws + WS_MN), DM, S, E); }
        else { pg8::SchedLin S{NBATCH * 256 / 256, 2048 / 256, F.G, (c + 128) % F.G, DM, (const bf16*)(F.ws + WS_WCKV), DM};
          pg8::EpiBf16S E{(bf16*)(F.ws + WS_KVC), 2048, nullptr, 1.f};
          pg8::gemm_phase<pg8::EpiBf16S, pg8::SchedLin, true>(F.lds, (const char*)(F.ws + WS_MN), DM, S, E); }
    } SEAM(1);
    if (IN(2)) { swa_phase(F); ssd_states_phase(F); } SEAM(2);
    if (IN(3)) { ssd_scan_phase(F); } SEAM(3);
    if (IN(4)) { ssd_out_phase(F); } SEAM(4);
    if (IN(5)) {
        constexpr int ES = FP8_G2 ? 1 : 2; typedef pg8::EpiG2<ES, FP8_G3 != 0> EpiT;
        pg8::SchedLin S{M_TOK / 256, 1024 / 256, F.G, c, 3072, (const bf16*)(F.ws + WS_WCAT), 3072, ES};
        EpiT E{(const bf16*)(F.ws + WS_P1) + C_G, P1C, (void*)(F.ws + WS_MERGED), DM, (const float*)(F.ws + WS_SSQG), FP8_G2 ? 1.f / pg8::W8_SCALE : 1.f, (LAS float*)(F.lds + TAB_OFF + 1024)};
        pg8::gemm_phase<EpiT, pg8::SchedLin, false, ES>(F.lds, (const char*)(F.ws + WS_ACAT), 3072, S, E);
    } SEAM(5);
    if (IN(6)) {
        constexpr int ES = FP8_G3 ? 1 : 2;
        pg8::SchedLin S{M_TOK / 256, 4, F.G, c, DM, (const bf16*)(F.ws + WS_WOUT), DM, ES};
        pg8::EpiRes<false> E{(const void*)F.in[I_X], (bf16*)(F.ws + WS_H1), FP8_G4 ? nullptr : (bf16*)(F.ws + WS_HB), F.in[I_NCW], (float*)(F.ws + WS_SSQ1), FP8_G4 ? (unsigned char*)(F.ws + WS_HB) : nullptr, FP8_G3 ? 1.f / pg8::W8_SCALE : 1.f};
        pg8::gemm_phase<pg8::EpiRes<false>, pg8::SchedLin, false, ES>(F.lds, (const char*)(F.ws + WS_MERGED), DM, S, E);
    } SEAM(6);
    if (IN(7)) {
        constexpr int ES = FP8_G4 ? 1 : 2;
        pg8::SchedLin S{M_TOK / 256, 4, F.G, c, DM, (const bf16*)(F.ws + WS_WCQ), DM, ES};
        pg8::EpiBf16S E{(bf16*)(F.ws + WS_QC), DM, (const float*)(F.ws + WS_SSQ1), FP8_G4 ? 1.f / pg8::W8_SCALE : 1.f};
        pg8::gemm_phase<pg8::EpiBf16S, pg8::SchedLin, false, ES>(F.lds, (const char*)(F.ws + WS_HB), DM, S, E);
        VM_WAIT(); __syncthreads();
        for (int i = 0;; ++i) { int pm, pn; if (!pg8::static_deal(i, F.G, c, M_TOK / 256, 4, pm, pn)) break;
            const int ua = (pm >> 3) * 64 + pn * 16 + 2 * (pm & 7); cross_units(F, ua, ua + 2, 1); }
    } SEAM(7);
    if (IN(9)) {
        constexpr int ES = FP8_G6 ? 1 : 2;
        pg8::SchedLin S{M_TOK / 256, 4, F.G, c, DM, (const bf16*)(F.ws + WS_WCO), DM, ES};
        pg8::EpiRes<true> E{(const void*)(F.ws + WS_H1), (bf16*)(F.ws + WS_H2), (bf16*)(F.ws + WS_T), F.in[I_NFW], (float*)(F.ws + WS_SSQ2), (unsigned char*)(F.ws + WS_T8), FP8_G6 ? 1.f / pg8::W8_SCALE : 1.f};
        pg8::gemm_phase<pg8::EpiRes<true>, pg8::SchedLin, false, ES>(F.lds, (const char*)(F.ws + WS_OC), DM, S, E);
    } SEAM(9);
    if (IN(10)) { router_phase(F); } SEAM(10);
    if (IN(11)) {
        const int nt = moe_tables(F);
        pg8::SchedMoe S{nt, 8, F.G, c, DM, (const void*)(F.ws + WS_WGU), DM, (size_t)2048 * 1024, true, 1,
                        (const LAS int*)(F.lds + TAB_TE), (const LAS int*)(F.lds + TAB_TP0), (const LAS int*)(F.lds + TAB_CNT), (const int*)(F.ws + WS_ROWMAP)};
        pg8::EpiGU E{(unsigned char*)(F.ws + WS_ACT), F.in[I_BGU], (const int*)(F.ws + WS_ROWMAP), (const LAS int*)(F.lds + TAB_CNT)};
        pg8::gemm_phase<pg8::EpiGU, pg8::SchedMoe, true, 1>(F.lds, (const char*)(F.ws + WS_T8), DM, S, E);
    } SEAM(11);
    if (IN(12)) {
        const int nt = moe_tables(F);
        pg8::SchedMoe S{nt, 4, F.G, c, DM, (const void*)(F.ws + WS_WDN), DM, (size_t)1024 * 1024, false, 1,
                        (const LAS int*)(F.lds + TAB_TE), (const LAS int*)(F.lds + TAB_TP0), (const LAS int*)(F.lds + TAB_CNT), (const int*)(F.ws + WS_ROWMAP)};
        pg8::EpiDN E{(unsigned char*)(F.ws + WS_Y), F.in[I_BDN]};
        pg8::gemm_phase<pg8::EpiDN, pg8::SchedMoe, true, 1>(F.lds, (const char*)(F.ws + WS_ACT), DM, S, E);
    } SEAM(12);
    if (IN(13)) { (void)moe_tables(F); combine_phase(F); }
#undef IN
#undef SEAM
}

static int mega_grid() {
    static int grid = 0;
    if (grid == 0) {
        int dev = 0, cus = 0;
        if (hipGetDevice(&dev) != hipSuccess || hipDeviceGetAttribute(&cus, hipDeviceAttributeMultiprocessorCount, dev) != hipSuccess) { grid = -1; return grid; }
        if (hipFuncSetAttribute((const void*)mega_fwd, hipFuncAttributeMaxDynamicSharedMemorySize, LDS_BYTES) != hipSuccess) { fprintf(stderr, "hipFuncSetAttribute failed\n"); grid = -1; return grid; }
        int per_cu = 0;
        if (hipOccupancyMaxActiveBlocksPerMultiprocessor(&per_cu, (const void*)mega_fwd, NWAVES * 64, LDS_BYTES) != hipSuccess || per_cu < 1) { fprintf(stderr, "occupancy query: %d\n", per_cu); (void)hipGetLastError(); grid = -1; return grid; }
        grid = cus;
    }
    return grid;
}
static void mega_launch(hipStream_t stream, void* const* d_in, void* d_out, void* d_ws, int lo, int hi) {
    const int grid = mega_grid(); if (grid <= 0) return;
    Args a{}; for (int i = 0; i < 29; ++i) a.in[i] = (const float*)d_in[i];
    a.out = (float*)d_out; a.ws = (unsigned char*)d_ws; a.ph_lo = lo; a.ph_hi = hi;
    hipLaunchKernelGGL(mega_fwd, dim3(grid), dim3(NWAVES * 64), LDS_BYTES, stream, a);
}
#ifndef HYB
#define HYB 6
#endif
#ifndef MK_ONE_LAUNCH
#define MK_ONE_LAUNCH 0
#endif
extern "C" void kernel_launch(void* const* d_in, const int* in_sizes, int n_in, void* d_out, int out_size, void* d_ws, size_t ws_size, hipStream_t stream) {
    if (n_in != 29 || ws_size < ((size_t)1000 << 20) || out_size != M_TOK * DM) { fprintf(stderr, "kernel_launch: unexpected n_in %d / ws %zu / out %d\n", n_in, ws_size, out_size); return; }
    if (hipMemsetAsync((char*)d_ws + WS_CTL, 0, CTL_ZERO_BYTES, stream) != hipSuccess) return;
    constexpr int nph = HYB == 1 ? 2 : HYB == 2 ? 5 : HYB == 3 ? 6 : HYB == 4 ? 7 : HYB == 5 ? 10 : 14;
#if MK_ONE_LAUNCH
    mega_launch(stream, d_in, d_out, d_ws, 0, nph);
#else
    for (int p = 0; p < nph; ++p) { if (p == 8) continue;
        mega_launch(stream, d_in, d_out, d_ws, p, p + 1);
#ifdef MK_REPEAT
        if (p == MK_REPEAT) { if (p == 10) (void)hipMemsetAsync((char*)d_ws + WS_CTL + CW_CNT * 4, 0, 32 * 64 * 4, stream); mega_launch(stream, d_in, d_out, d_ws, p, p + 1); }
#endif
    }
#endif
#if HYB < 6
    nv::In in; const float** ip = (const float**)&in; for (int i = 0; i < 29; ++i) ip[i] = (const float*)d_in[i];
    unsigned char* ws = (unsigned char*)d_ws; float* nb = (float*)(ws + WS_NAIVE);
    for (int b = 0; b < 8; ++b) {
        const size_t r0 = (size_t)b * 2048;
        auto cvt = [&](const unsigned short* src, int sp, float* dst, int dp, int cols) { hipLaunchKernelGGL(nv::k_bf16_to_f32, dim3((2048 * cols + 255) / 256), dim3(256), 0, stream, src, sp, dst, dp, 2048, cols); };
        auto cpy = [&](const float* src, int sp, float* dst, int dp, int cols) { hipLaunchKernelGGL(nv::k_copy_f32, dim3((2048 * cols + 255) / 256), dim3(256), 0, stream, src, sp, dst, dp, 2048, cols); };
        const unsigned short* P1 = (const unsigned short*)(ws + WS_P1) + r0 * P1C;
#if HYB == 1
        cvt(P1, P1C, nb + nv::B_PROJ, 6432, 6400); cpy((const float*)(ws + WS_DT) + r0 * 32, 32, nb + nv::B_PROJ + 6400, 6432, 32); cvt(P1 + C_G, P1C, nb + nv::B_GATES, 2048, 2048);
#elif HYB == 2
        cvt((const unsigned short*)(ws + WS_ACAT) + r0 * 3072, 3072, nb + nv::B_U, 1024, 1024); hipLaunchKernelGGL(nv::k_ssm_unnorm_to_f32, dim3(2048 * 2048 / 256), dim3(256), 0, stream, (const unsigned short*)(ws + WS_ACAT) + r0 * 3072, (const float*)(ws + WS_SSQG) + r0 * 4, nb + nv::B_Y, 2048); cvt(P1 + C_G, P1C, nb + nv::B_GATES, 2048, 2048);
#elif HYB == 3
        cvt((const unsigned short*)(ws + WS_MERGED) + r0 * 1024, 1024, nb + nv::B_T1, 1024, 1024);
#elif HYB == 4
        cvt((const unsigned short*)(ws + WS_H1) + r0 * 1024, 1024, nb + nv::B_H1, 1024, 1024);
#elif HYB == 5
        cvt((const unsigned short*)(ws + WS_H2) + r0 * 1024, 1024, nb + nv::B_H2, 1024, 1024);
#endif
        nv::forward_batch(stream, in, nb, b, (float*)d_out, HYB);
    }
#endif
}
```

```cpp
#define HYB 6
#define MK_ONE_LAUNCH 1
#include <hip/hip_runtime.h>
#include <cstdio>
#include <cstdint>
#define GAS __attribute__((address_space(1)))
#define LAS __attribute__((address_space(3)))
typedef unsigned short bf16;
typedef unsigned v4u __attribute__((ext_vector_type(4)));
typedef unsigned v2u __attribute__((ext_vector_type(2)));
typedef float f32x4 __attribute__((ext_vector_type(4)));
typedef float f32x2 __attribute__((ext_vector_type(2)));
typedef short bf16x8 __attribute__((ext_vector_type(8)));
typedef short s16x4 __attribute__((ext_vector_type(4)));
typedef GAS unsigned gu32;
#define RLX_AGENT __ATOMIC_RELAXED, __HIP_MEMORY_SCOPE_AGENT
#define LDS_WAIT() asm volatile("s_waitcnt lgkmcnt(0)" ::: "memory")
#define VM_WAIT() asm volatile("s_waitcnt vmcnt(0)" ::: "memory")
__device__ __forceinline__ unsigned f2bf(float f) { unsigned u = __builtin_bit_cast(unsigned, f); return (u + 0x7fffu + ((u >> 16) & 1u)) >> 16; }
__device__ __forceinline__ unsigned pk2(float lo, float hi) { return f2bf(lo) | (f2bf(hi) << 16); }
__device__ __forceinline__ float bf2f(unsigned short b) { return __uint_as_float((unsigned)b << 16); }
__device__ __forceinline__ float bflo(unsigned w) { return __uint_as_float(w << 16); }
__device__ __forceinline__ float bfhi(unsigned w) { return __uint_as_float(w & 0xffff0000u); }
typedef __bf16 bf16x2_t __attribute__((ext_vector_type(2)));
__device__ __forceinline__ unsigned cvt_pk_bf16(float lo, float hi) { const f32x2 v = {lo, hi}; const bf16x2_t b = __builtin_convertvector(v, bf16x2_t); return __builtin_bit_cast(unsigned, b); }
__device__ __forceinline__ float wave_sum(float v) {
#pragma unroll
    for (int o = 1; o < 64; o <<= 1) v += __shfl_xor(v, o);
    return v;
}
#define XB_TMO      128
#define XB_XCNT(j)  (256  + 64 * (j))
#define XB_XSUB(j)  (1280 + 64 * (j))
#define XB_XGEN(j)  (2304 + 64 * (j))
#define XB_TOP      3328
#define XB_TOPGEN   3392
#define XCD_BAR_WORDS 3456
#define XB_SPIN_CAP (1u << 18)

__device__ __forceinline__ unsigned xb_ld(unsigned* p)              { return __hip_atomic_load(p, __ATOMIC_RELAXED, __HIP_MEMORY_SCOPE_AGENT); }
__device__ __forceinline__ unsigned xb_add(unsigned* p, unsigned v) { return __hip_atomic_fetch_add(p, v, __ATOMIC_RELAXED, __HIP_MEMORY_SCOPE_AGENT); }
__device__ __forceinline__ unsigned xb_xcc_id() { return (unsigned)__builtin_amdgcn_s_getreg((3 << 11) | 20) & 0xFu; }
#define XB_SPIN(cond, bar) do { unsigned _sp = 0; while (cond) { __builtin_amdgcn_s_sleep(1); \
    if ((++_sp & 255u) == 0u) { if (xb_ld(&(bar)[XB_TMO])) break; if (_sp > XB_SPIN_CAP) { atomicAdd(&(bar)[XB_TMO], 1u); break; } } } } while (0)

struct XcdBarrier {
    unsigned* bar; unsigned x;
    volatile LAS unsigned* st;
};

__device__ __forceinline__ XcdBarrier xcd_barrier_post(unsigned* bar, volatile LAS unsigned* st) {
    XcdBarrier b; b.bar = bar; b.x = xb_xcc_id(); b.st = st;
    if (threadIdx.x == 0) (void)xb_add(&bar[XB_XCNT(b.x)], 1u);
    return b;
}
__device__ __forceinline__ void xcd_barrier_complete(unsigned* bar, unsigned x, unsigned& nloc, unsigned& nx) {
    const unsigned G = gridDim.x * gridDim.y * gridDim.z;
    unsigned sum, cnt, mine, sp = 0u;
    for (;;) {
        sum = 0u; cnt = 0u; mine = 0u;
#pragma unroll
        for (unsigned j = 0; j < 16; ++j) { const unsigned c = xb_ld(&bar[XB_XCNT(j)]); sum += c; cnt += (c > 0u) ? 1u : 0u; mine = (j == x) ? c : mine; }
        if (sum == G) break;
        __builtin_amdgcn_s_sleep(1);
        if ((++sp & 255u) == 0u) { if (xb_ld(&bar[XB_TMO])) break; if (sp > XB_SPIN_CAP) { atomicAdd(&bar[XB_TMO], 1u); break; } }
    }
    nloc = mine > 0u ? mine : 1u; nx = cnt > 0u ? cnt : 1u;
}

__device__ __forceinline__ void xcd_barrier(const XcdBarrier& b) {
    asm volatile("s_waitcnt vmcnt(0)" ::: "memory");
    __syncthreads();
    if (threadIdx.x == 0) {
        unsigned* bar = b.bar;
        __builtin_amdgcn_s_waitcnt(0);
        unsigned nloc = b.st[0], nx = b.st[1];
        if (nloc == 0u) { xcd_barrier_complete(bar, b.x, nloc, nx); b.st[0] = nloc; b.st[1] = nx; }
        const unsigned old = xb_add(&bar[XB_XSUB(b.x)], 1u);
        const unsigned gen = old / nloc;
        if (old + 1u == (gen + 1u) * nloc) {
            __builtin_amdgcn_fence(__ATOMIC_RELEASE, "agent");
            asm volatile("s_waitcnt vmcnt(0)" ::: "memory");
            const unsigned og = xb_add(&bar[XB_TOP], 1u);
            const unsigned tg = og / nx;
            if (og + 1u == (tg + 1u) * nx) xb_add(&bar[XB_TOPGEN], 1u);
            else XB_SPIN(xb_ld(&bar[XB_TOPGEN]) == tg, bar);
            __builtin_amdgcn_fence(__ATOMIC_ACQUIRE, "agent");
            xb_add(&bar[XB_XGEN(b.x)], 1u);
            asm volatile("s_waitcnt vmcnt(0)" ::: "memory");
        } else {
            XB_SPIN(xb_ld(&bar[XB_XGEN(b.x)]) == gen, bar);
            __builtin_amdgcn_fence(__ATOMIC_ACQUIRE, "agent");
            asm volatile("s_waitcnt vmcnt(0)" ::: "memory");
        }
    }
    __syncthreads();
}
namespace pg8 {
constexpr int BM = 256, BK = 64, HALF = 128, HTB = HALF * BK * 2  , STAGE_BYTES = 8 * HTB, NXCD = 8, WGM = 8;
__host__ __device__ __forceinline__ int lds_byte(int r, int c) { const int st = (r >> 4) * 2 + (c >> 5), rr = r & 15, cc = c & 31, ob = rr * 64 + cc * 2; return st * 1024 + (ob ^ (((ob >> 9) & 1) << 5)); }
__host__ __device__ __forceinline__ void stage_rc(int b, int& R, int& C) { const int st = b / 1024, sb = b % 1024, swz = sb ^ (((sb >> 9) & 1) << 5); R = (st >> 1) * 16 + swz / 64; C = (st & 1) * 32 + (swz % 64) / 2; }
__host__ __device__ __forceinline__ int perm32(int rho) { const int n = rho >> 4, i = rho & 15; return 8 * (i >> 2) + 4 * n + (i & 3); }

struct Unit { int pm, pn, e, p0; };
typedef int v8i __attribute__((ext_vector_type(8))); typedef int v4i __attribute__((ext_vector_type(4)));
__device__ __forceinline__ v8i cat_frag(bf16x8 a, bf16x8 b) { const v4i x = __builtin_bit_cast(v4i, a), y = __builtin_bit_cast(v4i, b); return (v8i){x[0], x[1], x[2], x[3], y[0], y[1], y[2], y[3]}; }
__device__ __forceinline__ unsigned pk4_fp8(float a, float b, float c, float d) {
    a = __builtin_amdgcn_fmed3f(a, -448.f, 448.f); b = __builtin_amdgcn_fmed3f(b, -448.f, 448.f); c = __builtin_amdgcn_fmed3f(c, -448.f, 448.f); d = __builtin_amdgcn_fmed3f(d, -448.f, 448.f);
    int w = 0; w = __builtin_amdgcn_cvt_pk_fp8_f32(a, b, w, false); w = __builtin_amdgcn_cvt_pk_fp8_f32(c, d, w, true); return (unsigned)w; }
constexpr float W8_SCALE = 32.f;

__device__ __forceinline__ bool static_deal(int i, int G, int c, int nM, int nN, int& pm, int& pn) {
    const int nwg = nM * nN; const long L = (long)i * G + c; if (L >= nwg) return false;
    int wgid = (int)L; { const int q = nwg / NXCD, r = nwg % NXCD, xcd = wgid % NXCD, off = wgid / NXCD; wgid = (xcd < r ? xcd * (q + 1) : r * (q + 1) + (xcd - r) * q) + off; }
    const int nig = WGM * nN, gid = wgid / nig, fm = gid * WGM, gsz = (nM - fm) < WGM ? (nM - fm) : WGM;
    pm = fm + ((wgid % nig) % gsz); pn = (wgid % nig) / gsz; return true;
}
struct SchedLin {
    int nM, nN, G, c, lda; const bf16* Bt; int K; int es = 2;
    __device__ __forceinline__ bool next(int i, Unit& u) const { u.e = 0; u.p0 = 0; return static_deal(i, G, c, nM, nN, u.pm, u.pn); }
    __device__ __forceinline__ void a_fetch(const Unit& u, int (&raw)[2][2]) const {
        int R[2], C[2]; stage_rc((int)threadIdx.x * 16, R[0], C[0]); stage_rc((int)threadIdx.x * 16 + 8192, R[1], C[1]);
#pragma unroll
        for (int h = 0; h < 2; ++h)
#pragma unroll
            for (int i = 0; i < 2; ++i) raw[h][i] = u.pm * BM + h * HALF + R[i];
    }
    __device__ __forceinline__ void a_finish(const Unit& u, const int (&raw)[2][2], unsigned (&o)[2][2]) const {
        int R[2], C[2]; stage_rc((int)threadIdx.x * 16, R[0], C[0]); stage_rc((int)threadIdx.x * 16 + 8192, R[1], C[1]);
#pragma unroll
        for (int h = 0; h < 2; ++h)
#pragma unroll
            for (int i = 0; i < 2; ++i) o[h][i] = (unsigned)(raw[h][i] * lda * es + C[i] * 2);
    }
    __device__ __forceinline__ int b_off(const Unit& u) const { return u.pn * BM * K * es; }
    __device__ __forceinline__ const void* bt() const { return Bt; }
};
struct SchedMoe {
    int nM, nN, G, c, lda; const void* Bt; int K; size_t bstride; bool gather; int es;
    const LAS int* tile_e; const LAS int* tile_p0; const LAS int* cnt_s; const int* rowmap;
    __device__ __forceinline__ bool next(int i, Unit& u) const { if (!static_deal(i, G, c, nM, nN, u.pm, u.pn)) return false; u.e = tile_e[u.pm]; u.p0 = tile_p0[u.pm]; return true; }
    __device__ __forceinline__ void a_fetch(const Unit& u, int (&raw)[2][2]) const {
        int R[2], C[2]; stage_rc((int)threadIdx.x * 16, R[0], C[0]); stage_rc((int)threadIdx.x * 16 + 8192, R[1], C[1]);
        const int ce = cnt_s[u.e];
#pragma unroll
        for (int h = 0; h < 2; ++h)
#pragma unroll
            for (int i = 0; i < 2; ++i) {
                if (gather) { const int pos = u.p0 + h * HALF + R[i]; raw[h][i] = pos < ce ? rowmap[2 * (u.e * 16384 + pos)] : 0; }
                else raw[h][i] = u.pm * BM + h * HALF + R[i]; }
    }
    __device__ __forceinline__ void a_finish(const Unit& u, const int (&raw)[2][2], unsigned (&o)[2][2]) const {
        int R[2], C[2]; stage_rc((int)threadIdx.x * 16, R[0], C[0]); stage_rc((int)threadIdx.x * 16 + 8192, R[1], C[1]);
#pragma unroll
        for (int h = 0; h < 2; ++h)
#pragma unroll
            for (int i = 0; i < 2; ++i) o[h][i] = (unsigned)(raw[h][i] * lda * es + C[i] * 2);
    }
    __device__ __forceinline__ int b_off(const Unit& u) const { return u.e * (int)bstride + u.pn * BM * K * es; }
    __device__ __forceinline__ const void* bt() const { return Bt; }
};

template <class Epi, class Sched, bool ALIGN_EPI, int ES = 2, bool I8 = false>
__device__ __forceinline__ void gemm_phase(LAS unsigned char* lds, const char* Abase, const int K, const Sched& S, const Epi& E) {
    const int tid = threadIdx.x, wid = __builtin_amdgcn_readfirstlane(tid >> 6), lane = tid & 63, wr = wid >> 2, wc = wid & 3, fr = lane & 15, fq = lane >> 4;
    const int nt = K * ES / (BK * 2);
    unsigned voffB[2];
#pragma unroll
    for (int i = 0; i < 2; ++i) { int R, C; stage_rc(tid * 16 + i * 8192, R, C); const int Rb = Epi::PERM ? ((R & ~31) + perm32(R & 31)) : R; voffB[i] = (unsigned)(Rb * K * ES + C * 2); }
    const int kstep = BK * 2;
    const int hstep = HALF * K * ES;
    const unsigned ldsw = (unsigned)wid * 1024u;
    const int aoff = lds_byte(wr * 64 + fr, fq * 8), boff = lds_byte(wc * 32 + fr, fq * 8);
    const __amdgpu_buffer_rsrc_t rsA = __builtin_amdgcn_make_buffer_rsrc((void*)Abase, (short)0, 0x7ffff000, 0x00020000);
    const __amdgpu_buffer_rsrc_t rsB = __builtin_amdgcn_make_buffer_rsrc((void*)S.bt(), (short)0, 0x7ffff000, 0x00020000);
#define PG8_SA(b, h) (((b) * 2 + (h)) * HTB)
#define PG8_SB(b, h) ((4 + (b) * 2 + (h)) * HTB)
#define PG8_STAGE_A(bufoff, soff, voff) do { _Pragma("unroll") for (int _i = 0; _i < 2; ++_i) \
        __builtin_amdgcn_raw_ptr_buffer_load_lds(rsA, (LAS unsigned*)(lds + (bufoff) + ldsw + _i * 8192), 16, (int)(voff)[_i], (soff), 0, 0); } while (0)
#define PG8_STAGE_B(bufoff, soff) do { _Pragma("unroll") for (int _i = 0; _i < 2; ++_i) \
        __builtin_amdgcn_raw_ptr_buffer_load_lds(rsB, (LAS unsigned*)(lds + (bufoff) + ldsw + _i * 8192), 16, (int)voffB[_i], (soff), 0, 0); } while (0)
#define PG8_LDA(dst, b, h) do { _Pragma("unroll") for (int m = 0; m < 4; ++m) _Pragma("unroll") for (int k = 0; k < 2; ++k) dst[m][k] = *(const LAS bf16x8*)(lds + PG8_SA(b, h) + aoff + m * 2048 + k * 1024); } while (0)
#define PG8_LDB(dst, b, h) do { _Pragma("unroll") for (int n = 0; n < 2; ++n) _Pragma("unroll") for (int k = 0; k < 2; ++k) dst[n][k] = *(const LAS bf16x8*)(lds + PG8_SB(b, h) + boff + n * 2048 + k * 1024); } while (0)
#define PG8_MMA(ai, bj, At, Bt) do { __builtin_amdgcn_s_setprio(1); _Pragma("unroll") for (int m = 0; m < 4; ++m) _Pragma("unroll") for (int n = 0; n < 2; ++n) { \
        if constexpr (I8) { _Pragma("unroll") for (int k = 0; k < 2; ++k) acc[ai][bj][m][n] = __builtin_bit_cast(f32x4, __builtin_amdgcn_mfma_i32_16x16x64_i8(__builtin_bit_cast(v4i, Bt[n][k]), __builtin_bit_cast(v4i, At[m][k]), __builtin_bit_cast(v4i, acc[ai][bj][m][n]), 0, 0, 0)); } \
        else if constexpr (ES == 2) { _Pragma("unroll") for (int k = 0; k < 2; ++k) acc[ai][bj][m][n] = __builtin_amdgcn_mfma_f32_16x16x32_bf16(Bt[n][k], At[m][k], acc[ai][bj][m][n], 0, 0, 0); } \
        else acc[ai][bj][m][n] = __builtin_amdgcn_mfma_scale_f32_16x16x128_f8f6f4(cat_frag(Bt[n][0], Bt[n][1]), cat_frag(At[m][0], At[m][1]), acc[ai][bj][m][n], 0, 0, 0, 0x7f7f7f7f, 0, 0x7f7f7f7f); } \
        __builtin_amdgcn_s_setprio(0); } while (0)
#define PG8_WAIT_V(n) asm volatile("s_waitcnt vmcnt(" #n ")" ::: "memory")
#define PG8_WAIT_L(n) asm volatile("s_waitcnt lgkmcnt(" #n ")" ::: "memory")
#define PG8_BAR __builtin_amdgcn_s_barrier()
#define PG8_SCHED __builtin_amdgcn_sched_barrier(0)
    Unit cur, nxt; int ui = 0;
    if (!S.next(0, cur)) return;
    f32x4 acc[2][2][4][2];
#pragma unroll
    for (int a = 0; a < 2; ++a)
#pragma unroll
        for (int b = 0; b < 2; ++b)
#pragma unroll
            for (int m = 0; m < 4; ++m)
#pragma unroll
                for (int n = 0; n < 2; ++n) acc[a][b][m][n] = (f32x4){0.f, 0.f, 0.f, 0.f};
    bf16x8 At[4][2], B0[2][2], B1[2][2];
    unsigned cao[2][2], nao[2][2];
    { int raw[2][2]; S.a_fetch(cur, raw); S.a_finish(cur, raw, cao); }
    int cB = S.b_off(cur);
    bool has_next = S.next(1, nxt); int nB = cB;
    if (has_next) { int raw[2][2]; S.a_fetch(nxt, raw); S.a_finish(nxt, raw, nao); nB = S.b_off(nxt); }
    else {
#pragma unroll
        for (int h = 0; h < 2; ++h)
#pragma unroll
            for (int i = 0; i < 2; ++i) nao[h][i] = cao[h][i]; }
    if constexpr (Epi::NSEG > 1) E.unit_begin(cur, tid);
    PG8_STAGE_B(PG8_SB(0, 0), cB); PG8_STAGE_B(PG8_SB(0, 1), cB + hstep); PG8_STAGE_A(PG8_SA(0, 0), 0, cao[0]); PG8_STAGE_A(PG8_SA(0, 1), 0, cao[1]);
    if (wr == 1) PG8_BAR;
    PG8_WAIT_V(2); PG8_BAR;
    PG8_STAGE_B(PG8_SB(1, 0), cB + kstep); PG8_STAGE_A(PG8_SA(1, 0), kstep, cao[0]); PG8_STAGE_B(PG8_SB(1, 1), cB + hstep + kstep);
    PG8_WAIT_V(6); PG8_BAR;
    for (;;) {
        int t = 0;
#pragma unroll 1
        for (int seg = 0; seg < Epi::NSEG; ++seg) {
        const int t_end = (Epi::NSEG == 1) ? nt : Epi::MID_T + Epi::SEG_STEP * seg;
#pragma unroll 1
        for (; t < t_end; t += 2) {
            const bool last = (t == nt - 2);
            const int a1 = (t + 1) * kstep;
            const int a2 = last ? 0 : (t + 2) * kstep; const int b2 = last ? nB : cB + (t + 2) * kstep;
            const int a3 = a2 + kstep; const int b3 = b2 + kstep;
            PG8_LDB(B0, 0, 0); PG8_LDB(B1, 0, 1); PG8_SCHED; PG8_LDA(At, 0, 0); PG8_STAGE_A(PG8_SA(1, 1), a1, cao[1]);
            if (last) {
#pragma unroll
                for (int h = 0; h < 2; ++h)
#pragma unroll
                    for (int i = 0; i < 2; ++i) cao[h][i] = nao[h][i]; }
            PG8_WAIT_V(8); PG8_WAIT_L(0); PG8_BAR; PG8_MMA(0, 0, At, B0); PG8_MMA(0, 1, At, B1); PG8_BAR; PG8_SCHED;
            PG8_LDA(At, 0, 1); PG8_STAGE_B(PG8_SB(0, 0), b2); PG8_STAGE_B(PG8_SB(0, 1), b2 + hstep); PG8_STAGE_A(PG8_SA(0, 0), a2, cao[0]);
            PG8_WAIT_V(8); PG8_WAIT_L(0); PG8_BAR; PG8_MMA(1, 0, At, B0); PG8_MMA(1, 1, At, B1); PG8_BAR; PG8_SCHED;
            PG8_LDB(B0, 1, 0); PG8_LDB(B1, 1, 1); PG8_SCHED; PG8_LDA(At, 1, 0); PG8_STAGE_A(PG8_SA(0, 1), a2, cao[1]);
            PG8_WAIT_V(8); PG8_WAIT_L(0); PG8_BAR; PG8_MMA(0, 0, At, B0); PG8_MMA(0, 1, At, B1); PG8_BAR; PG8_SCHED;
            PG8_LDA(At, 1, 1); PG8_STAGE_B(PG8_SB(1, 0), b3); PG8_STAGE_B(PG8_SB(1, 1), b3 + hstep); PG8_STAGE_A(PG8_SA(1, 0), a3, cao[0]);
            PG8_WAIT_V(8); PG8_WAIT_L(0); PG8_BAR; PG8_MMA(1, 0, At, B0); PG8_MMA(1, 1, At, B1); PG8_BAR; PG8_SCHED;
        }
        if constexpr (Epi::NSEG > 1) { E.mid(acc, cur, seg, wr, wc, fr, fq); }
        }
        if constexpr (ALIGN_EPI) { if (wr == 0) PG8_BAR; }
        Unit nn; const bool hnn = has_next && S.next(ui + 2, nn); int nraw[2][2];
        if (hnn) S.a_fetch(nn, nraw);
        E(acc, cur, wr, wc, fr, fq);
#ifdef MK_EPI2
        if constexpr (Epi::NSEG == 1 && Epi::PERM) { asm volatile("" ::: "memory"); E(acc, cur, wr, wc, fr, fq); }
#endif
        if (!has_next) break;
#pragma unroll
        for (int a = 0; a < 2; ++a)
#pragma unroll
            for (int b = 0; b < 2; ++b)
#pragma unroll
                for (int m = 0; m < 4; ++m)
#pragma unroll
                    for (int n = 0; n < 2; ++n) acc[a][b][m][n] = (f32x4){0.f, 0.f, 0.f, 0.f};
        cur = nxt; cB = nB; ++ui;
        has_next = hnn;
        if (hnn) { S.a_finish(nn, nraw, nao); nB = S.b_off(nn); nxt = nn; }
        else {
#pragma unroll
            for (int h = 0; h < 2; ++h)
#pragma unroll
                for (int i = 0; i < 2; ++i) nao[h][i] = cao[h][i]; }
        if constexpr (Epi::NSEG > 1) { PG8_BAR; E.unit_begin(cur, tid); }
        if constexpr (ALIGN_EPI) { if (wr == 1) PG8_BAR; }
    }
    PG8_WAIT_V(0);
    if constexpr (!ALIGN_EPI) { if (wr == 0) PG8_BAR; }
    PG8_BAR;
#undef PG8_SA
#undef PG8_SB
#undef PG8_STAGE_A
#undef PG8_STAGE_B
#undef PG8_LDA
#undef PG8_LDB
#undef PG8_MMA
#undef PG8_WAIT_V
#undef PG8_WAIT_L
#undef PG8_BAR
#undef PG8_SCHED
}

__device__ __forceinline__ float fsigmoid(float v) { return __builtin_amdgcn_rcpf(1.f + __builtin_amdgcn_exp2f(-1.4426950408889634f * v)); }
__device__ __forceinline__ float row_rstd(const float* ssq, int row) {
    const f32x4* p = (const f32x4*)(ssq + (size_t)row * 16); const f32x4 a = p[0], b = p[1], c = p[2], d = p[3];
    const float s = ((a.x + a.y) + (a.z + a.w)) + ((b.x + b.y) + (b.z + b.w)) + ((c.x + c.y) + (c.z + c.w)) + ((d.x + d.y) + (d.z + d.w));
    return 1.0f / sqrtf(s * (1.0f / 1024.0f) + 1e-5f);
}
template <bool I8> struct EpiP1 {
    static constexpr bool PERM = true; static constexpr int MID_T = 0, NSEG = 1, SEG_STEP = 0;
    bf16* O; int ldc; float* DT; const float* b_gate; const float* usc; const float* csc;
    __device__ __forceinline__ static f32x4 val(const f32x4& a, const f32x4& cs, float rs) {
        if constexpr (I8) { const v4i i = __builtin_bit_cast(v4i, a); return (f32x4){(float)i[0], (float)i[1], (float)i[2], (float)i[3]} * cs * rs; } else return a; }
    __device__ __forceinline__ void operator()(const f32x4 (&acc)[2][2][4][2], const Unit& u, int wr, int wc, int fr, int fq) const {
        int row0 = u.pm * BM + wr * 64 + fr; asm volatile("" : "+v"(row0));
        const int col0 = u.pn * BM + wc * 32 + 8 * fq;
        f32x4 cs[2][2]; float rsv[8];
#pragma unroll
        for (int bj = 0; bj < 2; ++bj)
#pragma unroll
            for (int n = 0; n < 2; ++n) cs[bj][n] = I8 ? *(const f32x4*)(csc + col0 + bj * HALF + 4 * n) : (f32x4){1.f, 1.f, 1.f, 1.f};
#pragma unroll
        for (int i = 0; i < 8; ++i) rsv[i] = I8 ? usc[row0 + (i >> 2) * HALF + (i & 3) * 16] : 1.f;
        if (u.pn == 33) {
            if (wc == 0) {
#pragma unroll
                for (int ai = 0; ai < 2; ++ai)
#pragma unroll
                    for (int m = 0; m < 4; ++m)
#pragma unroll
                        for (int n = 0; n < 2; ++n) *(f32x4*)(DT + (size_t)(row0 + ai * HALF + m * 16) * 32 + 8 * fq + 4 * n) = val(acc[ai][0][m][n], cs[0][n], rsv[ai * 4 + m]); }
            return; }
        const bool act = u.pn >= 25, zt = u.pn >= 5 && u.pn < 13;
        const int gj = (u.pn - 25) * 128 + wc * 32 + 8 * fq;
        f32x4 bv[2][2];
#pragma unroll
        for (int bj = 0; bj < 2; ++bj)
#pragma unroll
            for (int n = 0; n < 2; ++n) bv[bj][n] = act ? *(const f32x4*)(b_gate + bj * 1024 + gj + 4 * n) : (f32x4){0.f, 0.f, 0.f, 0.f};
#pragma unroll
        for (int ai = 0; ai < 2; ++ai)
#pragma unroll
            for (int m = 0; m < 4; ++m) { bf16* rowb = O + (size_t)(row0 + ai * HALF + m * 16) * ldc; const float rs = rsv[ai * 4 + m];
                f32x4 v[2][2];
#pragma unroll
                for (int bj = 0; bj < 2; ++bj) { v[bj][0] = val(acc[ai][bj][m][0], cs[bj][0], rs) + bv[bj][0]; v[bj][1] = val(acc[ai][bj][m][1], cs[bj][1], rs) + bv[bj][1]; }
                if (act) {
#pragma unroll
                    for (int n = 0; n < 2; ++n)
#pragma unroll
                        for (int k = 0; k < 4; ++k) { const float e0 = __builtin_amdgcn_exp2f(-1.4426950408889634f * v[0][n][k]), e1 = __builtin_amdgcn_exp2f(-1.4426950408889634f * v[1][n][k]);
                            v[0][n][k] = (1.f + e1) * __builtin_amdgcn_rcpf(1.f + e0);
                            v[1][n][k] = __builtin_amdgcn_rcpf(1.f + e1); }
                }
                if (zt) {
#pragma unroll
                    for (int bj = 0; bj < 2; ++bj)
#pragma unroll
                        for (int n = 0; n < 2; ++n)
#pragma unroll
                            for (int k = 0; k < 4; ++k) v[bj][n][k] = v[bj][n][k] * fsigmoid(v[bj][n][k]); }
#pragma unroll
                for (int bj = 0; bj < 2; ++bj) { const f32x4 v0 = v[bj][0], v1 = v[bj][1];
                    v4u w; w.x = cvt_pk_bf16(v0[0], v0[1]); w.y = cvt_pk_bf16(v0[2], v0[3]); w.z = cvt_pk_bf16(v1[0], v1[1]); w.w = cvt_pk_bf16(v1[2], v1[3]);
                    *(v4u*)(rowb + (act ? 6400 + bj * 1024 + gj : col0 + bj * HALF)) = w; } }
    }
};
struct EpiBf16S {
    static constexpr bool PERM = true; static constexpr int MID_T = 0, NSEG = 1, SEG_STEP = 0;
    bf16* O; int ldc; const float* ssq; float sc;
    __device__ __forceinline__ void operator()(const f32x4 (&acc)[2][2][4][2], const Unit& u, int wr, int wc, int fr, int fq) const {
        int row0 = u.pm * BM + wr * 64 + fr; asm volatile("" : "+v"(row0)); const int col0 = u.pn * BM + wc * 32 + 8 * fq;
#pragma unroll
        for (int ai = 0; ai < 2; ++ai)
#pragma unroll
            for (int m = 0; m < 4; ++m) { const int row = row0 + ai * HALF + m * 16; const float rs = (ssq ? row_rstd(ssq, row) : 1.f) * sc; bf16* rowp = O + (size_t)row * ldc + col0;
#pragma unroll
                for (int bj = 0; bj < 2; ++bj) { const f32x4 v0 = acc[ai][bj][m][0] * rs, v1 = acc[ai][bj][m][1] * rs;
                    v4u w; w.x = cvt_pk_bf16(v0[0], v0[1]); w.y = cvt_pk_bf16(v0[2], v0[3]); w.z = cvt_pk_bf16(v1[0], v1[1]); w.w = cvt_pk_bf16(v1[2], v1[3]);
                    *(v4u*)(rowp + bj * HALF) = w; } }
    }
};
struct EpiI8 {
    static constexpr bool PERM = true; static constexpr int MID_T = 0, NSEG = 1, SEG_STEP = 0;
    bf16* O; int ldc; const float* usc; const float* csc;
    __device__ __forceinline__ void operator()(const f32x4 (&acc)[2][2][4][2], const Unit& u, int wr, int wc, int fr, int fq) const {
        int row0 = u.pm * BM + wr * 64 + fr; asm volatile("" : "+v"(row0)); const int col0 = u.pn * BM + wc * 32 + 8 * fq;
        f32x4 cs[2][2];
#pragma unroll
        for (int bj = 0; bj < 2; ++bj)
#pragma unroll
            for (int n = 0; n < 2; ++n) cs[bj][n] = *(const f32x4*)(csc + col0 + bj * HALF + 4 * n);
#pragma unroll
        for (int ai = 0; ai < 2; ++ai)
#pragma unroll
            for (int m = 0; m < 4; ++m) { const int row = row0 + ai * HALF + m * 16; const float rs = usc[row]; bf16* rowp = O + (size_t)row * ldc + col0;
#pragma unroll
                for (int bj = 0; bj < 2; ++bj) { const v4i i0 = __builtin_bit_cast(v4i, acc[ai][bj][m][0]), i1 = __builtin_bit_cast(v4i, acc[ai][bj][m][1]);
                    const f32x4 v0 = (f32x4){(float)i0[0], (float)i0[1], (float)i0[2], (float)i0[3]} * cs[bj][0] * rs, v1 = (f32x4){(float)i1[0], (float)i1[1], (float)i1[2], (float)i1[3]} * cs[bj][1] * rs;
                    v4u w; w.x = cvt_pk_bf16(v0[0], v0[1]); w.y = cvt_pk_bf16(v0[2], v0[3]); w.z = cvt_pk_bf16(v1[0], v1[1]); w.w = cvt_pk_bf16(v1[2], v1[3]);
                    *(v4u*)(rowp + bj * HALF) = w; } }
    }
};
template <int ES, bool O8> struct EpiG2 {
    static constexpr bool PERM = true; static constexpr int MID_T = 16 * ES / 2, NSEG = 5, SEG_STEP = 8 * ES / 2;
    const bf16* gates; int ldg; void* O; int ldc; const float* ssqg; float sc; LAS float* ftab;
    __device__ __forceinline__ void unit_begin(const Unit& u, int tid) const {
        if (tid < 256) { const f32x4 sq = *(const f32x4*)(ssqg + (size_t)(u.pm * BM + tid) * 4);
            const float q0 = sq[0] * (1.f / 512.f) + 1e-5f, q1 = sq[1] * (1.f / 512.f) + 1e-5f, q2 = sq[2] * (1.f / 512.f) + 1e-5f, q3 = sq[3] * (1.f / 512.f) + 1e-5f;
            ftab[tid] = sqrtf(q0); ftab[256 + tid] = sqrtf(q1 / q0); ftab[512 + tid] = sqrtf(q2 / q1); ftab[768 + tid] = sqrtf(q3 / q2); ftab[1024 + tid] = sc / sqrtf(q3); }
    }
    __device__ __forceinline__ void mid(f32x4 (&acc)[2][2][4][2], const Unit& u, int seg, int wr, int wc, int fr, int fq) const {
        int row0 = u.pm * BM + wr * 64 + fr; asm volatile("" : "+v"(row0)); const int col0 = u.pn * BM + wc * 32 + 8 * fq;
        const LAS float* rfp = ftab + seg * 256 + wr * 64 + fr;
        const bool gh = seg == 0 || seg == 4; const bf16* gbase = gates + col0 + (seg == 0 ? 0 : 1024);
#pragma unroll
        for (int pb = 0; pb < 1; ++pb) {
            v4u gv[4][2][2];
            if (gh) {
#pragma unroll
                for (int pp = 0; pp < 4; ++pp)
#pragma unroll
                    for (int mm = 0; mm < 2; ++mm)
#pragma unroll
                        for (int bj = 0; bj < 2; ++bj) { const int pr = pp; gv[pp][mm][bj] = *(const v4u*)(gbase + (size_t)(row0 + (pr >> 1) * HALF + (2 * (pr & 1) + mm) * 16) * ldg + bj * HALF); } }
#pragma unroll
            for (int pp = 0; pp < 4; ++pp) { const int pr = pp, ai = pr >> 1, m0 = 2 * (pr & 1);
                f32x4 fa[2][2], fb[2][2];
#pragma unroll
                for (int mm = 0; mm < 2; ++mm)
#pragma unroll
                    for (int bj = 0; bj < 2; ++bj) { const float f = rfp[ai * HALF + (m0 + mm) * 16]; fa[mm][bj] = (f32x4){f, f, f, f}; fb[mm][bj] = fa[mm][bj]; }
                if (gh) {
#pragma unroll
                    for (int mm = 0; mm < 2; ++mm)
#pragma unroll
                        for (int bj = 0; bj < 2; ++bj) { const v4u b = gv[pp][mm][bj];
                            fa[mm][bj] *= (f32x4){bflo(b.x), bfhi(b.x), bflo(b.y), bfhi(b.y)}; fb[mm][bj] *= (f32x4){bflo(b.z), bfhi(b.z), bflo(b.w), bfhi(b.w)}; }
                }
#pragma unroll
                for (int mm = 0; mm < 2; ++mm)
#pragma unroll
                    for (int bj = 0; bj < 2; ++bj) { acc[ai][bj][m0 + mm][0] *= fa[mm][bj]; acc[ai][bj][m0 + mm][1] *= fb[mm][bj]; }
                asm volatile("" : "+v"(acc[ai][0][m0][0]), "+v"(acc[ai][0][m0][1]), "+v"(acc[ai][1][m0][0]), "+v"(acc[ai][1][m0][1]), "+v"(acc[ai][0][m0 + 1][0]), "+v"(acc[ai][0][m0 + 1][1]), "+v"(acc[ai][1][m0 + 1][0]), "+v"(acc[ai][1][m0 + 1][1]) :: "memory");
            }
        }
    }
    __device__ __forceinline__ void operator()(const f32x4 (&acc)[2][2][4][2], const Unit& u, int wr, int wc, int fr, int fq) const {
        int row0 = u.pm * BM + wr * 64 + fr; asm volatile("" : "+v"(row0)); const int col0 = u.pn * BM + wc * 32 + 8 * fq;
#pragma unroll
        for (int ai = 0; ai < 2; ++ai)
#pragma unroll
            for (int m = 0; m < 4; ++m) { const size_t ro = (size_t)(row0 + ai * HALF + m * 16) * ldc + col0;
#pragma unroll
                for (int bj = 0; bj < 2; ++bj) { const f32x4 v0 = acc[ai][bj][m][0], v1 = acc[ai][bj][m][1];
                    if constexpr (O8) *(v2u*)((unsigned char*)O + ro + bj * HALF) = (v2u){pk4_fp8(v0[0], v0[1], v0[2], v0[3]), pk4_fp8(v1[0], v1[1], v1[2], v1[3])};
                    else { v4u w; w.x = cvt_pk_bf16(v0[0], v0[1]); w.y = cvt_pk_bf16(v0[2], v0[3]); w.z = cvt_pk_bf16(v1[0], v1[1]); w.w = cvt_pk_bf16(v1[2], v1[3]);
                        *(v4u*)((bf16*)O + ro + bj * HALF) = w; } } }
    }
};
template <bool BASE16> struct EpiRes {
    static constexpr bool PERM = true; static constexpr int MID_T = 0, NSEG = 1, SEG_STEP = 0;
    const void* base; bf16* H; bf16* HB; const float* nw; float* ssq; unsigned char* T8; float sc;
    __device__ __forceinline__ void operator()(const f32x4 (&acc)[2][2][4][2], const Unit& u, int wr, int wc, int fr, int fq) const {
        int row0 = u.pm * BM + wr * 64 + fr; asm volatile("" : "+v"(row0)); const int col0 = u.pn * BM + wc * 32 + 8 * fq;
        f32x4 wv[2][2];
#pragma unroll
        for (int bj = 0; bj < 2; ++bj)
#pragma unroll
            for (int n = 0; n < 2; ++n) wv[bj][n] = *(const f32x4*)(nw + col0 + bj * HALF + 4 * n);
#pragma unroll
        for (int ai = 0; ai < 2; ++ai)
#pragma unroll
            for (int m = 0; m < 4; ++m) { const int row = row0 + ai * HALF + m * 16; const size_t off = (size_t)row * 1024 + col0; float s = 0.f;
#pragma unroll
                for (int bj = 0; bj < 2; ++bj) { f32x4 h0, h1;
                    if constexpr (BASE16) { const v4u b = *(const v4u*)((const bf16*)base + off + bj * HALF);
                        h0 = (f32x4){bflo(b.x), bfhi(b.x), bflo(b.y), bfhi(b.y)}; h1 = (f32x4){bflo(b.z), bfhi(b.z), bflo(b.w), bfhi(b.w)}; }
                    else { h0 = *(const f32x4*)((const float*)base + off + bj * HALF); h1 = *(const f32x4*)((const float*)base + off + bj * HALF + 4); }
                    h0 += acc[ai][bj][m][0] * sc; h1 += acc[ai][bj][m][1] * sc;
                    s += ((h0[0] * h0[0] + h0[1] * h0[1]) + (h0[2] * h0[2] + h0[3] * h0[3])) + ((h1[0] * h1[0] + h1[1] * h1[1]) + (h1[2] * h1[2] + h1[3] * h1[3]));
                    *(v4u*)(H + off + bj * HALF) = (v4u){cvt_pk_bf16(h0[0], h0[1]), cvt_pk_bf16(h0[2], h0[3]), cvt_pk_bf16(h1[0], h1[1]), cvt_pk_bf16(h1[2], h1[3])};
                    const f32x4 w0 = h0 * wv[bj][0], w1 = h1 * wv[bj][1];
                    if (HB) *(v4u*)(HB + off + bj * HALF) = (v4u){cvt_pk_bf16(w0[0], w0[1]), cvt_pk_bf16(w0[2], w0[3]), cvt_pk_bf16(w1[0], w1[1]), cvt_pk_bf16(w1[2], w1[3])};
                    if (T8) *(v2u*)(T8 + off + bj * HALF) = (v2u){pk4_fp8(w0[0], w0[1], w0[2], w0[3]), pk4_fp8(w1[0], w1[1], w1[2], w1[3])}; }
                s += __shfl_xor(s, 16); s += __shfl_xor(s, 32);
                if (fq == 0) ssq[(size_t)row * 16 + u.pn * 4 + wc] = s;
                if (m == 3) asm volatile("" ::: "memory"); }
    }
};
struct EpiGU {
    static constexpr bool PERM = true; static constexpr int MID_T = 0, NSEG = 1, SEG_STEP = 0;
    unsigned char* ACT8; const float* b_gu; const int* rowmap; const LAS int* cnt_s;
    __device__ __forceinline__ void operator()(const f32x4 (&acc)[2][2][4][2], const Unit& u, int wr, int wc, int fr, int fq) const {
        int r0 = wr * 64 + fr; asm volatile("" : "+v"(r0)); const int cc = wc * 32 + 8 * fq; const int ce = cnt_s[u.e];
        const float* bg = b_gu + (size_t)u.e * 2048 + u.pn * 128 + cc;
        f32x4 bgv[2], buv[2];
#pragma unroll
        for (int n = 0; n < 2; ++n) { bgv[n] = *(const f32x4*)(bg + 4 * n); buv[n] = *(const f32x4*)(bg + 1024 + 4 * n); }
        float rsv[8];
#pragma unroll
        for (int i = 0; i < 8; ++i) { const int pos = u.p0 + r0 + (i >> 2) * HALF + (i & 3) * 16; rsv[i] = pos < ce ? __int_as_float(rowmap[2 * (u.e * 16384 + pos) + 1]) * (1.f / W8_SCALE) : 0.f; }
#pragma unroll
        for (int ai = 0; ai < 2; ++ai)
#pragma unroll
            for (int m = 0; m < 4; ++m) { const int rt = r0 + ai * HALF + m * 16; const float rs = rsv[ai * 4 + m]; unsigned w[2];
#pragma unroll
                for (int n = 0; n < 2; ++n) { f32x4 g = acc[ai][0][m][n] * rs + bgv[n], up = acc[ai][1][m][n] * rs + buv[n]; float a[4];
#pragma unroll
                    for (int k = 0; k < 4; ++k) { const float gg = fminf(g[k], 7.f), uu = fminf(fmaxf(up[k], -7.f), 7.f); a[k] = (uu + 1.f) * (gg * fsigmoid(1.702f * gg)); }
                    w[n] = pk4_fp8(a[0], a[1], a[2], a[3]); }
                *(v2u*)(ACT8 + (size_t)(u.pm * BM + rt) * 1024 + u.pn * 128 + cc) = (v2u){w[0], w[1]}; }
    }
};
struct EpiDN {
    static constexpr bool PERM = true; static constexpr int MID_T = 0, NSEG = 1, SEG_STEP = 0;
    unsigned char* Y; const float* b_dn;
    __device__ __forceinline__ void operator()(const f32x4 (&acc)[2][2][4][2], const Unit& u, int wr, int wc, int fr, int fq) const {
        int row0 = u.pm * BM + wr * 64 + fr; asm volatile("" : "+v"(row0)); const int col0 = u.pn * BM + wc * 32 + 8 * fq;
        f32x4 bv[2][2];
#pragma unroll
        for (int bj = 0; bj < 2; ++bj)
#pragma unroll
            for (int n = 0; n < 2; ++n) bv[bj][n] = *(const f32x4*)(b_dn + (size_t)u.e * 1024 + col0 + bj * HALF + 4 * n);
#pragma unroll
        for (int ai = 0; ai < 2; ++ai)
#pragma unroll
            for (int m = 0; m < 4; ++m) { unsigned char* rowp = Y + (size_t)(row0 + ai * HALF + m * 16) * 1024 + col0;
#pragma unroll
                for (int bj = 0; bj < 2; ++bj) { const f32x4 v0 = acc[ai][bj][m][0] * (1.f / W8_SCALE) + bv[bj][0], v1 = acc[ai][bj][m][1] * (1.f / W8_SCALE) + bv[bj][1];
                    *(v2u*)(rowp + bj * HALF) = (v2u){pk4_fp8(v0[0], v0[1], v0[2], v0[3]), pk4_fp8(v1[0], v1[1], v1[2], v1[3])}; } }
    }
};
}
#ifndef FP8_G2
#define FP8_G2 0
#endif
#ifndef FP8_G3
#define FP8_G3 0
#endif
#ifndef FP8_G4
#define FP8_G4 1
#endif
#ifndef FP8_G6
#define FP8_G6 1
#endif
#ifndef I8_G1
#define I8_G1 1
#endif
#ifndef MK_SUBREP
#define MK_SUBREP 0
#endif
constexpr int NWAVES = 8;
constexpr int M_TOK = 16384, SEQ = 2048, NBATCH = 8, DM = 1024;
constexpr int P1C = 8448;
constexpr int C_Q = 0, C_K = 1024, C_V = 1152, C_Z = 1280, C_X = 3328, C_G = 6400;
constexpr int N1 = 8704;
constexpr size_t MiB = 1u << 20;
constexpr size_t WS_CTL = 0, CTL_ZERO_BYTES = 1 * MiB;
constexpr size_t WS_W1T = 1 * MiB, WS_WCKV = 18 * MiB, WS_WCAT = 22 * MiB, WS_WOUT = 28 * MiB, WS_WCQ = 30 * MiB, WS_WCO = 32 * MiB, WS_WR = 34 * MiB, WS_WGU = 35 * MiB, WS_WDN = 163 * MiB;
constexpr size_t WS_P1 = 228 * MiB, WS_DT = 492 * MiB, WS_KVC = 494 * MiB, WS_ACAT = 502 * MiB, WS_ST = 598 * MiB, WS_PREV = 662 * MiB, WS_U = 726 * MiB, WS_MN = 758 * MiB;
constexpr size_t WS_H1 = 762 * MiB, WS_HB = 826 * MiB, WS_MISC = 858 * MiB;
constexpr size_t WS_T8 = WS_ACAT  , WS_MERGED = WS_U, WS_QC = WS_ST, WS_OC = WS_ST + 32 * MiB, WS_H2 = WS_PREV, WS_T = WS_HB, WS_ACT = WS_P1, WS_Y = WS_P1 + 144 * MiB;
constexpr size_t WS_SSQ1 = WS_MISC, WS_SSQ2 = WS_MISC + 1 * MiB, WS_TOKE = WS_MISC + 2 * MiB, WS_TOKP = WS_TOKE + 256 * 1024, WS_TOKW = WS_TOKP + 256 * 1024, WS_CDEC = WS_TOKW + 256 * 1024, WS_ROWMAP = WS_MISC + 3 * MiB  , WS_SSQG = WS_MISC + 7 * MiB, WS_USC = WS_MISC + 7 * MiB + 512 * 1024  , WS_CSC = WS_MISC + 7 * MiB + 768 * 1024  , WS_MSC = WS_MISC + 7 * MiB + 832 * 1024  , WS_KSC = WS_MISC + 7 * MiB + 896 * 1024  ;
constexpr size_t WS_NAIVE = 880 * MiB;
constexpr int CW_TMO = 0, CW_BAR = 4096, CW_CNT = 16384;
constexpr int SCR_BYTES = 139264;
constexpr int TAB_OFF = SCR_BYTES;
constexpr int LDS_BYTES = SCR_BYTES + 16384;
constexpr int TAB_MISC = TAB_OFF;
constexpr int TAB_DT = TAB_OFF + 1024, TAB_ACUM = TAB_OFF + 1024 + 4096;
constexpr int TAB_TE = TAB_OFF + 1024, TAB_TP0 = TAB_TE + 1280, TAB_CNT = TAB_TP0 + 1280, TAB_TB = TAB_CNT + 128, TAB_NT = TAB_TB + 128;

typedef const float* fptr_t;
struct Frame {
    LAS unsigned char* lds; gu32* ctl; int tid, lane, wave, vcu, G;
    unsigned char* ws;
    const __attribute__((address_space(4))) fptr_t* in;
    float* out;
};
enum { I_X = 0, I_MEM, I_NMIXW, I_WIN, I_WGATE, I_BGATE, I_SINKS, I_CONVW, I_CONVB, I_DTB, I_ALOG, I_DSKIP, I_SSMNW, I_WAO, I_WSO, I_WOUT, I_NCW, I_NMW, I_WCQ, I_WCKV, I_WCO, I_NFW, I_WR, I_BR, I_WGU, I_BGU, I_WDN, I_BDN, I_FNW };

__device__ __forceinline__ void tr_item(const float* W, int ldw, int k0, int n0, bf16* dst, int ldt, LAS float* scr, int lane, const float* kscale = nullptr) {
    f32x4 t[8]; const int rr = lane >> 3, c4 = (lane & 7) * 4;
#pragma unroll
    for (int i = 0; i < 8; ++i) { t[i] = *(const GAS f32x4*)(W + (size_t)(k0 + 8 * i + rr) * ldw + n0 + c4); if (kscale) t[i] *= kscale[k0 + 8 * i + rr]; }
#pragma unroll
    for (int i = 0; i < 8; ++i) { LAS float* d = scr + (8 * i + rr) * 33 + c4; d[0] = t[i][0]; d[1] = t[i][1]; d[2] = t[i][2]; d[3] = t[i][3]; }
    LDS_WAIT(); asm volatile("" ::: "memory");
    const int c = lane & 7;
#pragma unroll
    for (int j = 0; j < 4; ++j) { const int n = (lane >> 3) + 8 * j; const LAS float* s = scr + (8 * c) * 33 + n;
        v4u o; o.x = pk2(s[0 * 33], s[1 * 33]); o.y = pk2(s[2 * 33], s[3 * 33]); o.z = pk2(s[4 * 33], s[5 * 33]); o.w = pk2(s[6 * 33], s[7 * 33]);
        *(GAS v4u*)(dst + (size_t)n * ldt + 8 * c) = o; }
    LDS_WAIT(); asm volatile("" ::: "memory");
}
__device__ __forceinline__ void tr_item8(const float* W, int ldw, int k0, int n0, unsigned char* dst, int ldt, LAS float* scr, int lane, float sc, const float* kscale = nullptr) {
    f32x4 t[8]; const int rr = lane >> 3, c4 = (lane & 7) * 4;
#pragma unroll
    for (int i = 0; i < 8; ++i) t[i] = *(const GAS f32x4*)(W + (size_t)(k0 + 8 * i + rr) * ldw + n0 + c4);
#pragma unroll
    for (int i = 0; i < 8; ++i) { LAS float* d = scr + (8 * i + rr) * 33 + c4; const float f = kscale ? sc * kscale[k0 + 8 * i + rr] : sc; d[0] = t[i][0] * f; d[1] = t[i][1] * f; d[2] = t[i][2] * f; d[3] = t[i][3] * f; }
    LDS_WAIT(); asm volatile("" ::: "memory");
    const int n = lane >> 1, hf = lane & 1; const LAS float* s = scr + (32 * hf) * 33 + n;
    unsigned o[8];
#pragma unroll
    for (int j = 0; j < 8; ++j) o[j] = pg8::pk4_fp8(s[(4 * j) * 33], s[(4 * j + 1) * 33], s[(4 * j + 2) * 33], s[(4 * j + 3) * 33]);
    GAS v4u* dp = (GAS v4u*)(dst + (size_t)n * ldt + 32 * hf);
    dp[0] = (v4u){o[0], o[1], o[2], o[3]}; dp[1] = (v4u){o[4], o[5], o[6], o[7]};
    LDS_WAIT(); asm volatile("" ::: "memory");
}
__device__ __forceinline__ void rms_row_to_bf16(const float* xrow, const float* w, bf16* orow, int lane) {
    const GAS f32x4* xr = (const GAS f32x4*)xrow + lane; const GAS f32x4* wr_ = (const GAS f32x4*)w + lane;
    f32x4 v[4]; float s = 0.f;
#pragma unroll
    for (int j = 0; j < 4; ++j) { v[j] = xr[64 * j]; s += (v[j].x * v[j].x + v[j].y * v[j].y) + (v[j].z * v[j].z + v[j].w * v[j].w); }
    const float rstd = 1.f / sqrtf(wave_sum(s) * (1.f / 1024.f) + 1e-5f);
    GAS unsigned long long* o8 = (GAS unsigned long long*)orow + lane;
#pragma unroll
    for (int j = 0; j < 4; ++j) { const f32x4 g = wr_[64 * j]; o8[64 * j] = (unsigned long long)pk2(v[j].x * rstd * g.x, v[j].y * rstd * g.y) | ((unsigned long long)pk2(v[j].z * rstd * g.z, v[j].w * rstd * g.w) << 32); }
}
__device__ __forceinline__ unsigned pk4_i8(float a, float b, float c, float d) {
    return ((unsigned)(int)a & 0xffu) | (((unsigned)(int)b & 0xffu) << 8) | (((unsigned)(int)c & 0xffu) << 16) | ((unsigned)(int)d << 24); }
__device__ __forceinline__ void rms_row_to_i8(const float* xrow, const float* w, unsigned char* orow, float* osc, int lane) {
    const GAS f32x4* xr = (const GAS f32x4*)xrow + lane; const GAS f32x4* wr_ = (const GAS f32x4*)w + lane;
    f32x4 v[4]; float s = 0.f;
#pragma unroll
    for (int j = 0; j < 4; ++j) { v[j] = xr[64 * j]; s += (v[j].x * v[j].x + v[j].y * v[j].y) + (v[j].z * v[j].z + v[j].w * v[j].w); }
    const float rstd = 1.f / sqrtf(wave_sum(s) * (1.f / 1024.f) + 1e-5f); float mx = 0.f;
#pragma unroll
    for (int j = 0; j < 4; ++j) { const f32x4 g = wr_[64 * j]; v[j] = v[j] * rstd * g; mx = fmaxf(fmaxf(fmaxf(fabsf(v[j].x), fabsf(v[j].y)), fmaxf(fabsf(v[j].z), fabsf(v[j].w))), mx); }
#pragma unroll
    for (int o = 1; o < 64; o <<= 1) mx = fmaxf(mx, __shfl_xor(mx, o));
    const float isc = mx > 0.f ? 127.f / mx : 0.f;
#pragma unroll
    for (int j = 0; j < 4; ++j) ((GAS unsigned*)orow)[lane + 64 * j] = pk4_i8(rintf(v[j].x * isc), rintf(v[j].y * isc), rintf(v[j].z * isc), rintf(v[j].w * isc));
    if (lane == 0) *osc = mx * (1.f / 127.f);
}
__device__ __forceinline__ void w1t_colblock_i8(Frame& F, const float* W, int ldw, int n0, unsigned char* dst  , float* csc  ) {
    LAS float* scr = (LAS float*)(F.lds + F.wave * 16384); LAS float* cmax = (LAS float*)(F.lds + TAB_OFF + 1024);
    const int lane = F.lane, rr = lane >> 3, c4 = (lane & 7) * 4, kb0 = 2 * F.wave;
    f32x4 t[2][8]; f32x4 mx = (f32x4){0.f, 0.f, 0.f, 0.f};
#pragma unroll
    for (int b = 0; b < 2; ++b)
#pragma unroll
        for (int i = 0; i < 8; ++i) t[b][i] = *(const GAS f32x4*)(W + (size_t)(64 * (kb0 + b) + 8 * i + rr) * ldw + n0 + c4);
#pragma unroll
    for (int b = 0; b < 2; ++b)
#pragma unroll
        for (int i = 0; i < 8; ++i) { mx[0] = fmaxf(mx[0], fabsf(t[b][i][0])); mx[1] = fmaxf(mx[1], fabsf(t[b][i][1])); mx[2] = fmaxf(mx[2], fabsf(t[b][i][2])); mx[3] = fmaxf(mx[3], fabsf(t[b][i][3])); }
#pragma unroll
    for (int o = 8; o < 64; o <<= 1) { mx[0] = fmaxf(mx[0], __shfl_xor(mx[0], o)); mx[1] = fmaxf(mx[1], __shfl_xor(mx[1], o)); mx[2] = fmaxf(mx[2], __shfl_xor(mx[2], o)); mx[3] = fmaxf(mx[3], __shfl_xor(mx[3], o)); }
    if (lane < 8) *(LAS f32x4*)(cmax + F.wave * 32 + c4) = mx;
    LDS_WAIT(); __syncthreads();
#pragma unroll
    for (int wv = 0; wv < 8; ++wv) { const f32x4 o = *(const LAS f32x4*)(cmax + wv * 32 + c4); mx[0] = fmaxf(mx[0], o[0]); mx[1] = fmaxf(mx[1], o[1]); mx[2] = fmaxf(mx[2], o[2]); mx[3] = fmaxf(mx[3], o[3]); }
    f32x4 isc;
#pragma unroll
    for (int k = 0; k < 4; ++k) isc[k] = mx[k] > 0.f ? 127.f / mx[k] : 0.f;
    if (F.wave == 0 && lane < 8) *(f32x4*)(csc + c4) = mx * (1.f / 127.f);
#pragma unroll
    for (int b = 0; b < 2; ++b) {
#pragma unroll
        for (int i = 0; i < 8; ++i) { LAS float* d = scr + (8 * i + rr) * 33 + c4; d[0] = rintf(t[b][i][0] * isc[0]); d[1] = rintf(t[b][i][1] * isc[1]); d[2] = rintf(t[b][i][2] * isc[2]); d[3] = rintf(t[b][i][3] * isc[3]); }
        LDS_WAIT(); asm volatile("" ::: "memory");
        { const int n = lane >> 1, hf = lane & 1; const LAS float* sp = scr + (32 * hf) * 33 + n; unsigned o[8];
#pragma unroll
          for (int j = 0; j < 8; ++j) o[j] = pk4_i8(sp[(4 * j) * 33], sp[(4 * j + 1) * 33], sp[(4 * j + 2) * 33], sp[(4 * j + 3) * 33]);
          GAS v4u* dp = (GAS v4u*)(dst + (size_t)n * 1024 + 64 * (kb0 + b) + 32 * hf); dp[0] = (v4u){o[0], o[1], o[2], o[3]}; dp[1] = (v4u){o[4], o[5], o[6], o[7]}; }
        LDS_WAIT(); asm volatile("" ::: "memory");
    }
    __syncthreads();
}
__device__ __forceinline__ int gate_row(int nb) { const int col = 32 * nb, half = col >> 10, j = col & 1023; return 6400 + (j >> 7) * 256 + half * 128 + (j & 127); }
__device__ __forceinline__ void p0_prologue(Frame& F) {
    LAS float* scr = (LAS float*)(F.lds + F.wave * 16384);
    const int gw = F.vcu * NWAVES + F.wave, NGW = F.G * NWAVES;
    bf16* W1T = (bf16*)(F.ws + WS_W1T); bf16* WCAT = (bf16*)(F.ws + WS_WCAT);
    constexpr int I1 = 16 * 200, I2 = 16, I3 = 16 * 64, I4 = 16 * 64, I5 = 16 * 32, I6 = 32 * 32, I7 = 16 * 32, I10 = 16, I11 = 32 * 16 * 64, I12 = 32 * 16 * 32;
    constexpr int NITEMS = (I8_G1 ? 0 : I1 + I2 + I3 + I4) + I5 + I6 + 3 * I7 + I10 + I11 + I12;
    for (int it = gw; it < NITEMS; it += NGW) {
        int r = it;
        if (I8_G1) r += I1 + I2 + I3;
        if (r < I1) { const int kb = r / 200, nb = r % 200; tr_item(F.in[I_WIN], 6432, 64 * kb, 32 * nb, W1T + (size_t)(32 * nb) * 1024 + 64 * kb, 1024, scr, F.lane); continue; } r -= I1;
        if (r < I2) { const int kb = r; tr_item(F.in[I_WIN], 6432, 64 * kb, 6400, W1T + (size_t)8448 * 1024 + 64 * kb, 1024, scr, F.lane); continue; } r -= I2;
        if (r < I3) { const int kb = r / 64, nb = r % 64; tr_item(F.in[I_WGATE], 2048, 64 * kb, 32 * nb, W1T + (size_t)gate_row(nb) * 1024 + 64 * kb, 1024, scr, F.lane); continue; } r -= I3;
        if (I8_G1) r += I4;
        if (r < I4) { const int kb = r / 64, nb = r % 64; tr_item(F.in[I_WCKV], 2048, 64 * kb, 32 * nb, (bf16*)(F.ws + WS_WCKV) + (size_t)(32 * nb) * 1024 + 64 * kb, 1024, scr, F.lane); continue; } r -= I4;
        if (r < I5) { const int kb = r / 32, nb = r % 32;
            if (FP8_G2) tr_item8(F.in[I_WAO], 1024, 64 * kb, 32 * nb, (unsigned char*)WCAT + (size_t)(32 * nb) * 3072 + 64 * kb, 3072, scr, F.lane, pg8::W8_SCALE);
            else tr_item(F.in[I_WAO], 1024, 64 * kb, 32 * nb, WCAT + (size_t)(32 * nb) * 3072 + 64 * kb, 3072, scr, F.lane);
            continue; } r -= I5;
        if (r < I6) { const int kb = r / 32, nb = r % 32;
            if (FP8_G2) tr_item8(F.in[I_WSO], 1024, 64 * kb, 32 * nb, (unsigned char*)WCAT + (size_t)(32 * nb) * 3072 + 1024 + 64 * kb, 3072, scr, F.lane, pg8::W8_SCALE, F.in[I_SSMNW]);
            else tr_item(F.in[I_WSO], 1024, 64 * kb, 32 * nb, WCAT + (size_t)(32 * nb) * 3072 + 1024 + 64 * kb, 3072, scr, F.lane, F.in[I_SSMNW]);
            continue; } r -= I6;
        if (r < I7) { const int kb = r / 32, nb = r % 32;
            if (FP8_G3) tr_item8(F.in[I_WOUT], 1024, 64 * kb, 32 * nb, (unsigned char*)(F.ws + WS_WOUT) + (size_t)(32 * nb) * 1024 + 64 * kb, 1024, scr, F.lane, pg8::W8_SCALE);
            else tr_item(F.in[I_WOUT], 1024, 64 * kb, 32 * nb, (bf16*)(F.ws + WS_WOUT) + (size_t)(32 * nb) * 1024 + 64 * kb, 1024, scr, F.lane);
            continue; } r -= I7;
        if (r < I7) { const int kb = r / 32, nb = r % 32;
            if (FP8_G4) tr_item8(F.in[I_WCQ], 1024, 64 * kb, 32 * nb, (unsigned char*)(F.ws + WS_WCQ) + (size_t)(32 * nb) * 1024 + 64 * kb, 1024, scr, F.lane, pg8::W8_SCALE);
            else tr_item(F.in[I_WCQ], 1024, 64 * kb, 32 * nb, (bf16*)(F.ws + WS_WCQ) + (size_t)(32 * nb) * 1024 + 64 * kb, 1024, scr, F.lane);
            continue; } r -= I7;
        if (r < I7) { const int kb = r / 32, nb = r % 32;
            if (FP8_G6) tr_item8(F.in[I_WCO], 1024, 64 * kb, 32 * nb, (unsigned char*)(F.ws + WS_WCO) + (size_t)(32 * nb) * 1024 + 64 * kb, 1024, scr, F.lane, pg8::W8_SCALE);
            else tr_item(F.in[I_WCO], 1024, 64 * kb, 32 * nb, (bf16*)(F.ws + WS_WCO) + (size_t)(32 * nb) * 1024 + 64 * kb, 1024, scr, F.lane);
            continue; } r -= I7;
        if (r < I10) { const int kb = r; tr_item(F.in[I_WR], 32, 64 * kb, 0, (bf16*)(F.ws + WS_WR) + 64 * kb, 1024, scr, F.lane); continue; } r -= I10;
        if (r < I11) { const int e = r / 1024, rr = r % 1024, kb = rr / 64, nb = rr % 64; const int n0 = 32 * nb, up = n0 >= 1024 ? 1 : 0, j = n0 & 1023, drow = (j >> 7) * 256 + up * 128 + (j & 127);
            tr_item8(F.in[I_WGU] + (size_t)e * 1024 * 2048, 2048, 64 * kb, n0, (unsigned char*)(F.ws + WS_WGU) + (size_t)e * 2048 * 1024 + (size_t)drow * 1024 + 64 * kb, 1024, scr, F.lane, pg8::W8_SCALE); continue; } r -= I11;
        { const int e = r / 512, rr = r % 512, kb = rr / 32, nb = rr % 32;
            tr_item8(F.in[I_WDN] + (size_t)e * 1024 * 1024, 1024, 64 * kb, 32 * nb, (unsigned char*)(F.ws + WS_WDN) + (size_t)e * 1024 * 1024 + (size_t)(32 * nb) * 1024 + 64 * kb, 1024, scr, F.lane, pg8::W8_SCALE); }
    }
    if (I8_G1) {
        unsigned char* W8 = (unsigned char*)(F.ws + WS_W1T); float* csc = (float*)(F.ws + WS_CSC);
        __syncthreads();
        for (int task = F.vcu; task < 265 + 64; task += F.G) {
            if (task >= 265) { const int nb = task - 265; w1t_colblock_i8(F, F.in[I_WCKV], 2048, 32 * nb, (unsigned char*)(F.ws + WS_WCKV) + (size_t)(32 * nb) * 1024, (float*)(F.ws + WS_KSC) + 32 * nb); }
            else if (task < 201) { const int drow = task < 200 ? 32 * task : 8448; w1t_colblock_i8(F, F.in[I_WIN], 6432, 32 * task, W8 + (size_t)drow * 1024, csc + drow); }
            else { const int nb = task - 201, drow = gate_row(nb); w1t_colblock_i8(F, F.in[I_WGATE], 2048, 32 * nb, W8 + (size_t)drow * 1024, csc + drow); } }
        for (int i = F.vcu * 512 + F.tid; i < 14336; i += F.G * 512) ((GAS v4u*)(W8 + (size_t)8480 * 1024))[i] = (v4u){0u, 0u, 0u, 0u};
        for (int i = F.vcu * 512 + F.tid; i < 224; i += F.G * 512) csc[8480 + i] = 0.f;
        for (int m = gw; m < M_TOK; m += NGW) rms_row_to_i8(F.in[I_X] + (size_t)m * DM, F.in[I_NMIXW], (unsigned char*)(F.ws + WS_U) + (size_t)m * DM, (float*)(F.ws + WS_USC) + m, F.lane);
    } else {
    for (int i = F.vcu * 512 + F.tid; i < 28672; i += F.G * 512) ((GAS v4u*)(W1T + (size_t)8480 * 1024))[i] = (v4u){0u, 0u, 0u, 0u};
    for (int m = gw; m < M_TOK; m += NGW) rms_row_to_bf16(F.in[I_X] + (size_t)m * DM, F.in[I_NMIXW], (bf16*)(F.ws + WS_U) + (size_t)m * DM, F.lane);
    }
    for (int m = gw; m < NBATCH * 256; m += NGW) {
        if (I8_G1) rms_row_to_i8(F.in[I_MEM] + (size_t)m * DM, F.in[I_NMW], (unsigned char*)(F.ws + WS_MN) + (size_t)m * DM, (float*)(F.ws + WS_MSC) + m, F.lane);
        else rms_row_to_bf16(F.in[I_MEM] + (size_t)m * DM, F.in[I_NMW], (bf16*)(F.ws + WS_MN) + (size_t)m * DM, F.lane); }
}

__device__ __forceinline__ s16x4 tr_read(const LAS unsigned char* p) { return __builtin_bit_cast(s16x4, __builtin_amdgcn_ds_read_tr16_b64_v4i16((LAS s16x4*)p)); }
__device__ __forceinline__ bf16x8 cat8(s16x4 a, s16x4 b) { return (bf16x8){a[0], a[1], a[2], a[3], b[0], b[1], b[2], b[3]}; }
__device__ __forceinline__ bf16x8 pack8(f32x4 a, f32x4 b) { v4u w; w.x = cvt_pk_bf16(a[0], a[1]); w.y = cvt_pk_bf16(a[2], a[3]); w.z = cvt_pk_bf16(b[0], b[1]); w.w = cvt_pk_bf16(b[2], b[3]); return __builtin_bit_cast(bf16x8, w); }
#define MFMA16(a, b, c) __builtin_amdgcn_mfma_f32_16x16x32_bf16((a), (b), (c), 0, 0, 0)
#define WG_BAR() do { asm volatile("s_waitcnt vmcnt(0) lgkmcnt(0)" ::: "memory"); __builtin_amdgcn_s_barrier(); asm volatile("" ::: "memory"); } while (0)
constexpr float LOG2E = 1.4426950408889634f;

constexpr int SWA_STR = 144, SWA_IMG = 272 * SWA_STR;
__device__ __forceinline__ void swa_phase(Frame& F) {
    const bf16* P1 = (const bf16*)(F.ws + WS_P1); bf16* ACAT = (bf16*)(F.ws + WS_ACAT);
    LAS unsigned char* Kimg = F.lds; LAS unsigned char* Vimg = F.lds + SWA_IMG;
    const int lane = F.lane, w = F.wave, q = lane & 15, g = lane >> 4;
    for (int u = F.vcu; u < 256; u += F.G) {
        const int b = u >> 5, kvh = (u >> 4) & 1, n = u & 15;
        for (int pc = F.tid; pc < 2 * 272 * 8; pc += 512) {
            const int img = pc >= 272 * 8 ? 1 : 0, p2 = pc - img * 272 * 8, row = p2 >> 3, ch = p2 & 7; const int s = (n - 1) * 128 + row;
            v4u v = (v4u){0u, 0u, 0u, 0u};
            if (row < 256 && s >= 0) v = *(const GAS v4u*)(P1 + (size_t)(b * SEQ + s) * P1C + (img ? C_V : C_K) + kvh * 64 + ch * 8);
            *(LAS v4u*)((img ? Vimg : Kimg) + row * SWA_STR + ch * 16) = v; }
        WG_BAR();
        const int h = kvh * 8 + w; const float slope2 = exp2f(-0.5f * (float)(h + 1)) * LOG2E, sink2 = F.in[I_SINKS][h] * LOG2E;
        f32x4 bias[9];
#pragma unroll
        for (int j = 0; j < 9; ++j)
#pragma unroll
            for (int r = 0; r < 4; ++r) { const int dist = 128 + q - 16 * j - 4 * g - r; const float bv = -slope2 * (float)dist;
                bias[j][r] = (j == 0) ? (dist < 128 ? bv : -INFINITY) : ((j == 8) ? (dist >= 0 ? bv : -INFINITY) : bv); }
        __builtin_amdgcn_sched_barrier(0);
        bf16x8 qn[2];
#pragma unroll
        for (int ks = 0; ks < 2; ++ks) qn[ks] = *(const GAS bf16x8*)(P1 + (size_t)(b * SEQ + n * 128 + q) * P1C + C_Q + h * 64 + 32 * ks + 8 * g);
        __builtin_amdgcn_sched_barrier(0);
#pragma unroll 1
        for (int i = 0; i < 8; ++i) {
            const int t0 = b * SEQ + n * 128 + 16 * i;
            bf16x8 qf[2]; qf[0] = qn[0]; qf[1] = qn[1];
            { const int tn = i < 7 ? t0 + 16 : t0;
#pragma unroll
              for (int ks = 0; ks < 2; ++ks) qn[ks] = *(const GAS bf16x8*)(P1 + (size_t)(tn + q) * P1C + C_Q + h * 64 + 32 * ks + 8 * g); }
            f32x4 s[10];
#pragma unroll
            for (int j = 0; j < 9; ++j) { s[j] = (f32x4){0.f, 0.f, 0.f, 0.f};
#pragma unroll
                for (int ks = 0; ks < 2; ++ks) { const bf16x8 kf = *(const LAS bf16x8*)(Kimg + (16 * (i + j) + q) * SWA_STR + (32 * ks + 8 * g) * 2); s[j] = MFMA16(kf, qf[ks], s[j]); } }
            s[9] = (f32x4){0.f, 0.f, 0.f, 0.f};
            __builtin_amdgcn_sched_barrier(0);
            float mx = sink2;
#pragma unroll
            for (int j = 0; j < 9; ++j) { const bool dead = (n == 0) && (i + j < 8);
#pragma unroll
                for (int r = 0; r < 4; ++r) { const float v = dead ? -INFINITY : s[j][r] * (0.125f * LOG2E) + bias[j][r]; s[j][r] = v; mx = fmaxf(mx, v); } }
            mx = fmaxf(mx, __shfl_xor(mx, 16)); mx = fmaxf(mx, __shfl_xor(mx, 32));
            float sum = 0.f;
#pragma unroll
            for (int j = 0; j < 9; ++j)
#pragma unroll
                for (int r = 0; r < 4; ++r) { const float p = __builtin_amdgcn_exp2f(s[j][r] - mx); s[j][r] = p; sum += p; }
            sum += __shfl_xor(sum, 16); sum += __shfl_xor(sum, 32); sum += __builtin_amdgcn_exp2f(sink2 - mx);
            const float inv = 1.f / sum;
            __builtin_amdgcn_sched_barrier(0);
            f32x4 o[4];
#pragma unroll
            for (int dt = 0; dt < 4; ++dt) o[dt] = (f32x4){0.f, 0.f, 0.f, 0.f};
#pragma unroll
            for (int kk = 0; kk < 5; ++kk) { const bf16x8 pf = pack8(s[2 * kk], s[2 * kk + 1]);
                const LAS unsigned char* vb = Vimg + (16 * (i + 2 * kk) + 4 * g + (q >> 2)) * SWA_STR + (4 * (q & 3)) * 2;
#pragma unroll
                for (int dt = 0; dt < 4; ++dt) { const bf16x8 vf = cat8(tr_read(vb + dt * 32), tr_read(vb + dt * 32 + 16 * SWA_STR)); o[dt] = MFMA16(vf, pf, o[dt]); } }
#pragma unroll
            for (int dt = 0; dt < 4; ++dt) {
                if (FP8_G2) *(GAS unsigned*)((unsigned char*)ACAT + (size_t)(t0 + q) * 3072 + h * 64 + 16 * dt + 4 * g) = pg8::pk4_fp8(o[dt][0] * inv, o[dt][1] * inv, o[dt][2] * inv, o[dt][3] * inv);
                else { v2u wv; wv.x = cvt_pk_bf16(o[dt][0] * inv, o[dt][1] * inv); wv.y = cvt_pk_bf16(o[dt][2] * inv, o[dt][3] * inv);
                    *(GAS v2u*)(ACAT + (size_t)(t0 + q) * 3072 + h * 64 + 16 * dt + 4 * g) = wv; } }
        }
        WG_BAR();
    }
}

__device__ __forceinline__ void ssd_tables(Frame& F, int b, int c, int g) {
    const float* DT = (const float*)(F.ws + WS_DT); LAS float* dt_s = (LAS float*)(F.lds + TAB_DT); LAS float* ac_s = (LAS float*)(F.lds + TAB_ACUM);
    const int hh = F.wave, h = 8 * g + hh, lane = F.lane; const float A = -expf(F.in[I_ALOG][h]) * LOG2E, dtb = F.in[I_DTB][h];
    const int tok = b * SEQ + c * 128 + 2 * lane;
    float d0 = DT[(size_t)tok * 32 + h] + dtb, d1 = DT[(size_t)(tok + 1) * 32 + h] + dtb;
    d0 = d0 > 20.f ? d0 : log1pf(expf(d0)); d1 = d1 > 20.f ? d1 : log1pf(expf(d1));
    const float a0 = d0 * A, a1 = d1 * A; float run = a0 + a1;
#pragma unroll
    for (int o = 1; o < 64; o <<= 1) { const float t = __shfl_up(run, o); if (lane >= o) run += t; }
    dt_s[hh * 128 + 2 * lane] = d0; dt_s[hh * 128 + 2 * lane + 1] = d1; ac_s[hh * 128 + 2 * lane] = run - a1; ac_s[hh * 128 + 2 * lane + 1] = run;
}
template <int NR>
__device__ __forceinline__ void conv_load(const bf16* P1, int b, int s0, int c0, v4u (&x)[NR + 3]) {
    const bf16* base = P1 + (size_t)(b * SEQ) * P1C + C_X + c0;
#pragma unroll
    for (int i = 0; i < NR + 3; ++i) { const int ss = s0 - 3 + i; x[i] = (v4u){0u, 0u, 0u, 0u}; if (ss >= 0) x[i] = *(const GAS v4u*)(base + (size_t)ss * P1C); }
}
template <int NR, class Emit>
__device__ __forceinline__ void conv_apply(const v4u (&x)[NR + 3], const float* cw, const float* cb, int c0, Emit&& emit) {
    float wt[4][8], bs[8];
    { const f32x4 b0 = *(const f32x4*)(cb + c0), b1 = *(const f32x4*)(cb + c0 + 4); bs[0] = b0[0]; bs[1] = b0[1]; bs[2] = b0[2]; bs[3] = b0[3]; bs[4] = b1[0]; bs[5] = b1[1]; bs[6] = b1[2]; bs[7] = b1[3]; }
#pragma unroll
    for (int j = 0; j < 4; ++j) { const f32x4 w0 = *(const f32x4*)(cw + j * 3072 + c0), w1 = *(const f32x4*)(cw + j * 3072 + c0 + 4);
        wt[j][0] = w0[0]; wt[j][1] = w0[1]; wt[j][2] = w0[2]; wt[j][3] = w0[3]; wt[j][4] = w1[0]; wt[j][5] = w1[1]; wt[j][6] = w1[2]; wt[j][7] = w1[3]; }
#pragma unroll
    for (int r = 0; r < NR; ++r) { float a[8];
#pragma unroll
        for (int k = 0; k < 8; ++k) a[k] = bs[k];
#pragma unroll
        for (int j = 0; j < 4; ++j) { const v4u xv = x[r + j];
            a[0] += wt[j][0] * bflo(xv.x); a[1] += wt[j][1] * bfhi(xv.x); a[2] += wt[j][2] * bflo(xv.y); a[3] += wt[j][3] * bfhi(xv.y); a[4] += wt[j][4] * bflo(xv.z); a[5] += wt[j][5] * bfhi(xv.z); a[6] += wt[j][6] * bflo(xv.w); a[7] += wt[j][7] * bfhi(xv.w); }
#pragma unroll
        for (int k = 0; k < 8; ++k) a[k] = a[k] * pg8::fsigmoid(a[k]);
        emit(r, a); }
}
template <int NR, class Emit>
__device__ __forceinline__ void conv_rows(const bf16* P1, const float* cw, const float* cb, int b, int s0, int c0, Emit&& emit) {
    v4u x[NR + 3]; conv_load<NR>(P1, b, s0, c0, x); conv_apply<NR>(x, cw, cb, c0, emit);
}
__device__ __forceinline__ v4u pack8u(const float (&v)[8], float sc) { return (v4u){cvt_pk_bf16(v[0] * sc, v[1] * sc), cvt_pk_bf16(v[2] * sc, v[3] * sc), cvt_pk_bf16(v[4] * sc, v[5] * sc), cvt_pk_bf16(v[6] * sc, v[7] * sc)}; }

constexpr int SB_STR = 272, SX_STR = 528;
__device__ __forceinline__ void ssd_states_phase(Frame& F) {
    const bf16* P1 = (const bf16*)(F.ws + WS_P1); bf16* ST = (bf16*)(F.ws + WS_ST); float* CDEC = (float*)(F.ws + WS_CDEC);
    const float* cw = F.in[I_CONVW]; const float* cb = F.in[I_CONVB];
    LAS unsigned char* Bimg = F.lds; LAS unsigned char* Ximg = F.lds + 128 * SB_STR;
    LAS float* dt_s = (LAS float*)(F.lds + TAB_DT); LAS float* ac_s = (LAS float*)(F.lds + TAB_ACUM);
    const int lane = F.lane, w = F.wave, q = lane & 15, g4 = lane >> 4;
    for (int u = F.vcu; u < 512; u += F.G) {
        const int b = u >> 6, c = (u >> 2) & 15, g = u & 3;
        if (c == 15) continue;
        ssd_tables(F, b, c, g);
        { const int ch = F.tid & 15, l0 = (F.tid >> 4) * 4;
          conv_rows<4>(P1, cw, cb, b, c * 128 + l0, 2048 + 128 * g + 8 * ch, [&](int r, const float (&v)[8]) { *(LAS v4u*)(Bimg + (l0 + r) * SB_STR + ch * 16) = pack8u(v, 1.f); }); }
        WG_BAR();
        if (F.tid < 8) CDEC[(b * 16 + c) * 32 + 8 * g + F.tid] = __builtin_amdgcn_exp2f(ac_s[F.tid * 128 + 127]);
#pragma unroll 1
        for (int half = 0; half < 2; ++half) {
            { const int ch = F.tid & 31, l0 = (F.tid >> 5) * 8, hh = half * 4 + (ch >> 3); const float aend = ac_s[hh * 128 + 127];
              conv_rows<8>(P1, cw, cb, b, c * 128 + l0, 512 * g + 256 * half + 8 * ch, [&](int r, const float (&v)[8]) {
                  const float sc = dt_s[hh * 128 + l0 + r] * __builtin_amdgcn_exp2f(aend - ac_s[hh * 128 + l0 + r]);
                  *(LAS v4u*)(Ximg + (l0 + r) * SX_STR + ch * 16) = pack8u(v, sc); }); }
            WG_BAR();
            const int hl = w >> 1, nt0 = (w & 1) * 4;
            f32x4 acc[4][4];
#pragma unroll
            for (int a = 0; a < 4; ++a)
#pragma unroll
                for (int p = 0; p < 4; ++p) acc[a][p] = (f32x4){0.f, 0.f, 0.f, 0.f};
#pragma unroll
            for (int ks = 0; ks < 4; ++ks) {
                const int lrow = 32 * ks + 8 * g4 + (q >> 2);
                bf16x8 bf[4], xf[4];
#pragma unroll
                for (int a = 0; a < 4; ++a) { const LAS unsigned char* p = Bimg + lrow * SB_STR + (16 * (nt0 + a) + 4 * (q & 3)) * 2; bf[a] = cat8(tr_read(p), tr_read(p + 4 * SB_STR)); }
#pragma unroll
                for (int p4 = 0; p4 < 4; ++p4) { const LAS unsigned char* p = Ximg + lrow * SX_STR + (64 * hl + 16 * p4 + 4 * (q & 3)) * 2; xf[p4] = cat8(tr_read(p), tr_read(p + 4 * SX_STR)); }
#pragma unroll
                for (int a = 0; a < 4; ++a)
#pragma unroll
                    for (int p4 = 0; p4 < 4; ++p4) acc[a][p4] = MFMA16(bf[a], xf[p4], acc[a][p4]);
            }
            bf16* stp = ST + ((size_t)((b * 16 + c) * 32 + 8 * g + half * 4 + hl)) * 8192;
#pragma unroll
            for (int a = 0; a < 4; ++a)
#pragma unroll
                for (int p4 = 0; p4 < 4; ++p4) { v2u wv; wv.x = cvt_pk_bf16(acc[a][p4][0], acc[a][p4][1]); wv.y = cvt_pk_bf16(acc[a][p4][2], acc[a][p4][3]);
                    *(GAS v2u*)(stp + (16 * p4 + q) * 128 + 16 * (nt0 + a) + 4 * g4) = wv; }
            WG_BAR();
        }
    }
}
__device__ __forceinline__ void ssd_scan_phase(Frame& F) {
    const bf16* ST = (const bf16*)(F.ws + WS_ST); bf16* PREV = (bf16*)(F.ws + WS_PREV); const float* CDEC = (const float*)(F.ws + WS_CDEC);
    for (int it = F.vcu * 512 + F.tid; it < 8 * 32 * 1024; it += F.G * 512) {
        const int b = it >> 15, h = (it >> 10) & 31, e8 = it & 1023; float carry[8];
#pragma unroll
        for (int k = 0; k < 8; ++k) carry[k] = 0.f;
#pragma unroll 5
        for (int c = 0; c < 16; ++c) { const size_t off = ((size_t)((b * 16 + c) * 32 + h)) * 8192 + e8 * 8;
            *(GAS v4u*)(PREV + off) = (v4u){cvt_pk_bf16(carry[0], carry[1]), cvt_pk_bf16(carry[2], carry[3]), cvt_pk_bf16(carry[4], carry[5]), cvt_pk_bf16(carry[6], carry[7])};
            if (c < 15) { const float dec = CDEC[(b * 16 + c) * 32 + h]; const v4u s = *(const GAS v4u*)(ST + off);
                carry[0] = carry[0] * dec + bflo(s.x); carry[1] = carry[1] * dec + bfhi(s.x); carry[2] = carry[2] * dec + bflo(s.y); carry[3] = carry[3] * dec + bfhi(s.y);
                carry[4] = carry[4] * dec + bflo(s.z); carry[5] = carry[5] * dec + bfhi(s.z); carry[6] = carry[6] * dec + bflo(s.w); carry[7] = carry[7] * dec + bfhi(s.w); } }
    }
}
constexpr int SXF_STR = 1040;
__device__ __forceinline__ void ssd_out_phase(Frame& F) {
    const bf16* P1 = (const bf16*)(F.ws + WS_P1); const bf16* PREV = (const bf16*)(F.ws + WS_PREV); bf16* ACAT = (bf16*)(F.ws + WS_ACAT);
    const float* cw = F.in[I_CONVW]; const float* cb = F.in[I_CONVB];
    LAS unsigned char* Bimg = F.lds; LAS unsigned char* Cimg = F.lds + 128 * SB_STR; LAS unsigned char* Ximg = F.lds;
    LAS float* dt_s = (LAS float*)(F.lds + TAB_DT); LAS float* ac_s = (LAS float*)(F.lds + TAB_ACUM);
    const int lane = F.lane, w = F.wave, q = lane & 15, g4 = lane >> 4;
    for (int u = F.vcu; u < 512; u += F.G) {
        const int b = u >> 6, c = (u >> 2) & 15, g = u & 3;
        ssd_tables(F, b, c, g);
        { const int ch = F.tid & 31, l0 = (F.tid >> 5) * 8; LAS unsigned char* img = ch >= 16 ? Cimg : Bimg;
          conv_rows<8>(P1, cw, cb, b, c * 128 + l0, 2048 + (ch >= 16 ? 512 : 0) + 128 * g + 8 * (ch & 15), [&](int r, const float (&v)[8]) { *(LAS v4u*)(img + (l0 + r) * SB_STR + (ch & 15) * 16) = pack8u(v, 1.f); }); }
        const int xch = F.tid & 63, xl0 = (F.tid >> 6) * 16;
        v4u x0[11]; conv_load<8>(P1, b, c * 128 + xl0, 512 * g + 8 * xch, x0);
        const int lq = 16 * w + q; const int tok = b * SEQ + c * 128 + lq;
        const bf16* pvb = PREV + ((size_t)((b * 16 + c) * 32 + 8 * g)) * 8192 + q * 128 + 8 * g4;
        const bf16* zb = P1 + (size_t)tok * P1C + C_Z + 512 * g + 4 * g4;
        asm volatile("s_waitcnt lgkmcnt(0)" ::: "memory"); __builtin_amdgcn_s_barrier(); asm volatile("" ::: "memory");
        bf16x8 cfr[4];
#pragma unroll
        for (int ks = 0; ks < 4; ++ks) cfr[ks] = *(const LAS bf16x8*)(Cimg + (16 * w + q) * SB_STR + (32 * ks + 8 * g4) * 2);
        f32x4 cbt[8];
#pragma unroll
        for (int st = 0; st < 8; ++st) { cbt[st] = (f32x4){0.f, 0.f, 0.f, 0.f};
            if (st <= w) {
#pragma unroll
                for (int ks = 0; ks < 4; ++ks) { const bf16x8 bfr = *(const LAS bf16x8*)(Bimg + (16 * st + q) * SB_STR + (32 * ks + 8 * g4) * 2); cbt[st] = MFMA16(bfr, cfr[ks], cbt[st]); } } }
        asm volatile("s_waitcnt lgkmcnt(0)" ::: "memory"); __builtin_amdgcn_s_barrier(); asm volatile("" ::: "memory");
        conv_apply<8>(x0, cw, cb, 512 * g + 8 * xch, [&](int r, const float (&v)[8]) { *(LAS v4u*)(Ximg + (xl0 + r) * SXF_STR + xch * 16) = pack8u(v, 1.f); });
        conv_rows<8>(P1, cw, cb, b, c * 128 + xl0 + 8, 512 * g + 8 * xch, [&](int r, const float (&v)[8]) { *(LAS v4u*)(Ximg + (xl0 + 8 + r) * SXF_STR + xch * 16) = pack8u(v, 1.f); });
        bf16x8 pfc[16]; v2u zc[4];
#pragma unroll
        for (int ks = 0; ks < 4; ++ks)
#pragma unroll
            for (int p4 = 0; p4 < 4; ++p4) pfc[ks * 4 + p4] = *(const GAS bf16x8*)(pvb + (16 * p4) * 128 + 32 * ks);
#pragma unroll
        for (int p4 = 0; p4 < 4; ++p4) zc[p4] = *(const GAS v2u*)(zb + 16 * p4);
        asm volatile("s_waitcnt lgkmcnt(0)" ::: "memory"); __builtin_amdgcn_s_barrier(); asm volatile("" ::: "memory");
        float ssq = 0.f;
#pragma unroll 1
        for (int hh = 0; hh < 8; ++hh) {
            const int h = 8 * g + hh; const float al = ac_s[hh * 128 + lq];
            const int hn = hh < 7 ? hh + 1 : 7;
            v2u zn[4];
#pragma unroll
            for (int p4 = 0; p4 < 4; ++p4) zn[p4] = *(const GAS v2u*)(zb + 64 * hn + 16 * p4);
            f32x4 y[4];
#pragma unroll
            for (int p4 = 0; p4 < 4; ++p4) y[p4] = (f32x4){0.f, 0.f, 0.f, 0.f};
#pragma unroll
            for (int ks = 0; ks < 4; ++ks)
#pragma unroll
                for (int p4 = 0; p4 < 4; ++p4) y[p4] = MFMA16(pfc[ks * 4 + p4], cfr[ks], y[p4]);
#pragma unroll
            for (int ks = 0; ks < 4; ++ks)
#pragma unroll
                for (int p4 = 0; p4 < 4; ++p4) pfc[ks * 4 + p4] = *(const GAS bf16x8*)(pvb + (size_t)hn * 8192 + (16 * p4) * 128 + 32 * ks);
            __builtin_amdgcn_sched_barrier(0);
            const float ea = __builtin_amdgcn_exp2f(al);
#pragma unroll
            for (int p4 = 0; p4 < 4; ++p4) y[p4] *= ea;
#pragma unroll
            for (int kk = 0; kk < 4; ++kk) {
                if (2 * kk <= w) {
                    f32x4 m0, m1;
                    { const int st = 2 * kk; const f32x4 as = *(const LAS f32x4*)(ac_s + hh * 128 + 16 * st + 4 * g4), ds = *(const LAS f32x4*)(dt_s + hh * 128 + 16 * st + 4 * g4);
#pragma unroll
                        for (int r = 0; r < 4; ++r) { const int s = 16 * st + 4 * g4 + r; m0[r] = s <= lq ? cbt[st][r] * __builtin_amdgcn_exp2f(al - as[r]) * ds[r] : 0.f; } }
                    { const int st = 2 * kk + 1; const f32x4 as = *(const LAS f32x4*)(ac_s + hh * 128 + 16 * st + 4 * g4), ds = *(const LAS f32x4*)(dt_s + hh * 128 + 16 * st + 4 * g4);
#pragma unroll
                        for (int r = 0; r < 4; ++r) { const int s = 16 * st + 4 * g4 + r; m1[r] = (st <= w && s <= lq) ? cbt[st][r] * __builtin_amdgcn_exp2f(al - as[r]) * ds[r] : 0.f; } }
                    const bf16x8 mf = pack8(m0, m1);
                    const LAS unsigned char* xb = Ximg + (32 * kk + 4 * g4 + (q >> 2)) * SXF_STR + (64 * hh + 4 * (q & 3)) * 2;
#pragma unroll
                    for (int p4 = 0; p4 < 4; ++p4) { const bf16x8 xf = cat8(tr_read(xb + p4 * 32), tr_read(xb + p4 * 32 + 16 * SXF_STR)); y[p4] = MFMA16(xf, mf, y[p4]); }
                }
            }
            const float Dh = F.in[I_DSKIP][h];
#pragma unroll
            for (int p4 = 0; p4 < 4; ++p4) { const int ch = 64 * hh + 16 * p4 + 4 * g4;
                const v2u xv = *(const LAS v2u*)(Ximg + lq * SXF_STR + ch * 2); const v2u zv = zc[p4];
                const float v0 = (y[p4][0] + bflo(xv.x) * Dh) * bflo(zv.x), v1 = (y[p4][1] + bfhi(xv.x) * Dh) * bfhi(zv.x), v2 = (y[p4][2] + bflo(xv.y) * Dh) * bflo(zv.y), v3 = (y[p4][3] + bfhi(xv.y) * Dh) * bfhi(zv.y);
                ssq += (v0 * v0 + v1 * v1) + (v2 * v2 + v3 * v3);
                if (FP8_G2) *(GAS unsigned*)((unsigned char*)ACAT + (size_t)tok * 3072 + 1024 + 512 * g + ch) = pg8::pk4_fp8(v0, v1, v2, v3);
                else { v2u o; o.x = cvt_pk_bf16(v0, v1); o.y = cvt_pk_bf16(v2, v3);
                    *(GAS v2u*)(ACAT + (size_t)tok * 3072 + 1024 + 512 * g + ch) = o; } }
#pragma unroll
            for (int p4 = 0; p4 < 4; ++p4) zc[p4] = zn[p4];
        }
        ssq += __shfl_xor(ssq, 16); ssq += __shfl_xor(ssq, 32);
        if (g4 == 0) ((float*)(F.ws + WS_SSQG))[(size_t)tok * 4 + g] = ssq;
        WG_BAR();
    }
}

constexpr int CX_STR = 528;
__device__ __forceinline__ void cross_units(Frame& F, int u_begin, int u_end, int u_step) {
    const bf16* QC = (const bf16*)(F.ws + WS_QC); const bf16* KVC = (const bf16*)(F.ws + WS_KVC); bf16* OC = (bf16*)(F.ws + WS_OC);
    LAS unsigned char* img = F.lds; const int lane = F.lane, w = F.wave, q = lane & 15, g = lane >> 4;
    for (int u = u_begin; u < u_end; u += u_step) {
        const int b = u >> 6, hd = (u >> 4) & 3, qb = u & 15; const int t0 = b * SEQ + qb * 128 + 16 * w;
#pragma unroll 1
        for (int pb = 0; pb < 2; ++pb) { v4u tmp[8];
#pragma unroll
            for (int i = 0; i < 8; ++i) { const int pc = F.tid + 512 * (pb * 8 + i), row = pc >> 5, ch = pc & 31; tmp[i] = *(const GAS v4u*)(KVC + (size_t)(b * 256 + row) * 2048 + hd * 256 + ch * 8); }
#pragma unroll
            for (int i = 0; i < 8; ++i) { const int pc = F.tid + 512 * (pb * 8 + i), row = pc >> 5, ch = pc & 31; *(LAS v4u*)(img + row * CX_STR + ch * 16) = tmp[i]; } }
        bf16x8 qf[8];
#pragma unroll
        for (int ks = 0; ks < 8; ++ks) qf[ks] = *(const GAS bf16x8*)(QC + (size_t)(t0 + q) * 1024 + hd * 256 + 32 * ks + 8 * g);
        WG_BAR();
        f32x4 s[16];
#pragma unroll
        for (int kt = 0; kt < 16; ++kt) { s[kt] = (f32x4){0.f, 0.f, 0.f, 0.f};
#pragma unroll
            for (int ks = 0; ks < 8; ++ks) { const bf16x8 kf = *(const LAS bf16x8*)(img + (16 * kt + q) * CX_STR + (32 * ks + 8 * g) * 2); s[kt] = MFMA16(kf, qf[ks], s[kt]); } }
        float mx = -INFINITY;
#pragma unroll
        for (int kt = 0; kt < 16; ++kt)
#pragma unroll
            for (int r = 0; r < 4; ++r) { s[kt][r] *= 0.0625f * LOG2E; mx = fmaxf(mx, s[kt][r]); }
        mx = fmaxf(mx, __shfl_xor(mx, 16)); mx = fmaxf(mx, __shfl_xor(mx, 32));
        float sum = 0.f;
#pragma unroll
        for (int kt = 0; kt < 16; ++kt)
#pragma unroll
            for (int r = 0; r < 4; ++r) { const float p = __builtin_amdgcn_exp2f(s[kt][r] - mx); s[kt][r] = p; sum += p; }
        sum += __shfl_xor(sum, 16); sum += __shfl_xor(sum, 32);
        const float inv = 1.f / sum;
        bf16x8 pf[8];
#pragma unroll
        for (int kk = 0; kk < 8; ++kk) pf[kk] = pack8(s[2 * kk], s[2 * kk + 1]);
        WG_BAR();
#pragma unroll 1
        for (int pb = 0; pb < 2; ++pb) { v4u tmp[8];
#pragma unroll
            for (int i = 0; i < 8; ++i) { const int pc = F.tid + 512 * (pb * 8 + i), row = pc >> 5, ch = pc & 31; tmp[i] = *(const GAS v4u*)(KVC + (size_t)(b * 256 + row) * 2048 + 1024 + hd * 256 + ch * 8); }
#pragma unroll
            for (int i = 0; i < 8; ++i) { const int pc = F.tid + 512 * (pb * 8 + i), row = pc >> 5, ch = pc & 31; *(LAS v4u*)(img + row * CX_STR + ch * 16) = tmp[i]; } }
        WG_BAR();
#pragma unroll 1
        for (int dh = 0; dh < 2; ++dh) {
            f32x4 o[8];
#pragma unroll
            for (int d = 0; d < 8; ++d) o[d] = (f32x4){0.f, 0.f, 0.f, 0.f};
#pragma unroll
            for (int kk = 0; kk < 8; ++kk) { const LAS unsigned char* vb = img + (32 * kk + 4 * g + (q >> 2)) * CX_STR + (128 * dh + 4 * (q & 3)) * 2;
#pragma unroll
                for (int d = 0; d < 8; ++d) { const bf16x8 vf = cat8(tr_read(vb + d * 32), tr_read(vb + d * 32 + 16 * CX_STR)); o[d] = MFMA16(vf, pf[kk], o[d]); } }
#pragma unroll
            for (int d = 0; d < 8; ++d) {
                if (FP8_G6) *(GAS unsigned*)((unsigned char*)OC + (size_t)(t0 + q) * 1024 + hd * 256 + 128 * dh + 16 * d + 4 * g) = pg8::pk4_fp8(o[d][0] * inv, o[d][1] * inv, o[d][2] * inv, o[d][3] * inv);
                else { v2u wv; wv.x = cvt_pk_bf16(o[d][0] * inv, o[d][1] * inv); wv.y = cvt_pk_bf16(o[d][2] * inv, o[d][3] * inv);
                    *(GAS v2u*)(OC + (size_t)(t0 + q) * 1024 + hd * 256 + 128 * dh + 16 * d + 4 * g) = wv; } }
        }
        WG_BAR();
    }
}

__device__ __forceinline__ void router_phase(Frame& F) {
    const bf16* T = (const bf16*)(F.ws + WS_T); const bf16* WR = (const bf16*)(F.ws + WS_WR); const float* ssq = (const float*)(F.ws + WS_SSQ2);
    int* tok_e = (int*)(F.ws + WS_TOKE); int* tok_p = (int*)(F.ws + WS_TOKP); float* tok_w = (float*)(F.ws + WS_TOKW); int* rowmap = (int*)(F.ws + WS_ROWMAP);
    LAS int* hist = (LAS int*)(F.lds + TAB_TE); LAS int* base = hist + 32;
    const int lane = F.lane, q = lane & 15, g = lane >> 4;
    for (int tb = F.vcu; tb * 4 < M_TOK / 16; tb += F.G) {
        if (F.tid < 32) hist[F.tid] = 0;
        __syncthreads();
        const int tile = tb * 4 + F.wave; const bool live = F.wave < 4;
        int ei[4] = {0, 0, 0, 0}, lp[4] = {0, 0, 0, 0}; float wv[4] = {0.f, 0.f, 0.f, 0.f}; float rs = 0.f; const int t0 = tile * 16;
        if (live) {
            f32x4 a0 = (f32x4){0.f, 0.f, 0.f, 0.f}, a1 = a0;
#pragma unroll 8
            for (int ks = 0; ks < 32; ++ks) { const bf16x8 tf = *(const GAS bf16x8*)(T + (size_t)(t0 + q) * 1024 + 32 * ks + 8 * g);
                const bf16x8 w0 = *(const GAS bf16x8*)(WR + (size_t)q * 1024 + 32 * ks + 8 * g), w1 = *(const GAS bf16x8*)(WR + (size_t)(16 + q) * 1024 + 32 * ks + 8 * g);
                a0 = MFMA16(w0, tf, a0); a1 = MFMA16(w1, tf, a1); }
            rs = pg8::row_rstd(ssq, t0 + q); const float* br = F.in[I_BR];
            float lv[8];
#pragma unroll
            for (int r = 0; r < 4; ++r) { lv[r] = a0[r] * rs + br[4 * g + r]; lv[4 + r] = a1[r] * rs + br[16 + 4 * g + r]; }
            float ev[4];
#pragma unroll
            for (int k = 0; k < 4; ++k) {
                float bv = -INFINITY; int bi = 0;
#pragma unroll
                for (int r = 0; r < 8; ++r) { const int e = (r < 4 ? 0 : 16) + 4 * g + (r & 3); if (lv[r] > bv) { bv = lv[r]; bi = e; } }
#pragma unroll
                for (int o = 16; o <= 32; o <<= 1) { const float ov = __shfl_xor(bv, o); const int oi = __shfl_xor(bi, o); if (ov > bv || (ov == bv && oi < bi)) { bv = ov; bi = oi; } }
                ei[k] = bi; ev[k] = bv;
#pragma unroll
                for (int r = 0; r < 8; ++r) { const int e = (r < 4 ? 0 : 16) + 4 * g + (r & 3); if (e == bi) lv[r] = -INFINITY; }
            }
            float sum = 0.f;
#pragma unroll
            for (int k = 0; k < 4; ++k) { wv[k] = expf(ev[k] - ev[0]); sum += wv[k]; }
            const float inv = 1.f / sum;
#pragma unroll
            for (int k = 0; k < 4; ++k) wv[k] *= inv;
            if (g == 0) {
#pragma unroll
                for (int k = 0; k < 4; ++k) lp[k] = __hip_atomic_fetch_add(hist + ei[k], 1, __ATOMIC_RELAXED, __HIP_MEMORY_SCOPE_WORKGROUP); }
        }
        __syncthreads();
        if (F.tid < 32) { const int hcnt = hist[F.tid]; base[F.tid] = hcnt > 0 ? (int)__hip_atomic_fetch_add((unsigned*)(F.ctl + CW_CNT + 64 * F.tid), (unsigned)hcnt, RLX_AGENT) : 0; }
        __syncthreads();
        if (live && g == 0) { const int tok = t0 + q;
#pragma unroll
            for (int k = 0; k < 4; ++k) { const int pos = base[ei[k]] + lp[k];
                *(int2*)(rowmap + 2 * (ei[k] * 16384 + pos)) = make_int2(tok, __float_as_int(rs)); tok_e[tok * 4 + k] = ei[k]; tok_p[tok * 4 + k] = pos; tok_w[tok * 4 + k] = wv[k]; } }
        __syncthreads();
    }
}
__device__ __forceinline__ int moe_tables(Frame& F) {
    LAS int* tile_e = (LAS int*)(F.lds + TAB_TE); LAS int* tile_p0 = (LAS int*)(F.lds + TAB_TP0); LAS int* cnt_s = (LAS int*)(F.lds + TAB_CNT); LAS int* tb = (LAS int*)(F.lds + TAB_TB); LAS int* ntp = (LAS int*)(F.lds + TAB_NT);
    __syncthreads();
    if (F.tid < 32) cnt_s[F.tid] = (int)__hip_atomic_load((unsigned*)(F.ctl + CW_CNT + 64 * F.tid), RLX_AGENT);
    __syncthreads();
    if (F.tid == 0) { int j = 0; for (int e = 0; e < 32; ++e) { tb[e] = j; const int c = cnt_s[e]; for (int p = 0; p < c && j < 320; p += 256) { tile_e[j] = e; tile_p0[j] = p; ++j; } } ntp[0] = j; }
    __syncthreads();
    return ntp[0];
}
__device__ __forceinline__ void combine_phase(Frame& F) {
    const bf16* H2 = (const bf16*)(F.ws + WS_H2); const unsigned char* Y = (const unsigned char*)(F.ws + WS_Y);
    const int* tok_e = (const int*)(F.ws + WS_TOKE); const int* tok_p = (const int*)(F.ws + WS_TOKP); const float* tok_w = (const float*)(F.ws + WS_TOKW);
    LAS int* tb = (LAS int*)(F.lds + TAB_TB); const float* fw = F.in[I_FNW];
    const int lane = F.lane; const int gw = F.vcu * NWAVES + F.wave, NGW = F.G * NWAVES;
    constexpr int NT = 4;
    for (int tok0 = NT * gw; tok0 < M_TOK; tok0 += NT * NGW) {
        f32x4 v[NT][4]; size_t slot[NT][4]; float wk[NT][4];
#pragma unroll
        for (int t = 0; t < NT; ++t)
#pragma unroll
            for (int k = 0; k < 4; ++k) { const int tok = tok0 + t; const int e = tok_e[tok * 4 + k]; slot[t][k] = (size_t)tb[e] * 256 + tok_p[tok * 4 + k]; wk[t][k] = tok_w[tok * 4 + k]; }
        v2u hv[NT][4]; unsigned y[NT][4][4];
#pragma unroll
        for (int t = 0; t < NT; ++t)
#pragma unroll
            for (int j = 0; j < 4; ++j) hv[t][j] = *(const GAS v2u*)(H2 + (size_t)(tok0 + t) * 1024 + 4 * lane + 256 * j);
#pragma unroll
        for (int t = 0; t < NT; ++t)
#pragma unroll
            for (int k = 0; k < 4; ++k)
#pragma unroll
                for (int j = 0; j < 4; ++j) y[t][k][j] = *(const GAS unsigned*)(Y + slot[t][k] * 1024 + 4 * lane + 256 * j);
#pragma unroll
        for (int t = 0; t < NT; ++t) {
#pragma unroll
            for (int j = 0; j < 4; ++j) v[t][j] = (f32x4){bflo(hv[t][j].x), bfhi(hv[t][j].x), bflo(hv[t][j].y), bfhi(hv[t][j].y)};
#pragma unroll
            for (int k = 0; k < 4; ++k)
#pragma unroll
                for (int j = 0; j < 4; ++j) { const f32x2 lo = __builtin_amdgcn_cvt_pk_f32_fp8((int)y[t][k][j], false), hi = __builtin_amdgcn_cvt_pk_f32_fp8((int)y[t][k][j], true);
                    v[t][j][0] += wk[t][k] * lo[0]; v[t][j][1] += wk[t][k] * lo[1]; v[t][j][2] += wk[t][k] * hi[0]; v[t][j][3] += wk[t][k] * hi[1]; } }
#pragma unroll
        for (int t = 0; t < NT; ++t) { float s = 0.f;
#pragma unroll
            for (int j = 0; j < 4; ++j) s += (v[t][j][0] * v[t][j][0] + v[t][j][1] * v[t][j][1]) + (v[t][j][2] * v[t][j][2] + v[t][j][3] * v[t][j][3]);
            const float rstd = 1.f / sqrtf(wave_sum(s) * (1.f / 1024.f) + 1e-5f);
#pragma unroll
            for (int j = 0; j < 4; ++j) { const f32x4 g = *(const f32x4*)(fw + 4 * lane + 256 * j); *(GAS f32x4*)(F.out + (size_t)(tok0 + t) * 1024 + 4 * lane + 256 * j) = v[t][j] * rstd * g; } }
    }
}
#ifndef MK_NPH
#define MK_NPH 14
#endif
struct Args { const float* in[29]; float* out; unsigned char* ws; int ph_lo, ph_hi; };
__global__ void __launch_bounds__(NWAVES * 64, 2) mega_fwd(Args args) {
    extern __shared__ __attribute__((aligned(16))) unsigned char lds_raw[];
    Frame F;
    F.lds = (LAS unsigned char*)lds_raw;
    F.tid = threadIdx.x; F.lane = F.tid & 63; F.wave = __builtin_amdgcn_readfirstlane(F.tid >> 6);
    F.G = gridDim.x; { const int bx = blockIdx.x; F.vcu = (F.G % 8 == 0) ? (bx % 8) * (F.G / 8) + bx / 8 : bx; }
    F.ws = args.ws; F.ctl = (gu32*)(args.ws + WS_CTL); F.out = args.out;
    F.in = (const __attribute__((address_space(4))) fptr_t*)__builtin_amdgcn_kernarg_segment_ptr();
    for (int u = F.tid; u < (LDS_BYTES - TAB_OFF) / 4; u += NWAVES * 64) ((LAS unsigned*)(F.lds + TAB_OFF))[u] = 0u;
    __syncthreads();
    const int lo = args.ph_lo, hi = args.ph_hi;
    XcdBarrier bar; bar.bar = (unsigned*)(F.ctl + CW_BAR); bar.x = 0; bar.st = nullptr;
    if (hi - lo > 1) bar = xcd_barrier_post((unsigned*)(F.ctl + CW_BAR), (volatile LAS unsigned*)(F.lds + TAB_MISC) + 8);
#ifndef MK_PHMASK
#define MK_PHMASK 0x3fff
#endif
#define IN(k) (((MK_PHMASK >> (k)) & 1) && lo <= (k) && (k) < hi)
#define SEAM(k) do { if (IN(k) && IN((k) + 1)) xcd_barrier(bar); } while (0)
    const int c = (int)blockIdx.x;

    if (IN(0)) { p0_prologue(F); } SEAM(0);
    if (IN(1)) {
        { constexpr int ES = I8_G1 ? 1 : 2; typedef pg8::EpiP1<I8_G1 != 0> EpiT;
          pg8::SchedLin S{M_TOK / 256, N1 / 256, F.G, c, DM, (const bf16*)(F.ws + WS_W1T), DM, ES};
          EpiT E{(bf16*)(F.ws + WS_P1), P1C, (float*)(F.ws + WS_DT), F.in[I_BGATE], (const float*)(F.ws + WS_USC), (const float*)(F.ws + WS_CSC)};
          pg8::gemm_phase<EpiT, pg8::SchedLin, true, ES, I8_G1 != 0>(F.lds, (const char*)(F.ws + WS_U), DM, S, E); }
        if (I8_G1) { pg8::SchedLin S{NBATCH * 256 / 256, 2048 / 256, F.G, (c + 128) % F.G, DM, (const bf16*)(F.ws + WS_WCKV), DM, 1};
          pg8::EpiI8 E{(bf16*)(F.ws + WS_KVC), 2048, (const float*)(F.ws + WS_MSC), (const float*)(F.ws + WS_KSC)};
          pg8::gemm_phase<pg8::EpiI8, pg8::SchedLin, true, 1, true>(F.lds, (const char*)(F.ws + WS_MN), DM, S, E); }
        else { pg8::SchedLin S{NBATCH * 256 / 256, 2048 / 256, F.G, (c + 128) % F.G, DM, (const bf16*)(F.ws + WS_WCKV), DM};
          pg8::EpiBf16S E{(bf16*)(F.ws + WS_KVC), 2048, nullptr, 1.f};
          pg8::gemm_phase<pg8::EpiBf16S, pg8::SchedLin, true>(F.lds, (const char*)(F.ws + WS_MN), DM, S, E); }
    } SEAM(1);
    if (IN(2)) { swa_phase(F); ssd_states_phase(F); } SEAM(2);
    if (IN(3)) { ssd_scan_phase(F); } SEAM(3);
    if (IN(4)) { ssd_out_phase(F); } SEAM(4);
    if (IN(5)) {
        constexpr int ES = FP8_G2 ? 1 : 2; typedef pg8::EpiG2<ES, FP8_G3 != 0> EpiT;
        pg8::SchedLin S{M_TOK / 256, 1024 / 256, F.G, c, 3072, (const bf16*)(F.ws + WS_WCAT), 3072, ES};
        EpiT E{(const bf16*)(F.ws + WS_P1) + C_G, P1C, (void*)(F.ws + WS_MERGED), DM, (const float*)(F.ws + WS_SSQG), FP8_G2 ? 1.f / pg8::W8_SCALE : 1.f, (LAS float*)(F.lds + TAB_OFF + 1024)};
        pg8::gemm_phase<EpiT, pg8::SchedLin, false, ES>(F.lds, (const char*)(F.ws + WS_ACAT), 3072, S, E);
    } SEAM(5);
    if (IN(6)) {
        constexpr int ES = FP8_G3 ? 1 : 2;
        pg8::SchedLin S{M_TOK / 256, 4, F.G, c, DM, (const bf16*)(F.ws + WS_WOUT), DM, ES};
        pg8::EpiRes<false> E{(const void*)F.in[I_X], (bf16*)(F.ws + WS_H1), FP8_G4 ? nullptr : (bf16*)(F.ws + WS_HB), F.in[I_NCW], (float*)(F.ws + WS_SSQ1), FP8_G4 ? (unsigned char*)(F.ws + WS_HB) : nullptr, FP8_G3 ? 1.f / pg8::W8_SCALE : 1.f};
        pg8::gemm_phase<pg8::EpiRes<false>, pg8::SchedLin, false, ES>(F.lds, (const char*)(F.ws + WS_MERGED), DM, S, E);
    } SEAM(6);
    if (IN(7)) {
        constexpr int ES = FP8_G4 ? 1 : 2;
        pg8::SchedLin S{M_TOK / 256, 4, F.G, c, DM, (const bf16*)(F.ws + WS_WCQ), DM, ES};
        pg8::EpiBf16S E{(bf16*)(F.ws + WS_QC), DM, (const float*)(F.ws + WS_SSQ1), FP8_G4 ? 1.f / pg8::W8_SCALE : 1.f};
        pg8::gemm_phase<pg8::EpiBf16S, pg8::SchedLin, false, ES>(F.lds, (const char*)(F.ws + WS_HB), DM, S, E);
        VM_WAIT(); __syncthreads();
        for (int i = 0;; ++i) { int pm, pn; if (!pg8::static_deal(i, F.G, c, M_TOK / 256, 4, pm, pn)) break;
            const int ua = (pm >> 3) * 64 + pn * 16 + 2 * (pm & 7); cross_units(F, ua, ua + 2, 1); }
    } SEAM(7);
    if (IN(9)) {
        constexpr int ES = FP8_G6 ? 1 : 2;
        pg8::SchedLin S{M_TOK / 256, 4, F.G, c, DM, (const bf16*)(F.ws + WS_WCO), DM, ES};
        pg8::EpiRes<true> E{(const void*)(F.ws + WS_H1), (bf16*)(F.ws + WS_H2), (bf16*)(F.ws + WS_T), F.in[I_NFW], (float*)(F.ws + WS_SSQ2), (unsigned char*)(F.ws + WS_T8), FP8_G6 ? 1.f / pg8::W8_SCALE : 1.f};
        pg8::gemm_phase<pg8::EpiRes<true>, pg8::SchedLin, false, ES>(F.lds, (const char*)(F.ws + WS_OC), DM, S, E);
    } SEAM(9);
    if (IN(10)) { router_phase(F); } SEAM(10);
    if (IN(11)) {
        const int nt = moe_tables(F);
        pg8::SchedMoe S{nt, 8, F.G, c, DM, (const void*)(F.ws + WS_WGU), DM, (size_t)2048 * 1024, true, 1,
                        (const LAS int*)(F.lds + TAB_TE), (const LAS int*)(F.lds + TAB_TP0), (const LAS int*)(F.lds + TAB_CNT), (const int*)(F.ws + WS_ROWMAP)};
        pg8::EpiGU E{(unsigned char*)(F.ws + WS_ACT), F.in[I_BGU], (const int*)(F.ws + WS_ROWMAP), (const LAS int*)(F.lds + TAB_CNT)};
        pg8::gemm_phase<pg8::EpiGU, pg8::SchedMoe, true, 1>(F.lds, (const char*)(F.ws + WS_T8), DM, S, E);
    } SEAM(11);
    if (IN(12)) {
        const int nt = moe_tables(F);
        pg8::SchedMoe S{nt, 4, F.G, c, DM, (const void*)(F.ws + WS_WDN), DM, (size_t)1024 * 1024, false, 1,
                        (const LAS int*)(F.lds + TAB_TE), (const LAS int*)(F.lds + TAB_TP0), (const LAS int*)(F.lds + TAB_CNT), (const int*)(F.ws + WS_ROWMAP)};
        pg8::EpiDN E{(unsigned char*)(F.ws + WS_Y), F.in[I_BDN]};
        pg8::gemm_phase<pg8::EpiDN, pg8::SchedMoe, true, 1>(F.lds, (const char*)(F.ws + WS_ACT), DM, S, E);
    } SEAM(12);
    if (IN(13)) { (void)moe_tables(F); combine_phase(F); }
#undef IN
#undef SEAM
}

static int mega_grid() {
    static int grid = 0;
    if (grid == 0) {
        int dev = 0, cus = 0;
        if (hipGetDevice(&dev) != hipSuccess || hipDeviceGetAttribute(&cus, hipDeviceAttributeMultiprocessorCount, dev) != hipSuccess) { grid = -1; return grid; }
        if (hipFuncSetAttribute((const void*)mega_fwd, hipFuncAttributeMaxDynamicSharedMemorySize, LDS_BYTES) != hipSuccess) { fprintf(stderr, "hipFuncSetAttribute failed\n"); grid = -1; return grid; }
        int per_cu = 0;
        if (hipOccupancyMaxActiveBlocksPerMultiprocessor(&per_cu, (const void*)mega_fwd, NWAVES * 64, LDS_BYTES) != hipSuccess || per_cu < 1) { fprintf(stderr, "occupancy query: %d\n", per_cu); (void)hipGetLastError(); grid = -1; return grid; }
        grid = cus;
    }
    return grid;
}
static void mega_launch(hipStream_t stream, void* const* d_in, void* d_out, void* d_ws, int lo, int hi) {
    const int grid = mega_grid(); if (grid <= 0) return;
    Args a{}; for (int i = 0; i < 29; ++i) a.in[i] = (const float*)d_in[i];
    a.out = (float*)d_out; a.ws = (unsigned char*)d_ws; a.ph_lo = lo; a.ph_hi = hi;
    hipLaunchKernelGGL(mega_fwd, dim3(grid), dim3(NWAVES * 64), LDS_BYTES, stream, a);
}
#ifndef HYB
#define HYB 6
#endif
#ifndef MK_ONE_LAUNCH
#define MK_ONE_LAUNCH 0
#endif
extern "C" void kernel_launch(void* const* d_in, const int* in_sizes, int n_in, void* d_out, int out_size, void* d_ws, size_t ws_size, hipStream_t stream) {
    if (n_in != 29 || ws_size < ((size_t)1000 << 20) || out_size != M_TOK * DM) { fprintf(stderr, "kernel_launch: unexpected n_in %d / ws %zu / out %d\n", n_in, ws_size, out_size); return; }
    if (hipMemsetAsync((char*)d_ws + WS_CTL, 0, CTL_ZERO_BYTES, stream) != hipSuccess) return;
    constexpr int nph = HYB == 1 ? 2 : HYB == 2 ? 5 : HYB == 3 ? 6 : HYB == 4 ? 7 : HYB == 5 ? 10 : 14;
#if MK_ONE_LAUNCH
    mega_launch(stream, d_in, d_out, d_ws, 0, nph);
#else
    for (int p = 0; p < nph; ++p) { if (p == 8) continue;
        mega_launch(stream, d_in, d_out, d_ws, p, p + 1);
#ifdef MK_REPEAT
        if (p == MK_REPEAT) { if (p == 10) (void)hipMemsetAsync((char*)d_ws + WS_CTL + CW_CNT * 4, 0, 32 * 64 * 4, stream); mega_launch(stream, d_in, d_out, d_ws, p, p + 1); }
#endif
    }
#endif
#if HYB < 6
    nv::In in; const float** ip = (const float**)&in; for (int i = 0; i < 29; ++i) ip[i] = (const float*)d_in[i];
    unsigned char* ws = (unsigned char*)d_ws; float* nb = (float*)(ws + WS_NAIVE);
    for (int b = 0; b < 8; ++b) {
        const size_t r0 = (size_t)b * 2048;
        auto cvt = [&](const unsigned short* src, int sp, float* dst, int dp, int cols) { hipLaunchKernelGGL(nv::k_bf16_to_f32, dim3((2048 * cols + 255) / 256), dim3(256), 0, stream, src, sp, dst, dp, 2048, cols); };
        auto cpy = [&](const float* src, int sp, float* dst, int dp, int cols) { hipLaunchKernelGGL(nv::k_copy_f32, dim3((2048 * cols + 255) / 256), dim3(256), 0, stream, src, sp, dst, dp, 2048, cols); };
        const unsigned short* P1 = (const unsigned short*)(ws + WS_P1) + r0 * P1C;
#if HYB == 1
        cvt(P1, P1C, nb + nv::B_PROJ, 6432, 6400); cpy((const float*)(ws + WS_DT) + r0 * 32, 32, nb + nv::B_PROJ + 6400, 6432, 32); cvt(P1 + C_G, P1C, nb + nv::B_GATES, 2048, 2048);
#elif HYB == 2
        cvt((const unsigned short*)(ws + WS_ACAT) + r0 * 3072, 3072, nb + nv::B_U, 1024, 1024); hipLaunchKernelGGL(nv::k_ssm_unnorm_to_f32, dim3(2048 * 2048 / 256), dim3(256), 0, stream, (const unsigned short*)(ws + WS_ACAT) + r0 * 3072, (const float*)(ws + WS_SSQG) + r0 * 4, nb + nv::B_Y, 2048); cvt(P1 + C_G, P1C, nb + nv::B_GATES, 2048, 2048);
#elif HYB == 3
        cvt((const unsigned short*)(ws + WS_MERGED) + r0 * 1024, 1024, nb + nv::B_T1, 1024, 1024);
#elif HYB == 4
        cvt((const unsigned short*)(ws + WS_H1) + r0 * 1024, 1024, nb + nv::B_H1, 1024, 1024);
#elif HYB == 5
        cvt((const unsigned short*)(ws + WS_H2) + r0 * 1024, 1024, nb + nv::B_H2, 1024, 1024);
#endif
        nv::forward_batch(stream, in, nb, b, (float*)d_out, HYB);
    }
#endif
}
```

```cpp
#define HYB 6
#define MK_ONE_LAUNCH 1
#include <hip/hip_runtime.h>
#include <cstdio>
#include <cstdint>
#define GAS __attribute__((address_space(1)))
#define LAS __attribute__((address_space(3)))
typedef unsigned short bf16;
typedef unsigned v4u __attribute__((ext_vector_type(4)));
typedef unsigned v2u __attribute__((ext_vector_type(2)));
typedef float f32x4 __attribute__((ext_vector_type(4)));
typedef float f32x2 __attribute__((ext_vector_type(2)));
typedef short bf16x8 __attribute__((ext_vector_type(8)));
typedef short s16x4 __attribute__((ext_vector_type(4)));
typedef GAS unsigned gu32;
#define RLX_AGENT __ATOMIC_RELAXED, __HIP_MEMORY_SCOPE_AGENT
#define LDS_WAIT() asm volatile("s_waitcnt lgkmcnt(0)" ::: "memory")
#define VM_WAIT() asm volatile("s_waitcnt vmcnt(0)" ::: "memory")
__device__ __forceinline__ unsigned f2bf(float f) { unsigned u = __builtin_bit_cast(unsigned, f); return (u + 0x7fffu + ((u >> 16) & 1u)) >> 16; }
__device__ __forceinline__ unsigned pk2(float lo, float hi) { return f2bf(lo) | (f2bf(hi) << 16); }
__device__ __forceinline__ float bf2f(unsigned short b) { return __uint_as_float((unsigned)b << 16); }
__device__ __forceinline__ float bflo(unsigned w) { return __uint_as_float(w << 16); }
__device__ __forceinline__ float bfhi(unsigned w) { return __uint_as_float(w & 0xffff0000u); }
typedef __bf16 bf16x2_t __attribute__((ext_vector_type(2)));
__device__ __forceinline__ unsigned cvt_pk_bf16(float lo, float hi) { const f32x2 v = {lo, hi}; const bf16x2_t b = __builtin_convertvector(v, bf16x2_t); return __builtin_bit_cast(unsigned, b); }
__device__ __forceinline__ float wave_sum(float v) {
#pragma unroll
    for (int o = 1; o < 64; o <<= 1) v += __shfl_xor(v, o);
    return v;
}
#define XB_TMO      128
#define XB_XCNT(j)  (256  + 64 * (j))
#define XB_XSUB(j)  (1280 + 64 * (j))
#define XB_XGEN(j)  (2304 + 64 * (j))
#define XB_TOP      3328
#define XB_TOPGEN   3392
#define XCD_BAR_WORDS 3456
#define XB_SPIN_CAP (1u << 18)

__device__ __forceinline__ unsigned xb_ld(unsigned* p)              { return __hip_atomic_load(p, __ATOMIC_RELAXED, __HIP_MEMORY_SCOPE_AGENT); }
__device__ __forceinline__ unsigned xb_add(unsigned* p, unsigned v) { return __hip_atomic_fetch_add(p, v, __ATOMIC_RELAXED, __HIP_MEMORY_SCOPE_AGENT); }
__device__ __forceinline__ unsigned xb_xcc_id() { return (unsigned)__builtin_amdgcn_s_getreg((3 << 11) | 20) & 0xFu; }
#define XB_SPIN(cond, bar) do { unsigned _sp = 0; while (cond) { __builtin_amdgcn_s_sleep(1); \
    if ((++_sp & 255u) == 0u) { if (xb_ld(&(bar)[XB_TMO])) break; if (_sp > XB_SPIN_CAP) { atomicAdd(&(bar)[XB_TMO], 1u); break; } } } } while (0)

struct XcdBarrier {
    unsigned* bar; unsigned x;
    volatile LAS unsigned* st;
};

__device__ __forceinline__ XcdBarrier xcd_barrier_post(unsigned* bar, volatile LAS unsigned* st) {
    XcdBarrier b; b.bar = bar; b.x = xb_xcc_id(); b.st = st;
    if (threadIdx.x == 0) (void)xb_add(&bar[XB_XCNT(b.x)], 1u);
    return b;
}
__device__ __forceinline__ void xcd_barrier_complete(unsigned* bar, unsigned x, unsigned& nloc, unsigned& nx) {
    const unsigned G = gridDim.x * gridDim.y * gridDim.z;
    unsigned sum, cnt, mine, sp = 0u;
    for (;;) {
        sum = 0u; cnt = 0u; mine = 0u;
#pragma unroll
        for (unsigned j = 0; j < 16; ++j) { const unsigned c = xb_ld(&bar[XB_XCNT(j)]); sum += c; cnt += (c > 0u) ? 1u : 0u; mine = (j == x) ? c : mine; }
        if (sum == G) break;
        __builtin_amdgcn_s_sleep(1);
        if ((++sp & 255u) == 0u) { if (xb_ld(&bar[XB_TMO])) break; if (sp > XB_SPIN_CAP) { atomicAdd(&bar[XB_TMO], 1u); break; } }
    }
    nloc = mine > 0u ? mine : 1u; nx = cnt > 0u ? cnt : 1u;
}

__device__ __forceinline__ void xcd_barrier(const XcdBarrier& b) {
    asm volatile("s_waitcnt vmcnt(0)" ::: "memory");
    __syncthreads();
    if (threadIdx.x == 0) {
        unsigned* bar = b.bar;
        __builtin_amdgcn_s_waitcnt(0);
        unsigned nloc = b.st[0], nx = b.st[1];
        if (nloc == 0u) { xcd_barrier_complete(bar, b.x, nloc, nx); b.st[0] = nloc; b.st[1] = nx; }
        const unsigned old = xb_add(&bar[XB_XSUB(b.x)], 1u);
        const unsigned gen = old / nloc;
        if (old + 1u == (gen + 1u) * nloc) {
            __builtin_amdgcn_fence(__ATOMIC_RELEASE, "agent");
            asm volatile("s_waitcnt vmcnt(0)" ::: "memory");
            const unsigned og = xb_add(&bar[XB_TOP], 1u);
            const unsigned tg = og / nx;
            if (og + 1u == (tg + 1u) * nx) xb_add(&bar[XB_TOPGEN], 1u);
            else XB_SPIN(xb_ld(&bar[XB_TOPGEN]) == tg, bar);
            __builtin_amdgcn_fence(__ATOMIC_ACQUIRE, "agent");
            xb_add(&bar[XB_XGEN(b.x)], 1u);
            asm volatile("s_waitcnt vmcnt(0)" ::: "memory");
        } else {
            XB_SPIN(xb_ld(&bar[XB_XGEN(b.x)]) == gen, bar);
            __builtin_amdgcn_fence(__ATOMIC_ACQUIRE, "agent");
            asm volatile("s_waitcnt vmcnt(0)" ::: "memory");
        }
    }
    __syncthreads();
}
namespace pg8 {
constexpr int BM = 256, BK = 64, HALF = 128, HTB = HALF * BK * 2  , STAGE_BYTES = 8 * HTB, NXCD = 8, WGM = 8;
__host__ __device__ __forceinline__ int lds_byte(int r, int c) { const int st = (r >> 4) * 2 + (c >> 5), rr = r & 15, cc = c & 31, ob = rr * 64 + cc * 2; return st * 1024 + (ob ^ (((ob >> 9) & 1) << 5)); }
__host__ __device__ __forceinline__ void stage_rc(int b, int& R, int& C) { const int st = b / 1024, sb = b % 1024, swz = sb ^ (((sb >> 9) & 1) << 5); R = (st >> 1) * 16 + swz / 64; C = (st & 1) * 32 + (swz % 64) / 2; }
__host__ __device__ __forceinline__ int perm32(int rho) { const int n = rho >> 4, i = rho & 15; return 8 * (i >> 2) + 4 * n + (i & 3); }

struct Unit { int pm, pn, e, p0; };
typedef int v8i __attribute__((ext_vector_type(8))); typedef int v4i __attribute__((ext_vector_type(4)));
__device__ __forceinline__ v8i cat_frag(bf16x8 a, bf16x8 b) { const v4i x = __builtin_bit_cast(v4i, a), y = __builtin_bit_cast(v4i, b); return (v8i){x[0], x[1], x[2], x[3], y[0], y[1], y[2], y[3]}; }
__device__ __forceinline__ unsigned pk4_fp8(float a, float b, float c, float d) {
    a = __builtin_amdgcn_fmed3f(a, -448.f, 448.f); b = __builtin_amdgcn_fmed3f(b, -448.f, 448.f); c = __builtin_amdgcn_fmed3f(c, -448.f, 448.f); d = __builtin_amdgcn_fmed3f(d, -448.f, 448.f);
    int w = 0; w = __builtin_amdgcn_cvt_pk_fp8_f32(a, b, w, false); w = __builtin_amdgcn_cvt_pk_fp8_f32(c, d, w, true); return (unsigned)w; }
constexpr float W8_SCALE = 32.f;

__device__ __forceinline__ bool static_deal(int i, int G, int c, int nM, int nN, int& pm, int& pn) {
    const int nwg = nM * nN; const long L = (long)i * G + c; if (L >= nwg) return false;
    int wgid = (int)L; { const int q = nwg / NXCD, r = nwg % NXCD, xcd = wgid % NXCD, off = wgid / NXCD; wgid = (xcd < r ? xcd * (q + 1) : r * (q + 1) + (xcd - r) * q) + off; }
    const int nig = WGM * nN, gid = wgid / nig, fm = gid * WGM, gsz = (nM - fm) < WGM ? (nM - fm) : WGM;
    pm = fm + ((wgid % nig) % gsz); pn = (wgid % nig) / gsz; return true;
}
struct SchedLin {
    int nM, nN, G, c, lda; const bf16* Bt; int K; int es = 2;
    __device__ __forceinline__ bool next(int i, Unit& u) const { u.e = 0; u.p0 = 0; return static_deal(i, G, c, nM, nN, u.pm, u.pn); }
    __device__ __forceinline__ void a_fetch(const Unit& u, int (&raw)[2][2]) const {
        int R[2], C[2]; stage_rc((int)threadIdx.x * 16, R[0], C[0]); stage_rc((int)threadIdx.x * 16 + 8192, R[1], C[1]);
#pragma unroll
        for (int h = 0; h < 2; ++h)
#pragma unroll
            for (int i = 0; i < 2; ++i) raw[h][i] = u.pm * BM + h * HALF + R[i];
    }
    __device__ __forceinline__ void a_finish(const Unit& u, const int (&raw)[2][2], unsigned (&o)[2][2]) const {
        int R[2], C[2]; stage_rc((int)threadIdx.x * 16, R[0], C[0]); stage_rc((int)threadIdx.x * 16 + 8192, R[1], C[1]);
#pragma unroll
        for (int h = 0; h < 2; ++h)
#pragma unroll
            for (int i = 0; i < 2; ++i) o[h][i] = (unsigned)(raw[h][i] * lda * es + C[i] * 2);
    }
    __device__ __forceinline__ int b_off(const Unit& u) const { return u.pn * BM * K * es; }
    __device__ __forceinline__ const void* bt() const { return Bt; }
};
struct SchedMoe {
    int nM, nN, G, c, lda; const void* Bt; int K; size_t bstride; bool gather; int es;
    const LAS int* tile_e; const LAS int* tile_p0; const LAS int* cnt_s; const int* rowmap;
    __device__ __forceinline__ bool next(int i, Unit& u) const { if (!static_deal(i, G, c, nM, nN, u.pm, u.pn)) return false; u.e = tile_e[u.pm]; u.p0 = tile_p0[u.pm]; return true; }
    __device__ __forceinline__ void a_fetch(const Unit& u, int (&raw)[2][2]) const {
        int R[2], C[2]; stage_rc((int)threadIdx.x * 16, R[0], C[0]); stage_rc((int)threadIdx.x * 16 + 8192, R[1], C[1]);
        const int ce = cnt_s[u.e];
#pragma unroll
        for (int h = 0; h < 2; ++h)
#pragma unroll
            for (int i = 0; i < 2; ++i) {
                if (gather) { const int pos = u.p0 + h * HALF + R[i]; raw[h][i] = pos < ce ? rowmap[2 * (u.e * 16384 + pos)] : 0; }
                else raw[h][i] = u.pm * BM + h * HALF + R[i]; }
    }
    __device__ __forceinline__ void a_finish(const Unit& u, const int (&raw)[2][2], unsigned (&o)[2][2]) const {
        int R[2], C[2]; stage_rc((int)threadIdx.x * 16, R[0], C[0]); stage_rc((int)threadIdx.x * 16 + 8192, R[1], C[1]);
#pragma unroll
        for (int h = 0; h < 2; ++h)
#pragma unroll
            for (int i = 0; i < 2; ++i) o[h][i] = (unsigned)(raw[h][i] * lda * es + C[i] * 2);
    }
    __device__ __forceinline__ int b_off(const Unit& u) const { return u.e * (int)bstride + u.pn * BM * K * es; }
    __device__ __forceinline__ const void* bt() const { return Bt; }
};

template <class Epi, class Sched, bool ALIGN_EPI, int ES = 2, bool I8 = false>
__device__ __forceinline__ void gemm_phase(LAS unsigned char* lds, const char* Abase, const int K, const Sched& S, const Epi& E) {
    const int tid = threadIdx.x, wid = __builtin_amdgcn_readfirstlane(tid >> 6), lane = tid & 63, wr = wid >> 2, wc = wid & 3, fr = lane & 15, fq = lane >> 4;
    const int nt = K * ES / (BK * 2);
    unsigned voffB[2];
#pragma unroll
    for (int i = 0; i < 2; ++i) { int R, C; stage_rc(tid * 16 + i * 8192, R, C); const int Rb = Epi::PERM ? ((R & ~31) + perm32(R & 31)) : R; voffB[i] = (unsigned)(Rb * K * ES + C * 2); }
    const int kstep = BK * 2;
    const int hstep = HALF * K * ES;
    const unsigned ldsw = (unsigned)wid * 1024u;
    const int aoff = lds_byte(wr * 64 + fr, fq * 8), boff = lds_byte(wc * 32 + fr, fq * 8);
    const __amdgpu_buffer_rsrc_t rsA = __builtin_amdgcn_make_buffer_rsrc((void*)Abase, (short)0, 0x7ffff000, 0x00020000);
    const __amdgpu_buffer_rsrc_t rsB = __builtin_amdgcn_make_buffer_rsrc((void*)S.bt(), (short)0, 0x7ffff000, 0x00020000);
#define PG8_SA(b, h) (((b) * 2 + (h)) * HTB)
#define PG8_SB(b, h) ((4 + (b) * 2 + (h)) * HTB)
#define PG8_STAGE_A(bufoff, soff, voff) do { _Pragma("unroll") for (int _i = 0; _i < 2; ++_i) \
        __builtin_amdgcn_raw_ptr_buffer_load_lds(rsA, (LAS unsigned*)(lds + (bufoff) + ldsw + _i * 8192), 16, (int)(voff)[_i], (soff), 0, 0); } while (0)
#define PG8_STAGE_B(bufoff, soff) do { _Pragma("unroll") for (int _i = 0; _i < 2; ++_i) \
        __builtin_amdgcn_raw_ptr_buffer_load_lds(rsB, (LAS unsigned*)(lds + (bufoff) + ldsw + _i * 8192), 16, (int)voffB[_i], (soff), 0, 0); } while (0)
#define PG8_LDA(dst, b, h) do { _Pragma("unroll") for (int m = 0; m < 4; ++m) _Pragma("unroll") for (int k = 0; k < 2; ++k) dst[m][k] = *(const LAS bf16x8*)(lds + PG8_SA(b, h) + aoff + m * 2048 + k * 1024); } while (0)
#define PG8_LDB(dst, b, h) do { _Pragma("unroll") for (int n = 0; n < 2; ++n) _Pragma("unroll") for (int k = 0; k < 2; ++k) dst[n][k] = *(const LAS bf16x8*)(lds + PG8_SB(b, h) + boff + n * 2048 + k * 1024); } while (0)
#define PG8_MMA(ai, bj, At, Bt) do { __builtin_amdgcn_s_setprio(1); _Pragma("unroll") for (int m = 0; m < 4; ++m) _Pragma("unroll") for (int n = 0; n < 2; ++n) { \
        if constexpr (I8) { _Pragma("unroll") for (int k = 0; k < 2; ++k) acc[ai][bj][m][n] = __builtin_bit_cast(f32x4, __builtin_amdgcn_mfma_i32_16x16x64_i8(__builtin_bit_cast(v4i, Bt[n][k]), __builtin_bit_cast(v4i, At[m][k]), __builtin_bit_cast(v4i, acc[ai][bj][m][n]), 0, 0, 0)); } \
        else if constexpr (ES == 2) { _Pragma("unroll") for (int k = 0; k < 2; ++k) acc[ai][bj][m][n] = __builtin_amdgcn_mfma_f32_16x16x32_bf16(Bt[n][k], At[m][k], acc[ai][bj][m][n], 0, 0, 0); } \
        else acc[ai][bj][m][n] = __builtin_amdgcn_mfma_scale_f32_16x16x128_f8f6f4(cat_frag(Bt[n][0], Bt[n][1]), cat_frag(At[m][0], At[m][1]), acc[ai][bj][m][n], 0, 0, 0, 0x7f7f7f7f, 0, 0x7f7f7f7f); } \
        __builtin_amdgcn_s_setprio(0); } while (0)
#define PG8_WAIT_V(n) asm volatile("s_waitcnt vmcnt(" #n ")" ::: "memory")
#define PG8_WAIT_L(n) asm volatile("s_waitcnt lgkmcnt(" #n ")" ::: "memory")
#define PG8_BAR __builtin_amdgcn_s_barrier()
#define PG8_SCHED __builtin_amdgcn_sched_barrier(0)
    Unit cur, nxt; int ui = 0;
    if (!S.next(0, cur)) return;
    f32x4 acc[2][2][4][2];
#pragma unroll
    for (int a = 0; a < 2; ++a)
#pragma unroll
        for (int b = 0; b < 2; ++b)
#pragma unroll
            for (int m = 0; m < 4; ++m)
#pragma unroll
                for (int n = 0; n < 2; ++n) acc[a][b][m][n] = (f32x4){0.f, 0.f, 0.f, 0.f};
    bf16x8 At[4][2], B0[2][2], B1[2][2];
    unsigned cao[2][2], nao[2][2];
    { int raw[2][2]; S.a_fetch(cur, raw); S.a_finish(cur, raw, cao); }
    int cB = S.b_off(cur);
    bool has_next = S.next(1, nxt); int nB = cB;
    if (has_next) { int raw[2][2]; S.a_fetch(nxt, raw); S.a_finish(nxt, raw, nao); nB = S.b_off(nxt); }
    else {
#pragma unroll
        for (int h = 0; h < 2; ++h)
#pragma unroll
            for (int i = 0; i < 2; ++i) nao[h][i] = cao[h][i]; }
    float pa0 = 0.f, pb0 = 0.f; f32x4 ub0 = (f32x4){0.f, 0.f, 0.f, 0.f};
    if constexpr (Epi::PRE) E.pre_fetch(cur, tid, pa0, pb0);
    if constexpr (Epi::NSEG > 1) ub0 = E.unit_fetch(cur, tid);
    PG8_STAGE_B(PG8_SB(0, 0), cB); PG8_STAGE_B(PG8_SB(0, 1), cB + hstep); PG8_STAGE_A(PG8_SA(0, 0), 0, cao[0]); PG8_STAGE_A(PG8_SA(0, 1), 0, cao[1]);
    if (wr == 1) PG8_BAR;
    PG8_WAIT_V(2); PG8_BAR;
    PG8_STAGE_B(PG8_SB(1, 0), cB + kstep); PG8_STAGE_A(PG8_SA(1, 0), kstep, cao[0]); PG8_STAGE_B(PG8_SB(1, 1), cB + hstep + kstep);
    PG8_WAIT_V(6); PG8_BAR;
    if constexpr (Epi::PRE) E.pre_store(tid, pa0, pb0, 0);
    if constexpr (Epi::NSEG > 1) E.unit_store(tid, ub0);
    for (;;) {
        int t = 0;
#pragma unroll 1
        for (int seg = 0; seg < Epi::NSEG; ++seg) {
        const int t_end = (Epi::NSEG == 1) ? nt : Epi::MID_T + Epi::SEG_STEP * seg;
#pragma unroll 1
        for (; t < t_end; t += 2) {
            const bool last = (t == nt - 2);
            const int a1 = (t + 1) * kstep;
            const int a2 = last ? 0 : (t + 2) * kstep; const int b2 = last ? nB : cB + (t + 2) * kstep;
            const int a3 = a2 + kstep; const int b3 = b2 + kstep;
            PG8_LDB(B0, 0, 0); PG8_LDB(B1, 0, 1); PG8_SCHED; PG8_LDA(At, 0, 0); PG8_STAGE_A(PG8_SA(1, 1), a1, cao[1]);
            if (last) {
#pragma unroll
                for (int h = 0; h < 2; ++h)
#pragma unroll
                    for (int i = 0; i < 2; ++i) cao[h][i] = nao[h][i]; }
            PG8_WAIT_V(8); PG8_WAIT_L(0); PG8_BAR; PG8_MMA(0, 0, At, B0); PG8_MMA(0, 1, At, B1); PG8_BAR; PG8_SCHED;
            PG8_LDA(At, 0, 1); PG8_STAGE_B(PG8_SB(0, 0), b2); PG8_STAGE_B(PG8_SB(0, 1), b2 + hstep); PG8_STAGE_A(PG8_SA(0, 0), a2, cao[0]);
            PG8_WAIT_V(8); PG8_WAIT_L(0); PG8_BAR; PG8_MMA(1, 0, At, B0); PG8_MMA(1, 1, At, B1); PG8_BAR; PG8_SCHED;
            PG8_LDB(B0, 1, 0); PG8_LDB(B1, 1, 1); PG8_SCHED; PG8_LDA(At, 1, 0); PG8_STAGE_A(PG8_SA(0, 1), a2, cao[1]);
            PG8_WAIT_V(8); PG8_WAIT_L(0); PG8_BAR; PG8_MMA(0, 0, At, B0); PG8_MMA(0, 1, At, B1); PG8_BAR; PG8_SCHED;
            PG8_LDA(At, 1, 1); PG8_STAGE_B(PG8_SB(1, 0), b3); PG8_STAGE_B(PG8_SB(1, 1), b3 + hstep); PG8_STAGE_A(PG8_SA(1, 0), a3, cao[0]);
            PG8_WAIT_V(8); PG8_WAIT_L(0); PG8_BAR; PG8_MMA(1, 0, At, B0); PG8_MMA(1, 1, At, B1); PG8_BAR; PG8_SCHED;
        }
        if constexpr (Epi::NSEG > 1) { E.mid(acc, cur, seg, wr, wc, fr, fq); }
        }
        if constexpr (ALIGN_EPI) { if (wr == 0) PG8_BAR; }
        Unit nn; const bool hnn = has_next && S.next(ui + 2, nn); int nraw[2][2];
        if (hnn) S.a_fetch(nn, nraw);
        float pa = 0.f, pb = 0.f;
        if constexpr (Epi::PRE) { if (has_next) E.pre_fetch(nxt, tid, pa, pb); E(acc, cur, wr, wc, fr, fq, ui & 1); if (has_next) E.pre_store(tid, pa, pb, (ui + 1) & 1); }
        else E(acc, cur, wr, wc, fr, fq);
        if (!has_next) break;
#pragma unroll
        for (int a = 0; a < 2; ++a)
#pragma unroll
            for (int b = 0; b < 2; ++b)
#pragma unroll
                for (int m = 0; m < 4; ++m)
#pragma unroll
                    for (int n = 0; n < 2; ++n) acc[a][b][m][n] = (f32x4){0.f, 0.f, 0.f, 0.f};
        cur = nxt; cB = nB; ++ui;
        has_next = hnn;
        if (hnn) { S.a_finish(nn, nraw, nao); nB = S.b_off(nn); nxt = nn; }
        else {
#pragma unroll
            for (int h = 0; h < 2; ++h)
#pragma unroll
                for (int i = 0; i < 2; ++i) nao[h][i] = cao[h][i]; }
        if constexpr (Epi::NSEG > 1) { PG8_BAR; E.unit_store(tid, E.unit_fetch(cur, tid)); }
        if constexpr (ALIGN_EPI) { if (wr == 1) PG8_BAR; }
    }
    PG8_WAIT_V(0);
    if constexpr (!ALIGN_EPI) { if (wr == 0) PG8_BAR; }
    PG8_BAR;
#undef PG8_SA
#undef PG8_SB
#undef PG8_STAGE_A
#undef PG8_STAGE_B
#undef PG8_LDA
#undef PG8_LDB
#undef PG8_MMA
#undef PG8_WAIT_V
#undef PG8_WAIT_L
#undef PG8_BAR
#undef PG8_SCHED
}

__device__ __forceinline__ float fsigmoid(float v) { return __builtin_amdgcn_rcpf(1.f + __builtin_amdgcn_exp2f(-1.4426950408889634f * v)); }
__device__ __forceinline__ float row_rstd(const float* ssq, int row) {
    const f32x4* p = (const f32x4*)(ssq + (size_t)row * 16); const f32x4 a = p[0], b = p[1], c = p[2], d = p[3];
    const float s = ((a.x + a.y) + (a.z + a.w)) + ((b.x + b.y) + (b.z + b.w)) + ((c.x + c.y) + (c.z + c.w)) + ((d.x + d.y) + (d.z + d.w));
    return 1.0f / sqrtf(s * (1.0f / 1024.0f) + 1e-5f);
}
template <bool I8> struct EpiP1 {
    static constexpr bool PERM = true; static constexpr int MID_T = 0, NSEG = 1, SEG_STEP = 0; static constexpr bool PRE = true;
    bf16* O; int ldc; float* DT; const float* b_gate; const float* usc; const float* csc; LAS float* tab;
    __device__ __forceinline__ void pre_fetch(const Unit& u, int tid, float& a, float& b) const {
        a = 1.f; b = 0.f;
        if (tid < 256) { if (I8) a = usc[u.pm * BM + tid]; if (u.pn >= 25 && u.pn < 33) b = b_gate[(tid >> 7) * 1024 + (u.pn - 25) * 128 + (tid & 127)]; }
        else if (I8) a = csc[u.pn * BM + tid - 256];
    }
    __device__ __forceinline__ void pre_store(int tid, float a, float b, int par) const { LAS float* t = tab + par * 768; if (tid < 256) { t[tid] = a; t[512 + tid] = b; } else t[tid] = a; }
    __device__ __forceinline__ static f32x4 val(const f32x4& a, const f32x4& cs, float rs) {
        if constexpr (I8) { const v4i i = __builtin_bit_cast(v4i, a); return (f32x4){(float)i[0], (float)i[1], (float)i[2], (float)i[3]} * cs * rs; } else return a; }
    __device__ __forceinline__ void operator()(const f32x4 (&acc)[2][2][4][2], const Unit& u, int wr, int wc, int fr, int fq, int par) const {
        int row0 = u.pm * BM + wr * 64 + fr; asm volatile("" : "+v"(row0));
        const int col0 = u.pn * BM + wc * 32 + 8 * fq; const LAS float* t = tab + par * 768;
        f32x4 cs[2][2]; float rsv[8];
#pragma unroll
        for (int bj = 0; bj < 2; ++bj)
#pragma unroll
            for (int n = 0; n < 2; ++n) cs[bj][n] = *(const LAS f32x4*)(t + 256 + wc * 32 + 8 * fq + bj * HALF + 4 * n);
#pragma unroll
        for (int i = 0; i < 8; ++i) rsv[i] = t[wr * 64 + fr + (i >> 2) * HALF + (i & 3) * 16];
        if (u.pn == 33) {
            if (wc == 0) {
#pragma unroll
                for (int ai = 0; ai < 2; ++ai)
#pragma unroll
                    for (int m = 0; m < 4; ++m)
#pragma unroll
                        for (int n = 0; n < 2; ++n) *(f32x4*)(DT + (size_t)(row0 + ai * HALF + m * 16) * 32 + 8 * fq + 4 * n) = val(acc[ai][0][m][n], cs[0][n], rsv[ai * 4 + m]); }
            return; }
        const bool act = u.pn >= 25, zt = u.pn >= 5 && u.pn < 13;
        const int gj = (u.pn - 25) * 128 + wc * 32 + 8 * fq;
        f32x4 bv[2][2];
#pragma unroll
        for (int bj = 0; bj < 2; ++bj)
#pragma unroll
            for (int n = 0; n < 2; ++n) bv[bj][n] = *(const LAS f32x4*)(t + 512 + bj * 128 + wc * 32 + 8 * fq + 4 * n);
#pragma unroll
        for (int ai = 0; ai < 2; ++ai)
#pragma unroll
            for (int m = 0; m < 4; ++m) { bf16* rowb = O + (size_t)(row0 + ai * HALF + m * 16) * ldc; const float rs = rsv[ai * 4 + m];
                f32x4 v[2][2];
#pragma unroll
                for (int bj = 0; bj < 2; ++bj) { v[bj][0] = val(acc[ai][bj][m][0], cs[bj][0], rs) + bv[bj][0]; v[bj][1] = val(acc[ai][bj][m][1], cs[bj][1], rs) + bv[bj][1]; }
                if (act) {
#pragma unroll
                    for (int n = 0; n < 2; ++n)
#pragma unroll
                        for (int k = 0; k < 4; ++k) { const float e0 = __builtin_amdgcn_exp2f(-1.4426950408889634f * v[0][n][k]), e1 = __builtin_amdgcn_exp2f(-1.4426950408889634f * v[1][n][k]);
                            v[0][n][k] = (1.f + e1) * __builtin_amdgcn_rcpf(1.f + e0);
                            v[1][n][k] = __builtin_amdgcn_rcpf(1.f + e1); }
                }
                if (zt) {
#pragma unroll
                    for (int bj = 0; bj < 2; ++bj)
#pragma unroll
                        for (int n = 0; n < 2; ++n)
#pragma unroll
                            for (int k = 0; k < 4; ++k) v[bj][n][k] = v[bj][n][k] * fsigmoid(v[bj][n][k]); }
#pragma unroll
                for (int bj = 0; bj < 2; ++bj) { const f32x4 v0 = v[bj][0], v1 = v[bj][1];
                    v4u w; w.x = cvt_pk_bf16(v0[0], v0[1]); w.y = cvt_pk_bf16(v0[2], v0[3]); w.z = cvt_pk_bf16(v1[0], v1[1]); w.w = cvt_pk_bf16(v1[2], v1[3]);
                    *(v4u*)(rowb + (act ? 6400 + bj * 1024 + gj : col0 + bj * HALF)) = w; } }
    }
};
struct EpiBf16S {
    static constexpr bool PERM = true; static constexpr int MID_T = 0, NSEG = 1, SEG_STEP = 0; static constexpr bool PRE = true;
    bf16* O; int ldc; const float* ssq; float sc; LAS float* tab;
    __device__ __forceinline__ void pre_fetch(const Unit& u, int tid, float& a, float& b) const { a = sc; b = 0.f; if (ssq && tid < 256) a = row_rstd(ssq, u.pm * BM + tid) * sc; }
    __device__ __forceinline__ void pre_store(int tid, float a, float b, int par) const { if (tid < 256) tab[par * 768 + tid] = a; }
    __device__ __forceinline__ void operator()(const f32x4 (&acc)[2][2][4][2], const Unit& u, int wr, int wc, int fr, int fq, int par) const {
        int row0 = u.pm * BM + wr * 64 + fr; asm volatile("" : "+v"(row0)); const int col0 = u.pn * BM + wc * 32 + 8 * fq; const LAS float* t = tab + par * 768 + wr * 64 + fr;
#pragma unroll
        for (int ai = 0; ai < 2; ++ai)
#pragma unroll
            for (int m = 0; m < 4; ++m) { const int row = row0 + ai * HALF + m * 16; const float rs = t[ai * HALF + m * 16]; bf16* rowp = O + (size_t)row * ldc + col0;
#pragma unroll
                for (int bj = 0; bj < 2; ++bj) { const f32x4 v0 = acc[ai][bj][m][0] * rs, v1 = acc[ai][bj][m][1] * rs;
                    v4u w; w.x = cvt_pk_bf16(v0[0], v0[1]); w.y = cvt_pk_bf16(v0[2], v0[3]); w.z = cvt_pk_bf16(v1[0], v1[1]); w.w = cvt_pk_bf16(v1[2], v1[3]);
                    *(v4u*)(rowp + bj * HALF) = w; } }
    }
};
struct EpiI8 {
    static constexpr bool PERM = true; static constexpr int MID_T = 0, NSEG = 1, SEG_STEP = 0; static constexpr bool PRE = true;
    bf16* O; int ldc; const float* usc; const float* csc; LAS float* tab;
    __device__ __forceinline__ void pre_fetch(const Unit& u, int tid, float& a, float& b) const { b = 0.f; a = tid < 256 ? usc[u.pm * BM + tid] : csc[u.pn * BM + tid - 256]; }
    __device__ __forceinline__ void pre_store(int tid, float a, float b, int par) const { tab[par * 768 + tid] = a; }
    __device__ __forceinline__ void operator()(const f32x4 (&acc)[2][2][4][2], const Unit& u, int wr, int wc, int fr, int fq, int par) const {
        int row0 = u.pm * BM + wr * 64 + fr; asm volatile("" : "+v"(row0)); const int col0 = u.pn * BM + wc * 32 + 8 * fq; const LAS float* t = tab + par * 768;
        f32x4 cs[2][2];
#pragma unroll
        for (int bj = 0; bj < 2; ++bj)
#pragma unroll
            for (int n = 0; n < 2; ++n) cs[bj][n] = *(const LAS f32x4*)(t + 256 + wc * 32 + 8 * fq + bj * HALF + 4 * n);
#pragma unroll
        for (int ai = 0; ai < 2; ++ai)
#pragma unroll
            for (int m = 0; m < 4; ++m) { const int row = row0 + ai * HALF + m * 16; const float rs = t[wr * 64 + fr + ai * HALF + m * 16]; bf16* rowp = O + (size_t)row * ldc + col0;
#pragma unroll
                for (int bj = 0; bj < 2; ++bj) { const v4i i0 = __builtin_bit_cast(v4i, acc[ai][bj][m][0]), i1 = __builtin_bit_cast(v4i, acc[ai][bj][m][1]);
                    const f32x4 v0 = (f32x4){(float)i0[0], (float)i0[1], (float)i0[2], (float)i0[3]} * cs[bj][0] * rs, v1 = (f32x4){(float)i1[0], (float)i1[1], (float)i1[2], (float)i1[3]} * cs[bj][1] * rs;
                    v4u w; w.x = cvt_pk_bf16(v0[0], v0[1]); w.y = cvt_pk_bf16(v0[2], v0[3]); w.z = cvt_pk_bf16(v1[0], v1[1]); w.w = cvt_pk_bf16(v1[2], v1[3]);
                    *(v4u*)(rowp + bj * HALF) = w; } }
    }
};
template <int ES, bool O8> struct EpiG2 {
    static constexpr bool PERM = true; static constexpr int MID_T = 16 * ES / 2, NSEG = 5, SEG_STEP = 8 * ES / 2; static constexpr bool PRE = false;
    const bf16* gates; int ldg; void* O; int ldc; const float* ssqg; float sc; LAS float* ftab;
    __device__ __forceinline__ f32x4 unit_fetch(const Unit& u, int tid) const { return tid < 256 ? *(const f32x4*)(ssqg + (size_t)(u.pm * BM + tid) * 4) : (f32x4){1.f, 1.f, 1.f, 1.f}; }
    __device__ __forceinline__ void unit_store(int tid, const f32x4& sq) const {
        if (tid < 256) { const float q0 = sq[0] * (1.f / 512.f) + 1e-5f, q1 = sq[1] * (1.f / 512.f) + 1e-5f, q2 = sq[2] * (1.f / 512.f) + 1e-5f, q3 = sq[3] * (1.f / 512.f) + 1e-5f;
            ftab[tid] = sqrtf(q0); ftab[256 + tid] = sqrtf(q1 / q0); ftab[512 + tid] = sqrtf(q2 / q1); ftab[768 + tid] = sqrtf(q3 / q2); ftab[1024 + tid] = sc / sqrtf(q3); }
    }
    __device__ __forceinline__ void mid(f32x4 (&acc)[2][2][4][2], const Unit& u, int seg, int wr, int wc, int fr, int fq) const {
        int row0 = u.pm * BM + wr * 64 + fr; asm volatile("" : "+v"(row0)); const int col0 = u.pn * BM + wc * 32 + 8 * fq;
        const LAS float* rfp = ftab + seg * 256 + wr * 64 + fr;
        const bool gh = seg == 0 || seg == 4; const bf16* gbase = gates + col0 + (seg == 0 ? 0 : 1024);
#pragma unroll
        for (int pb = 0; pb < 1; ++pb) {
            v4u gv[4][2][2];
            if (gh) {
#pragma unroll
                for (int pp = 0; pp < 4; ++pp)
#pragma unroll
                    for (int mm = 0; mm < 2; ++mm)
#pragma unroll
                        for (int bj = 0; bj < 2; ++bj) { const int pr = pp; gv[pp][mm][bj] = *(const v4u*)(gbase + (size_t)(row0 + (pr >> 1) * HALF + (2 * (pr & 1) + mm) * 16) * ldg + bj * HALF); } }
#pragma unroll
            for (int pp = 0; pp < 4; ++pp) { const int pr = pp, ai = pr >> 1, m0 = 2 * (pr & 1);
                f32x4 fa[2][2], fb[2][2];
#pragma unroll
                for (int mm = 0; mm < 2; ++mm)
#pragma unroll
                    for (int bj = 0; bj < 2; ++bj) { const float f = rfp[ai * HALF + (m0 + mm) * 16]; fa[mm][bj] = (f32x4){f, f, f, f}; fb[mm][bj] = fa[mm][bj]; }
                if (gh) {
#pragma unroll
                    for (int mm = 0; mm < 2; ++mm)
#pragma unroll
                        for (int bj = 0; bj < 2; ++bj) { const v4u b = gv[pp][mm][bj];
                            fa[mm][bj] *= (f32x4){bflo(b.x), bfhi(b.x), bflo(b.y), bfhi(b.y)}; fb[mm][bj] *= (f32x4){bflo(b.z), bfhi(b.z), bflo(b.w), bfhi(b.w)}; }
                }
#pragma unroll
                for (int mm = 0; mm < 2; ++mm)
#pragma unroll
                    for (int bj = 0; bj < 2; ++bj) { acc[ai][bj][m0 + mm][0] *= fa[mm][bj]; acc[ai][bj][m0 + mm][1] *= fb[mm][bj]; }
                asm volatile("" : "+v"(acc[ai][0][m0][0]), "+v"(acc[ai][0][m0][1]), "+v"(acc[ai][1][m0][0]), "+v"(acc[ai][1][m0][1]), "+v"(acc[ai][0][m0 + 1][0]), "+v"(acc[ai][0][m0 + 1][1]), "+v"(acc[ai][1][m0 + 1][0]), "+v"(acc[ai][1][m0 + 1][1]) :: "memory");
            }
        }
    }
    __device__ __forceinline__ void operator()(const f32x4 (&acc)[2][2][4][2], const Unit& u, int wr, int wc, int fr, int fq) const {
        int row0 = u.pm * BM + wr * 64 + fr; asm volatile("" : "+v"(row0)); const int col0 = u.pn * BM + wc * 32 + 8 * fq;
#pragma unroll
        for (int ai = 0; ai < 2; ++ai)
#pragma unroll
            for (int m = 0; m < 4; ++m) { const size_t ro = (size_t)(row0 + ai * HALF + m * 16) * ldc + col0;
#pragma unroll
                for (int bj = 0; bj < 2; ++bj) { const f32x4 v0 = acc[ai][bj][m][0], v1 = acc[ai][bj][m][1];
                    if constexpr (O8) *(v2u*)((unsigned char*)O + ro + bj * HALF) = (v2u){pk4_fp8(v0[0], v0[1], v0[2], v0[3]), pk4_fp8(v1[0], v1[1], v1[2], v1[3])};
                    else { v4u w; w.x = cvt_pk_bf16(v0[0], v0[1]); w.y = cvt_pk_bf16(v0[2], v0[3]); w.z = cvt_pk_bf16(v1[0], v1[1]); w.w = cvt_pk_bf16(v1[2], v1[3]);
                        *(v4u*)((bf16*)O + ro + bj * HALF) = w; } } }
    }
};
template <bool BASE16> struct EpiRes {
    static constexpr bool PERM = true; static constexpr int MID_T = 0, NSEG = 1, SEG_STEP = 0; static constexpr bool PRE = true;
    const void* base; bf16* H; bf16* HB; const float* nw; float* ssq; unsigned char* T8; float sc; LAS float* tab;
    __device__ __forceinline__ void pre_fetch(const Unit& u, int tid, float& a, float& b) const { a = 0.f; b = 0.f; if (tid >= 256) a = nw[u.pn * BM + tid - 256]; }
    __device__ __forceinline__ void pre_store(int tid, float a, float b, int par) const { if (tid >= 256) tab[par * 768 + tid] = a; }
    __device__ __forceinline__ void operator()(const f32x4 (&acc)[2][2][4][2], const Unit& u, int wr, int wc, int fr, int fq, int par) const {
        int row0 = u.pm * BM + wr * 64 + fr; asm volatile("" : "+v"(row0)); const int col0 = u.pn * BM + wc * 32 + 8 * fq;
        f32x4 wv[2][2];
#pragma unroll
        for (int bj = 0; bj < 2; ++bj)
#pragma unroll
            for (int n = 0; n < 2; ++n) wv[bj][n] = *(const LAS f32x4*)(tab + par * 768 + 256 + wc * 32 + 8 * fq + bj * HALF + 4 * n);
#pragma unroll
        for (int ai = 0; ai < 2; ++ai)
#pragma unroll
            for (int m = 0; m < 4; ++m) { const int row = row0 + ai * HALF + m * 16; const size_t off = (size_t)row * 1024 + col0; float s = 0.f;
#pragma unroll
                for (int bj = 0; bj < 2; ++bj) { f32x4 h0, h1;
                    if constexpr (BASE16) { const v4u b = *(const v4u*)((const bf16*)base + off + bj * HALF);
                        h0 = (f32x4){bflo(b.x), bfhi(b.x), bflo(b.y), bfhi(b.y)}; h1 = (f32x4){bflo(b.z), bfhi(b.z), bflo(b.w), bfhi(b.w)}; }
                    else { h0 = *(const f32x4*)((const float*)base + off + bj * HALF); h1 = *(const f32x4*)((const float*)base + off + bj * HALF + 4); }
                    h0 += acc[ai][bj][m][0] * sc; h1 += acc[ai][bj][m][1] * sc;
                    s += ((h0[0] * h0[0] + h0[1] * h0[1]) + (h0[2] * h0[2] + h0[3] * h0[3])) + ((h1[0] * h1[0] + h1[1] * h1[1]) + (h1[2] * h1[2] + h1[3] * h1[3]));
                    *(v4u*)(H + off + bj * HALF) = (v4u){cvt_pk_bf16(h0[0], h0[1]), cvt_pk_bf16(h0[2], h0[3]), cvt_pk_bf16(h1[0], h1[1]), cvt_pk_bf16(h1[2], h1[3])};
                    const f32x4 w0 = h0 * wv[bj][0], w1 = h1 * wv[bj][1];
                    if (HB) *(v4u*)(HB + off + bj * HALF) = (v4u){cvt_pk_bf16(w0[0], w0[1]), cvt_pk_bf16(w0[2], w0[3]), cvt_pk_bf16(w1[0], w1[1]), cvt_pk_bf16(w1[2], w1[3])};
                    if (T8) *(v2u*)(T8 + off + bj * HALF) = (v2u){pk4_fp8(w0[0], w0[1], w0[2], w0[3]), pk4_fp8(w1[0], w1[1], w1[2], w1[3])}; }
                s += __shfl_xor(s, 16); s += __shfl_xor(s, 32);
                if (fq == 0) ssq[(size_t)row * 16 + u.pn * 4 + wc] = s;
                if (m == 3) asm volatile("" ::: "memory"); }
    }
};
struct EpiGU {
    static constexpr bool PERM = true; static constexpr int MID_T = 0, NSEG = 1, SEG_STEP = 0; static constexpr bool PRE = true;
    unsigned char* ACT8; const float* b_gu; const int* rowmap; const LAS int* cnt_s; LAS float* tab;
    __device__ __forceinline__ void pre_fetch(const Unit& u, int tid, float& a, float& b) const {
        a = 0.f; b = 0.f;
        if (tid < 256) { const int pos = u.p0 + tid; if (pos < cnt_s[u.e]) a = __int_as_float(rowmap[2 * (u.e * 16384 + pos) + 1]) * (1.f / W8_SCALE);
            b = b_gu[(size_t)u.e * 2048 + (tid >> 7) * 1024 + u.pn * 128 + (tid & 127)]; }
    }
    __device__ __forceinline__ void pre_store(int tid, float a, float b, int par) const { LAS float* t = tab + par * 768; if (tid < 256) { t[tid] = a; t[512 + tid] = b; } }
    __device__ __forceinline__ void operator()(const f32x4 (&acc)[2][2][4][2], const Unit& u, int wr, int wc, int fr, int fq, int par) const {
        int r0 = wr * 64 + fr; asm volatile("" : "+v"(r0)); const int cc = wc * 32 + 8 * fq; const LAS float* t = tab + par * 768;
        f32x4 bgv[2], buv[2];
#pragma unroll
        for (int n = 0; n < 2; ++n) { bgv[n] = *(const LAS f32x4*)(t + 512 + cc + 4 * n); buv[n] = *(const LAS f32x4*)(t + 512 + 128 + cc + 4 * n); }
        float rsv[8];
#pragma unroll
        for (int i = 0; i < 8; ++i) rsv[i] = t[r0 + (i >> 2) * HALF + (i & 3) * 16];
#pragma unroll
        for (int ai = 0; ai < 2; ++ai)
#pragma unroll
            for (int m = 0; m < 4; ++m) { const int rt = r0 + ai * HALF + m * 16; const float rs = rsv[ai * 4 + m]; unsigned w[2];
#pragma unroll
                for (int n = 0; n < 2; ++n) { f32x4 g = acc[ai][0][m][n] * rs + bgv[n], up = acc[ai][1][m][n] * rs + buv[n]; float a[4];
#pragma unroll
                    for (int k = 0; k < 4; ++k) { const float gg = fminf(g[k], 7.f), uu = fminf(fmaxf(up[k], -7.f), 7.f); a[k] = (uu + 1.f) * (gg * fsigmoid(1.702f * gg)); }
                    w[n] = pk4_fp8(a[0], a[1], a[2], a[3]); }
                *(v2u*)(ACT8 + (size_t)(u.pm * BM + rt) * 1024 + u.pn * 128 + cc) = (v2u){w[0], w[1]}; }
    }
};
struct EpiDN {
    static constexpr bool PERM = true; static constexpr int MID_T = 0, NSEG = 1, SEG_STEP = 0; static constexpr bool PRE = true;
    unsigned char* Y; const float* b_dn; LAS float* tab;
    __device__ __forceinline__ void pre_fetch(const Unit& u, int tid, float& a, float& b) const { a = 0.f; b = 0.f; if (tid < 256) b = b_dn[(size_t)u.e * 1024 + u.pn * BM + tid]; }
    __device__ __forceinline__ void pre_store(int tid, float a, float b, int par) const { if (tid < 256) tab[par * 768 + 512 + tid] = b; }
    __device__ __forceinline__ void operator()(const f32x4 (&acc)[2][2][4][2], const Unit& u, int wr, int wc, int fr, int fq, int par) const {
        int row0 = u.pm * BM + wr * 64 + fr; asm volatile("" : "+v"(row0)); const int col0 = u.pn * BM + wc * 32 + 8 * fq; const LAS float* t = tab + par * 768 + 512 + wc * 32 + 8 * fq;
        f32x4 bv[2][2];
#pragma unroll
        for (int bj = 0; bj < 2; ++bj)
#pragma unroll
            for (int n = 0; n < 2; ++n) bv[bj][n] = *(const LAS f32x4*)(t + bj * HALF + 4 * n);
#pragma unroll
        for (int ai = 0; ai < 2; ++ai)
#pragma unroll
            for (int m = 0; m < 4; ++m) { unsigned char* rowp = Y + (size_t)(row0 + ai * HALF + m * 16) * 1024 + col0;
#pragma unroll
                for (int bj = 0; bj < 2; ++bj) { const f32x4 v0 = acc[ai][bj][m][0] * (1.f / W8_SCALE) + bv[bj][0], v1 = acc[ai][bj][m][1] * (1.f / W8_SCALE) + bv[bj][1];
                    *(v2u*)(rowp + bj * HALF) = (v2u){pk4_fp8(v0[0], v0[1], v0[2], v0[3]), pk4_fp8(v1[0], v1[1], v1[2], v1[3])}; } }
    }
};
}
#ifndef FP8_G2
#define FP8_G2 0
#endif
#ifndef FP8_G3
#define FP8_G3 0
#endif
#ifndef FP8_G4
#define FP8_G4 1
#endif
#ifndef FP8_G6
#define FP8_G6 1
#endif
#ifndef I8_G1
#define I8_G1 1
#endif
#ifndef MK_SUBREP
#define MK_SUBREP 0
#endif
constexpr int NWAVES = 8;
constexpr int M_TOK = 16384, SEQ = 2048, NBATCH = 8, DM = 1024;
constexpr int P1C = 8448;
constexpr int C_Q = 0, C_K = 1024, C_V = 1152, C_Z = 1280, C_X = 3328, C_G = 6400;
constexpr int N1 = 8704;
constexpr size_t MiB = 1u << 20;
constexpr size_t WS_CTL = 0, CTL_ZERO_BYTES = 1 * MiB;
constexpr size_t WS_W1T = 1 * MiB, WS_WCKV = 18 * MiB, WS_WCAT = 22 * MiB, WS_WOUT = 28 * MiB, WS_WCQ = 30 * MiB, WS_WCO = 32 * MiB, WS_WR = 34 * MiB, WS_WGU = 35 * MiB, WS_WDN = 163 * MiB;
constexpr size_t WS_P1 = 228 * MiB, WS_DT = 492 * MiB, WS_KVC = 494 * MiB, WS_ACAT = 502 * MiB, WS_ST = 598 * MiB, WS_PREV = 662 * MiB, WS_U = 726 * MiB, WS_MN = 758 * MiB;
constexpr size_t WS_H1 = 762 * MiB, WS_HB = 826 * MiB, WS_MISC = 858 * MiB;
constexpr size_t WS_T8 = WS_ACAT  , WS_MERGED = WS_U, WS_QC = WS_ST, WS_OC = WS_ST + 32 * MiB, WS_H2 = WS_PREV, WS_T = WS_HB, WS_ACT = WS_P1, WS_Y = WS_P1 + 144 * MiB;
constexpr size_t WS_SSQ1 = WS_MISC, WS_SSQ2 = WS_MISC + 1 * MiB, WS_TOKE = WS_MISC + 2 * MiB, WS_TOKP = WS_TOKE + 256 * 1024, WS_TOKW = WS_TOKP + 256 * 1024, WS_CDEC = WS_TOKW + 256 * 1024, WS_ROWMAP = WS_MISC + 3 * MiB  , WS_SSQG = WS_MISC + 7 * MiB, WS_USC = WS_MISC + 7 * MiB + 512 * 1024  , WS_CSC = WS_MISC + 7 * MiB + 768 * 1024  , WS_MSC = WS_MISC + 7 * MiB + 832 * 1024  , WS_KSC = WS_MISC + 7 * MiB + 896 * 1024  ;
constexpr size_t WS_NAIVE = 880 * MiB;
constexpr int CW_TMO = 0, CW_BAR = 4096, CW_CNT = 16384;
constexpr int SCR_BYTES = 139264;
constexpr int TAB_OFF = SCR_BYTES;
constexpr int LDS_BYTES = SCR_BYTES + 16384;
constexpr int TAB_MISC = TAB_OFF;
constexpr int TAB_DT = TAB_OFF + 1024, TAB_ACUM = TAB_OFF + 1024 + 4096;
constexpr int TAB_TE = TAB_OFF + 1024, TAB_TP0 = TAB_TE + 1280, TAB_CNT = TAB_TP0 + 1280, TAB_TB = TAB_CNT + 128, TAB_NT = TAB_TB + 128;

typedef const float* fptr_t;
struct Frame {
    LAS unsigned char* lds; gu32* ctl; int tid, lane, wave, vcu, G;
    unsigned char* ws;
    const __attribute__((address_space(4))) fptr_t* in;
    float* out;
};
enum { I_X = 0, I_MEM, I_NMIXW, I_WIN, I_WGATE, I_BGATE, I_SINKS, I_CONVW, I_CONVB, I_DTB, I_ALOG, I_DSKIP, I_SSMNW, I_WAO, I_WSO, I_WOUT, I_NCW, I_NMW, I_WCQ, I_WCKV, I_WCO, I_NFW, I_WR, I_BR, I_WGU, I_BGU, I_WDN, I_BDN, I_FNW };

__device__ __forceinline__ void tr_item(const float* W, int ldw, int k0, int n0, bf16* dst, int ldt, LAS float* scr, int lane, const float* kscale = nullptr) {
    f32x4 t[8]; const int rr = lane >> 3, c4 = (lane & 7) * 4;
#pragma unroll
    for (int i = 0; i < 8; ++i) { t[i] = *(const GAS f32x4*)(W + (size_t)(k0 + 8 * i + rr) * ldw + n0 + c4); if (kscale) t[i] *= kscale[k0 + 8 * i + rr]; }
#pragma unroll
    for (int i = 0; i < 8; ++i) { LAS float* d = scr + (8 * i + rr) * 33 + c4; d[0] = t[i][0]; d[1] = t[i][1]; d[2] = t[i][2]; d[3] = t[i][3]; }
    LDS_WAIT(); asm volatile("" ::: "memory");
    const int c = lane & 7;
#pragma unroll
    for (int j = 0; j < 4; ++j) { const int n = (lane >> 3) + 8 * j; const LAS float* s = scr + (8 * c) * 33 + n;
        v4u o; o.x = pk2(s[0 * 33], s[1 * 33]); o.y = pk2(s[2 * 33], s[3 * 33]); o.z = pk2(s[4 * 33], s[5 * 33]); o.w = pk2(s[6 * 33], s[7 * 33]);
        *(GAS v4u*)(dst + (size_t)n * ldt + 8 * c) = o; }
    LDS_WAIT(); asm volatile("" ::: "memory");
}
__device__ __forceinline__ void tr_item8(const float* W, int ldw, int k0, int n0, unsigned char* dst, int ldt, LAS float* scr, int lane, float sc, const float* kscale = nullptr) {
    f32x4 t[8]; const int rr = lane >> 3, c4 = (lane & 7) * 4;
#pragma unroll
    for (int i = 0; i < 8; ++i) t[i] = *(const GAS f32x4*)(W + (size_t)(k0 + 8 * i + rr) * ldw + n0 + c4);
#pragma unroll
    for (int i = 0; i < 8; ++i) { LAS float* d = scr + (8 * i + rr) * 33 + c4; const float f = kscale ? sc * kscale[k0 + 8 * i + rr] : sc; d[0] = t[i][0] * f; d[1] = t[i][1] * f; d[2] = t[i][2] * f; d[3] = t[i][3] * f; }
    LDS_WAIT(); asm volatile("" ::: "memory");
    const int n = lane >> 1, hf = lane & 1; const LAS float* s = scr + (32 * hf) * 33 + n;
    unsigned o[8];
#pragma unroll
    for (int j = 0; j < 8; ++j) o[j] = pg8::pk4_fp8(s[(4 * j) * 33], s[(4 * j + 1) * 33], s[(4 * j + 2) * 33], s[(4 * j + 3) * 33]);
    GAS v4u* dp = (GAS v4u*)(dst + (size_t)n * ldt + 32 * hf);
    dp[0] = (v4u){o[0], o[1], o[2], o[3]}; dp[1] = (v4u){o[4], o[5], o[6], o[7]};
    LDS_WAIT(); asm volatile("" ::: "memory");
}
__device__ __forceinline__ void rms_row_to_bf16(const float* xrow, const float* w, bf16* orow, int lane) {
    const GAS f32x4* xr = (const GAS f32x4*)xrow + lane; const GAS f32x4* wr_ = (const GAS f32x4*)w + lane;
    f32x4 v[4]; float s = 0.f;
#pragma unroll
    for (int j = 0; j < 4; ++j) { v[j] = xr[64 * j]; s += (v[j].x * v[j].x + v[j].y * v[j].y) + (v[j].z * v[j].z + v[j].w * v[j].w); }
    const float rstd = 1.f / sqrtf(wave_sum(s) * (1.f / 1024.f) + 1e-5f);
    GAS unsigned long long* o8 = (GAS unsigned long long*)orow + lane;
#pragma unroll
    for (int j = 0; j < 4; ++j) { const f32x4 g = wr_[64 * j]; o8[64 * j] = (unsigned long long)pk2(v[j].x * rstd * g.x, v[j].y * rstd * g.y) | ((unsigned long long)pk2(v[j].z * rstd * g.z, v[j].w * rstd * g.w) << 32); }
}
__device__ __forceinline__ unsigned pk4_i8(float a, float b, float c, float d) {
    return ((unsigned)(int)a & 0xffu) | (((unsigned)(int)b & 0xffu) << 8) | (((unsigned)(int)c & 0xffu) << 16) | ((unsigned)(int)d << 24); }
__device__ __forceinline__ void rms_row_to_i8(const float* xrow, const float* w, unsigned char* orow, float* osc, int lane) {
    const GAS f32x4* xr = (const GAS f32x4*)xrow + lane; const GAS f32x4* wr_ = (const GAS f32x4*)w + lane;
    f32x4 v[4]; float s = 0.f;
#pragma unroll
    for (int j = 0; j < 4; ++j) { v[j] = xr[64 * j]; s += (v[j].x * v[j].x + v[j].y * v[j].y) + (v[j].z * v[j].z + v[j].w * v[j].w); }
    const float rstd = 1.f / sqrtf(wave_sum(s) * (1.f / 1024.f) + 1e-5f); float mx = 0.f;
#pragma unroll
    for (int j = 0; j < 4; ++j) { const f32x4 g = wr_[64 * j]; v[j] = v[j] * rstd * g; mx = fmaxf(fmaxf(fmaxf(fabsf(v[j].x), fabsf(v[j].y)), fmaxf(fabsf(v[j].z), fabsf(v[j].w))), mx); }
#pragma unroll
    for (int o = 1; o < 64; o <<= 1) mx = fmaxf(mx, __shfl_xor(mx, o));
    const float isc = mx > 0.f ? 127.f / mx : 0.f;
#pragma unroll
    for (int j = 0; j < 4; ++j) ((GAS unsigned*)orow)[lane + 64 * j] = pk4_i8(rintf(v[j].x * isc), rintf(v[j].y * isc), rintf(v[j].z * isc), rintf(v[j].w * isc));
    if (lane == 0) *osc = mx * (1.f / 127.f);
}
__device__ __forceinline__ void w1t_colblock_i8(Frame& F, const float* W, int ldw, int n0, unsigned char* dst  , float* csc  ) {
    LAS float* scr = (LAS float*)(F.lds + F.wave * 16384); LAS float* cmax = (LAS float*)(F.lds + TAB_OFF + 1024);
    const int lane = F.lane, rr = lane >> 3, c4 = (lane & 7) * 4, kb0 = 2 * F.wave;
    f32x4 t[2][8]; f32x4 mx = (f32x4){0.f, 0.f, 0.f, 0.f};
#pragma unroll
    for (int b = 0; b < 2; ++b)
#pragma unroll
        for (int i = 0; i < 8; ++i) t[b][i] = *(const GAS f32x4*)(W + (size_t)(64 * (kb0 + b) + 8 * i + rr) * ldw + n0 + c4);
#pragma unroll
    for (int b = 0; b < 2; ++b)
#pragma unroll
        for (int i = 0; i < 8; ++i) { mx[0] = fmaxf(mx[0], fabsf(t[b][i][0])); mx[1] = fmaxf(mx[1], fabsf(t[b][i][1])); mx[2] = fmaxf(mx[2], fabsf(t[b][i][2])); mx[3] = fmaxf(mx[3], fabsf(t[b][i][3])); }
#pragma unroll
    for (int o = 8; o < 64; o <<= 1) { mx[0] = fmaxf(mx[0], __shfl_xor(mx[0], o)); mx[1] = fmaxf(mx[1], __shfl_xor(mx[1], o)); mx[2] = fmaxf(mx[2], __shfl_xor(mx[2], o)); mx[3] = fmaxf(mx[3], __shfl_xor(mx[3], o)); }
    if (lane < 8) *(LAS f32x4*)(cmax + F.wave * 32 + c4) = mx;
    LDS_WAIT(); __syncthreads();
#pragma unroll
    for (int wv = 0; wv < 8; ++wv) { const f32x4 o = *(const LAS f32x4*)(cmax + wv * 32 + c4); mx[0] = fmaxf(mx[0], o[0]); mx[1] = fmaxf(mx[1], o[1]); mx[2] = fmaxf(mx[2], o[2]); mx[3] = fmaxf(mx[3], o[3]); }
    f32x4 isc;
#pragma unroll
    for (int k = 0; k < 4; ++k) isc[k] = mx[k] > 0.f ? 127.f / mx[k] : 0.f;
    if (F.wave == 0 && lane < 8) *(f32x4*)(csc + c4) = mx * (1.f / 127.f);
#pragma unroll
    for (int b = 0; b < 2; ++b) {
#pragma unroll
        for (int i = 0; i < 8; ++i) { LAS float* d = scr + (8 * i + rr) * 33 + c4; d[0] = rintf(t[b][i][0] * isc[0]); d[1] = rintf(t[b][i][1] * isc[1]); d[2] = rintf(t[b][i][2] * isc[2]); d[3] = rintf(t[b][i][3] * isc[3]); }
        LDS_WAIT(); asm volatile("" ::: "memory");
        { const int n = lane >> 1, hf = lane & 1; const LAS float* sp = scr + (32 * hf) * 33 + n; unsigned o[8];
#pragma unroll
          for (int j = 0; j < 8; ++j) o[j] = pk4_i8(sp[(4 * j) * 33], sp[(4 * j + 1) * 33], sp[(4 * j + 2) * 33], sp[(4 * j + 3) * 33]);
          GAS v4u* dp = (GAS v4u*)(dst + (size_t)n * 1024 + 64 * (kb0 + b) + 32 * hf); dp[0] = (v4u){o[0], o[1], o[2], o[3]}; dp[1] = (v4u){o[4], o[5], o[6], o[7]}; }
        LDS_WAIT(); asm volatile("" ::: "memory");
    }
    __syncthreads();
}
__device__ __forceinline__ int gate_row(int nb) { const int col = 32 * nb, half = col >> 10, j = col & 1023; return 6400 + (j >> 7) * 256 + half * 128 + (j & 127); }
__device__ __forceinline__ void p0_prologue(Frame& F) {
    LAS float* scr = (LAS float*)(F.lds + F.wave * 16384);
    const int gw = F.vcu * NWAVES + F.wave, NGW = F.G * NWAVES;
    bf16* W1T = (bf16*)(F.ws + WS_W1T); bf16* WCAT = (bf16*)(F.ws + WS_WCAT);
    constexpr int I1 = 16 * 200, I2 = 16, I3 = 16 * 64, I4 = 16 * 64, I5 = 16 * 32, I6 = 32 * 32, I7 = 16 * 32, I10 = 16, I11 = 32 * 16 * 64, I12 = 32 * 16 * 32;
    constexpr int NITEMS = (I8_G1 ? 0 : I1 + I2 + I3 + I4) + I5 + I6 + 3 * I7 + I10 + I11 + I12;
    for (int it = gw; it < NITEMS; it += NGW) {
        int r = it;
        if (I8_G1) r += I1 + I2 + I3;
        if (r < I1) { const int kb = r / 200, nb = r % 200; tr_item(F.in[I_WIN], 6432, 64 * kb, 32 * nb, W1T + (size_t)(32 * nb) * 1024 + 64 * kb, 1024, scr, F.lane); continue; } r -= I1;
        if (r < I2) { const int kb = r; tr_item(F.in[I_WIN], 6432, 64 * kb, 6400, W1T + (size_t)8448 * 1024 + 64 * kb, 1024, scr, F.lane); continue; } r -= I2;
        if (r < I3) { const int kb = r / 64, nb = r % 64; tr_item(F.in[I_WGATE], 2048, 64 * kb, 32 * nb, W1T + (size_t)gate_row(nb) * 1024 + 64 * kb, 1024, scr, F.lane); continue; } r -= I3;
        if (I8_G1) r += I4;
        if (r < I4) { const int kb = r / 64, nb = r % 64; tr_item(F.in[I_WCKV], 2048, 64 * kb, 32 * nb, (bf16*)(F.ws + WS_WCKV) + (size_t)(32 * nb) * 1024 + 64 * kb, 1024, scr, F.lane); continue; } r -= I4;
        if (r < I5) { const int kb = r / 32, nb = r % 32;
            if (FP8_G2) tr_item8(F.in[I_WAO], 1024, 64 * kb, 32 * nb, (unsigned char*)WCAT + (size_t)(32 * nb) * 3072 + 64 * kb, 3072, scr, F.lane, pg8::W8_SCALE);
            else tr_item(F.in[I_WAO], 1024, 64 * kb, 32 * nb, WCAT + (size_t)(32 * nb) * 3072 + 64 * kb, 3072, scr, F.lane);
            continue; } r -= I5;
        if (r < I6) { const int kb = r / 32, nb = r % 32;
            if (FP8_G2) tr_item8(F.in[I_WSO], 1024, 64 * kb, 32 * nb, (unsigned char*)WCAT + (size_t)(32 * nb) * 3072 + 1024 + 64 * kb, 3072, scr, F.lane, pg8::W8_SCALE, F.in[I_SSMNW]);
            else tr_item(F.in[I_WSO], 1024, 64 * kb, 32 * nb, WCAT + (size_t)(32 * nb) * 3072 + 1024 + 64 * kb, 3072, scr, F.lane, F.in[I_SSMNW]);
            continue; } r -= I6;
        if (r < I7) { const int kb = r / 32, nb = r % 32;
            if (FP8_G3) tr_item8(F.in[I_WOUT], 1024, 64 * kb, 32 * nb, (unsigned char*)(F.ws + WS_WOUT) + (size_t)(32 * nb) * 1024 + 64 * kb, 1024, scr, F.lane, pg8::W8_SCALE);
            else tr_item(F.in[I_WOUT], 1024, 64 * kb, 32 * nb, (bf16*)(F.ws + WS_WOUT) + (size_t)(32 * nb) * 1024 + 64 * kb, 1024, scr, F.lane);
            continue; } r -= I7;
        if (r < I7) { const int kb = r / 32, nb = r % 32;
            if (FP8_G4) tr_item8(F.in[I_WCQ], 1024, 64 * kb, 32 * nb, (unsigned char*)(F.ws + WS_WCQ) + (size_t)(32 * nb) * 1024 + 64 * kb, 1024, scr, F.lane, pg8::W8_SCALE);
            else tr_item(F.in[I_WCQ], 1024, 64 * kb, 32 * nb, (bf16*)(F.ws + WS_WCQ) + (size_t)(32 * nb) * 1024 + 64 * kb, 1024, scr, F.lane);
            continue; } r -= I7;
        if (r < I7) { const int kb = r / 32, nb = r % 32;
            if (FP8_G6) tr_item8(F.in[I_WCO], 1024, 64 * kb, 32 * nb, (unsigned char*)(F.ws + WS_WCO) + (size_t)(32 * nb) * 1024 + 64 * kb, 1024, scr, F.lane, pg8::W8_SCALE);
            else tr_item(F.in[I_WCO], 1024, 64 * kb, 32 * nb, (bf16*)(F.ws + WS_WCO) + (size_t)(32 * nb) * 1024 + 64 * kb, 1024, scr, F.lane);
            continue; } r -= I7;
        if (r < I10) { const int kb = r; tr_item(F.in[I_WR], 32, 64 * kb, 0, (bf16*)(F.ws + WS_WR) + 64 * kb, 1024, scr, F.lane); continue; } r -= I10;
        if (r < I11) { const int e = r / 1024, rr = r % 1024, kb = rr / 64, nb = rr % 64; const int n0 = 32 * nb, up = n0 >= 1024 ? 1 : 0, j = n0 & 1023, drow = (j >> 7) * 256 + up * 128 + (j & 127);
            tr_item8(F.in[I_WGU] + (size_t)e * 1024 * 2048, 2048, 64 * kb, n0, (unsigned char*)(F.ws + WS_WGU) + (size_t)e * 2048 * 1024 + (size_t)drow * 1024 + 64 * kb, 1024, scr, F.lane, pg8::W8_SCALE); continue; } r -= I11;
        { const int e = r / 512, rr = r % 512, kb = rr / 32, nb = rr % 32;
            tr_item8(F.in[I_WDN] + (size_t)e * 1024 * 1024, 1024, 64 * kb, 32 * nb, (unsigned char*)(F.ws + WS_WDN) + (size_t)e * 1024 * 1024 + (size_t)(32 * nb) * 1024 + 64 * kb, 1024, scr, F.lane, pg8::W8_SCALE); }
    }
    if (I8_G1) {
        unsigned char* W8 = (unsigned char*)(F.ws + WS_W1T); float* csc = (float*)(F.ws + WS_CSC);
        __syncthreads();
        for (int task = F.vcu; task < 265 + 64; task += F.G) {
            if (task >= 265) { const int nb = task - 265; w1t_colblock_i8(F, F.in[I_WCKV], 2048, 32 * nb, (unsigned char*)(F.ws + WS_WCKV) + (size_t)(32 * nb) * 1024, (float*)(F.ws + WS_KSC) + 32 * nb); }
            else if (task < 201) { const int drow = task < 200 ? 32 * task : 8448; w1t_colblock_i8(F, F.in[I_WIN], 6432, 32 * task, W8 + (size_t)drow * 1024, csc + drow); }
            else { const int nb = task - 201, drow = gate_row(nb); w1t_colblock_i8(F, F.in[I_WGATE], 2048, 32 * nb, W8 + (size_t)drow * 1024, csc + drow); } }
        for (int i = F.vcu * 512 + F.tid; i < 14336; i += F.G * 512) ((GAS v4u*)(W8 + (size_t)8480 * 1024))[i] = (v4u){0u, 0u, 0u, 0u};
        for (int i = F.vcu * 512 + F.tid; i < 224; i += F.G * 512) csc[8480 + i] = 0.f;
        for (int m = gw; m < M_TOK; m += NGW) rms_row_to_i8(F.in[I_X] + (size_t)m * DM, F.in[I_NMIXW], (unsigned char*)(F.ws + WS_U) + (size_t)m * DM, (float*)(F.ws + WS_USC) + m, F.lane);
    } else {
    for (int i = F.vcu * 512 + F.tid; i < 28672; i += F.G * 512) ((GAS v4u*)(W1T + (size_t)8480 * 1024))[i] = (v4u){0u, 0u, 0u, 0u};
    for (int m = gw; m < M_TOK; m += NGW) rms_row_to_bf16(F.in[I_X] + (size_t)m * DM, F.in[I_NMIXW], (bf16*)(F.ws + WS_U) + (size_t)m * DM, F.lane);
    }
    for (int m = gw; m < NBATCH * 256; m += NGW) {
        if (I8_G1) rms_row_to_i8(F.in[I_MEM] + (size_t)m * DM, F.in[I_NMW], (unsigned char*)(F.ws + WS_MN) + (size_t)m * DM, (float*)(F.ws + WS_MSC) + m, F.lane);
        else rms_row_to_bf16(F.in[I_MEM] + (size_t)m * DM, F.in[I_NMW], (bf16*)(F.ws + WS_MN) + (size_t)m * DM, F.lane); }
}

__device__ __forceinline__ s16x4 tr_read(const LAS unsigned char* p) { return __builtin_bit_cast(s16x4, __builtin_amdgcn_ds_read_tr16_b64_v4i16((LAS s16x4*)p)); }
__device__ __forceinline__ bf16x8 cat8(s16x4 a, s16x4 b) { return (bf16x8){a[0], a[1], a[2], a[3], b[0], b[1], b[2], b[3]}; }
__device__ __forceinline__ bf16x8 pack8(f32x4 a, f32x4 b) { v4u w; w.x = cvt_pk_bf16(a[0], a[1]); w.y = cvt_pk_bf16(a[2], a[3]); w.z = cvt_pk_bf16(b[0], b[1]); w.w = cvt_pk_bf16(b[2], b[3]); return __builtin_bit_cast(bf16x8, w); }
#define MFMA16(a, b, c) __builtin_amdgcn_mfma_f32_16x16x32_bf16((a), (b), (c), 0, 0, 0)
#define WG_BAR() do { asm volatile("s_waitcnt vmcnt(0) lgkmcnt(0)" ::: "memory"); __builtin_amdgcn_s_barrier(); asm volatile("" ::: "memory"); } while (0)
constexpr float LOG2E = 1.4426950408889634f;

constexpr int SWA_STR = 144, SWA_IMG = 272 * SWA_STR;
__device__ __forceinline__ void swa_phase(Frame& F) {
    const bf16* P1 = (const bf16*)(F.ws + WS_P1); bf16* ACAT = (bf16*)(F.ws + WS_ACAT);
    LAS unsigned char* Kimg = F.lds; LAS unsigned char* Vimg = F.lds + SWA_IMG;
    const int lane = F.lane, w = F.wave, q = lane & 15, g = lane >> 4;
    for (int u = F.vcu; u < 256; u += F.G) {
        const int b = u >> 5, kvh = (u >> 4) & 1, n = u & 15;
        for (int pc = F.tid; pc < 2 * 272 * 8; pc += 512) {
            const int img = pc >= 272 * 8 ? 1 : 0, p2 = pc - img * 272 * 8, row = p2 >> 3, ch = p2 & 7; const int s = (n - 1) * 128 + row;
            v4u v = (v4u){0u, 0u, 0u, 0u};
            if (row < 256 && s >= 0) v = *(const GAS v4u*)(P1 + (size_t)(b * SEQ + s) * P1C + (img ? C_V : C_K) + kvh * 64 + ch * 8);
            *(LAS v4u*)((img ? Vimg : Kimg) + row * SWA_STR + ch * 16) = v; }
        WG_BAR();
        const int h = kvh * 8 + w; const float slope2 = exp2f(-0.5f * (float)(h + 1)) * LOG2E, sink2 = F.in[I_SINKS][h] * LOG2E;
        f32x4 bias[9];
#pragma unroll
        for (int j = 0; j < 9; ++j)
#pragma unroll
            for (int r = 0; r < 4; ++r) { const int dist = 128 + q - 16 * j - 4 * g - r; const float bv = -slope2 * (float)dist;
                bias[j][r] = (j == 0) ? (dist < 128 ? bv : -INFINITY) : ((j == 8) ? (dist >= 0 ? bv : -INFINITY) : bv); }
        __builtin_amdgcn_sched_barrier(0);
        bf16x8 qn[2];
#pragma unroll
        for (int ks = 0; ks < 2; ++ks) qn[ks] = *(const GAS bf16x8*)(P1 + (size_t)(b * SEQ + n * 128 + q) * P1C + C_Q + h * 64 + 32 * ks + 8 * g);
        __builtin_amdgcn_sched_barrier(0);
#pragma unroll 1
        for (int i = 0; i < 8; ++i) {
            const int t0 = b * SEQ + n * 128 + 16 * i;
            bf16x8 qf[2]; qf[0] = qn[0]; qf[1] = qn[1];
            { const int tn = i < 7 ? t0 + 16 : t0;
#pragma unroll
              for (int ks = 0; ks < 2; ++ks) qn[ks] = *(const GAS bf16x8*)(P1 + (size_t)(tn + q) * P1C + C_Q + h * 64 + 32 * ks + 8 * g); }
            f32x4 s[10];
#pragma unroll
            for (int j = 0; j < 9; ++j) { s[j] = (f32x4){0.f, 0.f, 0.f, 0.f};
#pragma unroll
                for (int ks = 0; ks < 2; ++ks) { const bf16x8 kf = *(const LAS bf16x8*)(Kimg + (16 * (i + j) + q) * SWA_STR + (32 * ks + 8 * g) * 2); s[j] = MFMA16(kf, qf[ks], s[j]); } }
            s[9] = (f32x4){0.f, 0.f, 0.f, 0.f};
            __builtin_amdgcn_sched_barrier(0);
            float mx = sink2;
#pragma unroll
            for (int j = 0; j < 9; ++j) { const bool dead = (n == 0) && (i + j < 8);
#pragma unroll
                for (int r = 0; r < 4; ++r) { const float v = dead ? -INFINITY : s[j][r] * (0.125f * LOG2E) + bias[j][r]; s[j][r] = v; mx = fmaxf(mx, v); } }
            mx = fmaxf(mx, __shfl_xor(mx, 16)); mx = fmaxf(mx, __shfl_xor(mx, 32));
            float sum = 0.f;
#pragma unroll
            for (int j = 0; j < 9; ++j)
#pragma unroll
                for (int r = 0; r < 4; ++r) { const float p = __builtin_amdgcn_exp2f(s[j][r] - mx); s[j][r] = p; sum += p; }
            sum += __shfl_xor(sum, 16); sum += __shfl_xor(sum, 32); sum += __builtin_amdgcn_exp2f(sink2 - mx);
            const float inv = 1.f / sum;
            __builtin_amdgcn_sched_barrier(0);
            f32x4 o[4];
#pragma unroll
            for (int dt = 0; dt < 4; ++dt) o[dt] = (f32x4){0.f, 0.f, 0.f, 0.f};
#pragma unroll
            for (int kk = 0; kk < 5; ++kk) { const bf16x8 pf = pack8(s[2 * kk], s[2 * kk + 1]);
                const LAS unsigned char* vb = Vimg + (16 * (i + 2 * kk) + 4 * g + (q >> 2)) * SWA_STR + (4 * (q & 3)) * 2;
#pragma unroll
                for (int dt = 0; dt < 4; ++dt) { const bf16x8 vf = cat8(tr_read(vb + dt * 32), tr_read(vb + dt * 32 + 16 * SWA_STR)); o[dt] = MFMA16(vf, pf, o[dt]); } }
#pragma unroll
            for (int dt = 0; dt < 4; ++dt) {
                if (FP8_G2) *(GAS unsigned*)((unsigned char*)ACAT + (size_t)(t0 + q) * 3072 + h * 64 + 16 * dt + 4 * g) = pg8::pk4_fp8(o[dt][0] * inv, o[dt][1] * inv, o[dt][2] * inv, o[dt][3] * inv);
                else { v2u wv; wv.x = cvt_pk_bf16(o[dt][0] * inv, o[dt][1] * inv); wv.y = cvt_pk_bf16(o[dt][2] * inv, o[dt][3] * inv);
                    *(GAS v2u*)(ACAT + (size_t)(t0 + q) * 3072 + h * 64 + 16 * dt + 4 * g) = wv; } }
        }
        WG_BAR();
    }
}

__device__ __forceinline__ void ssd_tables(Frame& F, int b, int c, int g) {
    const float* DT = (const float*)(F.ws + WS_DT); LAS float* dt_s = (LAS float*)(F.lds + TAB_DT); LAS float* ac_s = (LAS float*)(F.lds + TAB_ACUM);
    const int hh = F.wave, h = 8 * g + hh, lane = F.lane; const float A = -expf(F.in[I_ALOG][h]) * LOG2E, dtb = F.in[I_DTB][h];
    const int tok = b * SEQ + c * 128 + 2 * lane;
    float d0 = DT[(size_t)tok * 32 + h] + dtb, d1 = DT[(size_t)(tok + 1) * 32 + h] + dtb;
    d0 = d0 > 20.f ? d0 : log1pf(expf(d0)); d1 = d1 > 20.f ? d1 : log1pf(expf(d1));
    const float a0 = d0 * A, a1 = d1 * A; float run = a0 + a1;
#pragma unroll
    for (int o = 1; o < 64; o <<= 1) { const float t = __shfl_up(run, o); if (lane >= o) run += t; }
    dt_s[hh * 128 + 2 * lane] = d0; dt_s[hh * 128 + 2 * lane + 1] = d1; ac_s[hh * 128 + 2 * lane] = run - a1; ac_s[hh * 128 + 2 * lane + 1] = run;
}
template <int NR>
__device__ __forceinline__ void conv_load(const bf16* P1, int b, int s0, int c0, v4u (&x)[NR + 3]) {
    const bf16* base = P1 + (size_t)(b * SEQ) * P1C + C_X + c0;
#pragma unroll
    for (int i = 0; i < NR + 3; ++i) { const int ss = s0 - 3 + i; x[i] = (v4u){0u, 0u, 0u, 0u}; if (ss >= 0) x[i] = *(const GAS v4u*)(base + (size_t)ss * P1C); }
}
template <int NR, class Emit>
__device__ __forceinline__ void conv_apply(const v4u (&x)[NR + 3], const float* cw, const float* cb, int c0, Emit&& emit) {
    float wt[4][8], bs[8];
    { const f32x4 b0 = *(const f32x4*)(cb + c0), b1 = *(const f32x4*)(cb + c0 + 4); bs[0] = b0[0]; bs[1] = b0[1]; bs[2] = b0[2]; bs[3] = b0[3]; bs[4] = b1[0]; bs[5] = b1[1]; bs[6] = b1[2]; bs[7] = b1[3]; }
#pragma unroll
    for (int j = 0; j < 4; ++j) { const f32x4 w0 = *(const f32x4*)(cw + j * 3072 + c0), w1 = *(const f32x4*)(cw + j * 3072 + c0 + 4);
        wt[j][0] = w0[0]; wt[j][1] = w0[1]; wt[j][2] = w0[2]; wt[j][3] = w0[3]; wt[j][4] = w1[0]; wt[j][5] = w1[1]; wt[j][6] = w1[2]; wt[j][7] = w1[3]; }
#pragma unroll
    for (int r = 0; r < NR; ++r) { float a[8];
#pragma unroll
        for (int k = 0; k < 8; ++k) a[k] = bs[k];
#pragma unroll
        for (int j = 0; j < 4; ++j) { const v4u xv = x[r + j];
            a[0] += wt[j][0] * bflo(xv.x); a[1] += wt[j][1] * bfhi(xv.x); a[2] += wt[j][2] * bflo(xv.y); a[3] += wt[j][3] * bfhi(xv.y); a[4] += wt[j][4] * bflo(xv.z); a[5] += wt[j][5] * bfhi(xv.z); a[6] += wt[j][6] * bflo(xv.w); a[7] += wt[j][7] * bfhi(xv.w); }
#pragma unroll
        for (int k = 0; k < 8; ++k) a[k] = a[k] * pg8::fsigmoid(a[k]);
        emit(r, a); }
}
template <int NR, class Emit>
__device__ __forceinline__ void conv_rows(const bf16* P1, const float* cw, const float* cb, int b, int s0, int c0, Emit&& emit) {
    v4u x[NR + 3]; conv_load<NR>(P1, b, s0, c0, x); conv_apply<NR>(x, cw, cb, c0, emit);
}
__device__ __forceinline__ v4u pack8u(const float (&v)[8], float sc) { return (v4u){cvt_pk_bf16(v[0] * sc, v[1] * sc), cvt_pk_bf16(v[2] * sc, v[3] * sc), cvt_pk_bf16(v[4] * sc, v[5] * sc), cvt_pk_bf16(v[6] * sc, v[7] * sc)}; }

constexpr int SB_STR = 272, SX_STR = 528;
__device__ __forceinline__ void ssd_states_phase(Frame& F) {
    const bf16* P1 = (const bf16*)(F.ws + WS_P1); bf16* ST = (bf16*)(F.ws + WS_ST); float* CDEC = (float*)(F.ws + WS_CDEC);
    const float* cw = F.in[I_CONVW]; const float* cb = F.in[I_CONVB];
    LAS unsigned char* Bimg = F.lds; LAS unsigned char* Ximg = F.lds + 128 * SB_STR;
    LAS float* dt_s = (LAS float*)(F.lds + TAB_DT); LAS float* ac_s = (LAS float*)(F.lds + TAB_ACUM);
    const int lane = F.lane, w = F.wave, q = lane & 15, g4 = lane >> 4;
    for (int u = F.vcu; u < 512; u += F.G) {
        const int b = u >> 6, c = (u >> 2) & 15, g = u & 3;
        if (c == 15) continue;
        ssd_tables(F, b, c, g);
        { const int ch = F.tid & 15, l0 = (F.tid >> 4) * 4;
          conv_rows<4>(P1, cw, cb, b, c * 128 + l0, 2048 + 128 * g + 8 * ch, [&](int r, const float (&v)[8]) { *(LAS v4u*)(Bimg + (l0 + r) * SB_STR + ch * 16) = pack8u(v, 1.f); }); }
        WG_BAR();
        if (F.tid < 8) CDEC[(b * 16 + c) * 32 + 8 * g + F.tid] = __builtin_amdgcn_exp2f(ac_s[F.tid * 128 + 127]);
#pragma unroll 1
        for (int half = 0; half < 2; ++half) {
            { const int ch = F.tid & 31, l0 = (F.tid >> 5) * 8, hh = half * 4 + (ch >> 3); const float aend = ac_s[hh * 128 + 127];
              conv_rows<8>(P1, cw, cb, b, c * 128 + l0, 512 * g + 256 * half + 8 * ch, [&](int r, const float (&v)[8]) {
                  const float sc = dt_s[hh * 128 + l0 + r] * __builtin_amdgcn_exp2f(aend - ac_s[hh * 128 + l0 + r]);
                  *(LAS v4u*)(Ximg + (l0 + r) * SX_STR + ch * 16) = pack8u(v, sc); }); }
            WG_BAR();
            const int hl = w >> 1, nt0 = (w & 1) * 4;
            f32x4 acc[4][4];
#pragma unroll
            for (int a = 0; a < 4; ++a)
#pragma unroll
                for (int p = 0; p < 4; ++p) acc[a][p] = (f32x4){0.f, 0.f, 0.f, 0.f};
#pragma unroll
            for (int ks = 0; ks < 4; ++ks) {
                const int lrow = 32 * ks + 8 * g4 + (q >> 2);
                bf16x8 bf[4], xf[4];
#pragma unroll
                for (int a = 0; a < 4; ++a) { const LAS unsigned char* p = Bimg + lrow * SB_STR + (16 * (nt0 + a) + 4 * (q & 3)) * 2; bf[a] = cat8(tr_read(p), tr_read(p + 4 * SB_STR)); }
#pragma unroll
                for (int p4 = 0; p4 < 4; ++p4) { const LAS unsigned char* p = Ximg + lrow * SX_STR + (64 * hl + 16 * p4 + 4 * (q & 3)) * 2; xf[p4] = cat8(tr_read(p), tr_read(p + 4 * SX_STR)); }
#pragma unroll
                for (int a = 0; a < 4; ++a)
#pragma unroll
                    for (int p4 = 0; p4 < 4; ++p4) acc[a][p4] = MFMA16(bf[a], xf[p4], acc[a][p4]);
            }
            bf16* stp = ST + ((size_t)((b * 16 + c) * 32 + 8 * g + half * 4 + hl)) * 8192;
#pragma unroll
            for (int a = 0; a < 4; ++a)
#pragma unroll
                for (int p4 = 0; p4 < 4; ++p4) { v2u wv; wv.x = cvt_pk_bf16(acc[a][p4][0], acc[a][p4][1]); wv.y = cvt_pk_bf16(acc[a][p4][2], acc[a][p4][3]);
                    *(GAS v2u*)(stp + (16 * p4 + q) * 128 + 16 * (nt0 + a) + 4 * g4) = wv; }
            WG_BAR();
        }
    }
}
__device__ __forceinline__ void ssd_scan_phase(Frame& F) {
    const bf16* ST = (const bf16*)(F.ws + WS_ST); bf16* PREV = (bf16*)(F.ws + WS_PREV); const float* CDEC = (const float*)(F.ws + WS_CDEC);
    for (int it = F.vcu * 512 + F.tid; it < 8 * 32 * 1024; it += F.G * 512) {
        const int b = it >> 15, h = (it >> 10) & 31, e8 = it & 1023; float carry[8];
#pragma unroll
        for (int k = 0; k < 8; ++k) carry[k] = 0.f;
#pragma unroll 5
        for (int c = 0; c < 16; ++c) { const size_t off = ((size_t)((b * 16 + c) * 32 + h)) * 8192 + e8 * 8;
            *(GAS v4u*)(PREV + off) = (v4u){cvt_pk_bf16(carry[0], carry[1]), cvt_pk_bf16(carry[2], carry[3]), cvt_pk_bf16(carry[4], carry[5]), cvt_pk_bf16(carry[6], carry[7])};
            if (c < 15) { const float dec = CDEC[(b * 16 + c) * 32 + h]; const v4u s = *(const GAS v4u*)(ST + off);
                carry[0] = carry[0] * dec + bflo(s.x); carry[1] = carry[1] * dec + bfhi(s.x); carry[2] = carry[2] * dec + bflo(s.y); carry[3] = carry[3] * dec + bfhi(s.y);
                carry[4] = carry[4] * dec + bflo(s.z); carry[5] = carry[5] * dec + bfhi(s.z); carry[6] = carry[6] * dec + bflo(s.w); carry[7] = carry[7] * dec + bfhi(s.w); } }
    }
}
constexpr int SXF_STR = 1040;
__device__ __forceinline__ void ssd_out_phase(Frame& F) {
    const bf16* P1 = (const bf16*)(F.ws + WS_P1); const bf16* PREV = (const bf16*)(F.ws + WS_PREV); bf16* ACAT = (bf16*)(F.ws + WS_ACAT);
    const float* cw = F.in[I_CONVW]; const float* cb = F.in[I_CONVB];
    LAS unsigned char* Bimg = F.lds; LAS unsigned char* Cimg = F.lds + 128 * SB_STR; LAS unsigned char* Ximg = F.lds;
    LAS float* dt_s = (LAS float*)(F.lds + TAB_DT); LAS float* ac_s = (LAS float*)(F.lds + TAB_ACUM);
    const int lane = F.lane, w = F.wave, q = lane & 15, g4 = lane >> 4;
    for (int u = F.vcu; u < 512; u += F.G) {
        const int b = u >> 6, c = (u >> 2) & 15, g = u & 3;
        ssd_tables(F, b, c, g);
        { const int ch = F.tid & 31, l0 = (F.tid >> 5) * 8; LAS unsigned char* img = ch >= 16 ? Cimg : Bimg;
          conv_rows<8>(P1, cw, cb, b, c * 128 + l0, 2048 + (ch >= 16 ? 512 : 0) + 128 * g + 8 * (ch & 15), [&](int r, const float (&v)[8]) { *(LAS v4u*)(img + (l0 + r) * SB_STR + (ch & 15) * 16) = pack8u(v, 1.f); }); }
        const int xch = F.tid & 63, xl0 = (F.tid >> 6) * 16;
        v4u x0[11]; conv_load<8>(P1, b, c * 128 + xl0, 512 * g + 8 * xch, x0);
        const int lq = 16 * w + q; const int tok = b * SEQ + c * 128 + lq;
        const bf16* pvb = PREV + ((size_t)((b * 16 + c) * 32 + 8 * g)) * 8192 + q * 128 + 8 * g4;
        const bf16* zb = P1 + (size_t)tok * P1C + C_Z + 512 * g + 4 * g4;
        asm volatile("s_waitcnt lgkmcnt(0)" ::: "memory"); __builtin_amdgcn_s_barrier(); asm volatile("" ::: "memory");
        bf16x8 cfr[4];
#pragma unroll
        for (int ks = 0; ks < 4; ++ks) cfr[ks] = *(const LAS bf16x8*)(Cimg + (16 * w + q) * SB_STR + (32 * ks + 8 * g4) * 2);
        f32x4 cbt[8];
#pragma unroll
        for (int st = 0; st < 8; ++st) { cbt[st] = (f32x4){0.f, 0.f, 0.f, 0.f};
            if (st <= w) {
#pragma unroll
                for (int ks = 0; ks < 4; ++ks) { const bf16x8 bfr = *(const LAS bf16x8*)(Bimg + (16 * st + q) * SB_STR + (32 * ks + 8 * g4) * 2); cbt[st] = MFMA16(bfr, cfr[ks], cbt[st]); } } }
        asm volatile("s_waitcnt lgkmcnt(0)" ::: "memory"); __builtin_amdgcn_s_barrier(); asm volatile("" ::: "memory");
        conv_apply<8>(x0, cw, cb, 512 * g + 8 * xch, [&](int r, const float (&v)[8]) { *(LAS v4u*)(Ximg + (xl0 + r) * SXF_STR + xch * 16) = pack8u(v, 1.f); });
        conv_rows<8>(P1, cw, cb, b, c * 128 + xl0 + 8, 512 * g + 8 * xch, [&](int r, const float (&v)[8]) { *(LAS v4u*)(Ximg + (xl0 + 8 + r) * SXF_STR + xch * 16) = pack8u(v, 1.f); });
        bf16x8 pfc[16]; v2u zc[4];
#pragma unroll
        for (int ks = 0; ks < 4; ++ks)
#pragma unroll
            for (int p4 = 0; p4 < 4; ++p4) pfc[ks * 4 + p4] = *(const GAS bf16x8*)(pvb + (16 * p4) * 128 + 32 * ks);
#pragma unroll
        for (int p4 = 0; p4 < 4; ++p4) zc[p4] = *(const GAS v2u*)(zb + 16 * p4);
        asm volatile("s_waitcnt lgkmcnt(0)" ::: "memory"); __builtin_amdgcn_s_barrier(); asm volatile("" ::: "memory");
        float ssq = 0.f;
#pragma unroll 1
        for (int hh = 0; hh < 8; ++hh) {
            const int h = 8 * g + hh; const float al = ac_s[hh * 128 + lq];
            const int hn = hh < 7 ? hh + 1 : 7;
            v2u zn[4];
#pragma unroll
            for (int p4 = 0; p4 < 4; ++p4) zn[p4] = *(const GAS v2u*)(zb + 64 * hn + 16 * p4);
            f32x4 y[4];
#pragma unroll
            for (int p4 = 0; p4 < 4; ++p4) y[p4] = (f32x4){0.f, 0.f, 0.f, 0.f};
#pragma unroll
            for (int ks = 0; ks < 4; ++ks)
#pragma unroll
                for (int p4 = 0; p4 < 4; ++p4) y[p4] = MFMA16(pfc[ks * 4 + p4], cfr[ks], y[p4]);
#pragma unroll
            for (int ks = 0; ks < 4; ++ks)
#pragma unroll
                for (int p4 = 0; p4 < 4; ++p4) pfc[ks * 4 + p4] = *(const GAS bf16x8*)(pvb + (size_t)hn * 8192 + (16 * p4) * 128 + 32 * ks);
            __builtin_amdgcn_sched_barrier(0);
            const float ea = __builtin_amdgcn_exp2f(al);
#pragma unroll
            for (int p4 = 0; p4 < 4; ++p4) y[p4] *= ea;
#pragma unroll
            for (int kk = 0; kk < 4; ++kk) {
                if (2 * kk <= w) {
                    f32x4 m0, m1;
                    { const int st = 2 * kk; const f32x4 as = *(const LAS f32x4*)(ac_s + hh * 128 + 16 * st + 4 * g4), ds = *(const LAS f32x4*)(dt_s + hh * 128 + 16 * st + 4 * g4);
#pragma unroll
                        for (int r = 0; r < 4; ++r) { const int s = 16 * st + 4 * g4 + r; m0[r] = s <= lq ? cbt[st][r] * __builtin_amdgcn_exp2f(al - as[r]) * ds[r] : 0.f; } }
                    { const int st = 2 * kk + 1; const f32x4 as = *(const LAS f32x4*)(ac_s + hh * 128 + 16 * st + 4 * g4), ds = *(const LAS f32x4*)(dt_s + hh * 128 + 16 * st + 4 * g4);
#pragma unroll
                        for (int r = 0; r < 4; ++r) { const int s = 16 * st + 4 * g4 + r; m1[r] = (st <= w && s <= lq) ? cbt[st][r] * __builtin_amdgcn_exp2f(al - as[r]) * ds[r] : 0.f; } }
                    const bf16x8 mf = pack8(m0, m1);
                    const LAS unsigned char* xb = Ximg + (32 * kk + 4 * g4 + (q >> 2)) * SXF_STR + (64 * hh + 4 * (q & 3)) * 2;
#pragma unroll
                    for (int p4 = 0; p4 < 4; ++p4) { const bf16x8 xf = cat8(tr_read(xb + p4 * 32), tr_read(xb + p4 * 32 + 16 * SXF_STR)); y[p4] = MFMA16(xf, mf, y[p4]); }
                }
            }
            const float Dh = F.in[I_DSKIP][h];
#pragma unroll
            for (int p4 = 0; p4 < 4; ++p4) { const int ch = 64 * hh + 16 * p4 + 4 * g4;
                const v2u xv = *(const LAS v2u*)(Ximg + lq * SXF_STR + ch * 2); const v2u zv = zc[p4];
                const float v0 = (y[p4][0] + bflo(xv.x) * Dh) * bflo(zv.x), v1 = (y[p4][1] + bfhi(xv.x) * Dh) * bfhi(zv.x), v2 = (y[p4][2] + bflo(xv.y) * Dh) * bflo(zv.y), v3 = (y[p4][3] + bfhi(xv.y) * Dh) * bfhi(zv.y);
                ssq += (v0 * v0 + v1 * v1) + (v2 * v2 + v3 * v3);
                if (FP8_G2) *(GAS unsigned*)((unsigned char*)ACAT + (size_t)tok * 3072 + 1024 + 512 * g + ch) = pg8::pk4_fp8(v0, v1, v2, v3);
                else { v2u o; o.x = cvt_pk_bf16(v0, v1); o.y = cvt_pk_bf16(v2, v3);
                    *(GAS v2u*)(ACAT + (size_t)tok * 3072 + 1024 + 512 * g + ch) = o; } }
#pragma unroll
            for (int p4 = 0; p4 < 4; ++p4) zc[p4] = zn[p4];
        }
        ssq += __shfl_xor(ssq, 16); ssq += __shfl_xor(ssq, 32);
        if (g4 == 0) ((float*)(F.ws + WS_SSQG))[(size_t)tok * 4 + g] = ssq;
        WG_BAR();
    }
}

constexpr int CX_STR = 528;
__device__ __forceinline__ void cross_units(Frame& F, int u_begin, int u_end, int u_step) {
    const bf16* QC = (const bf16*)(F.ws + WS_QC); const bf16* KVC = (const bf16*)(F.ws + WS_KVC); bf16* OC = (bf16*)(F.ws + WS_OC);
    LAS unsigned char* img = F.lds; const int lane = F.lane, w = F.wave, q = lane & 15, g = lane >> 4;
    for (int u = u_begin; u < u_end; u += u_step) {
        const int b = u >> 6, hd = (u >> 4) & 3, qb = u & 15; const int t0 = b * SEQ + qb * 128 + 16 * w;
#pragma unroll 1
        for (int pb = 0; pb < 2; ++pb) { v4u tmp[8];
#pragma unroll
            for (int i = 0; i < 8; ++i) { const int pc = F.tid + 512 * (pb * 8 + i), row = pc >> 5, ch = pc & 31; tmp[i] = *(const GAS v4u*)(KVC + (size_t)(b * 256 + row) * 2048 + hd * 256 + ch * 8); }
#pragma unroll
            for (int i = 0; i < 8; ++i) { const int pc = F.tid + 512 * (pb * 8 + i), row = pc >> 5, ch = pc & 31; *(LAS v4u*)(img + row * CX_STR + ch * 16) = tmp[i]; } }
        bf16x8 qf[8];
#pragma unroll
        for (int ks = 0; ks < 8; ++ks) qf[ks] = *(const GAS bf16x8*)(QC + (size_t)(t0 + q) * 1024 + hd * 256 + 32 * ks + 8 * g);
        WG_BAR();
        f32x4 s[16];
#pragma unroll
        for (int kt = 0; kt < 16; ++kt) { s[kt] = (f32x4){0.f, 0.f, 0.f, 0.f};
#pragma unroll
            for (int ks = 0; ks < 8; ++ks) { const bf16x8 kf = *(const LAS bf16x8*)(img + (16 * kt + q) * CX_STR + (32 * ks + 8 * g) * 2); s[kt] = MFMA16(kf, qf[ks], s[kt]); } }
        float mx = -INFINITY;
#pragma unroll
        for (int kt = 0; kt < 16; ++kt)
#pragma unroll
            for (int r = 0; r < 4; ++r) { s[kt][r] *= 0.0625f * LOG2E; mx = fmaxf(mx, s[kt][r]); }
        mx = fmaxf(mx, __shfl_xor(mx, 16)); mx = fmaxf(mx, __shfl_xor(mx, 32));
        float sum = 0.f;
#pragma unroll
        for (int kt = 0; kt < 16; ++kt)
#pragma unroll
            for (int r = 0; r < 4; ++r) { const float p = __builtin_amdgcn_exp2f(s[kt][r] - mx); s[kt][r] = p; sum += p; }
        sum += __shfl_xor(sum, 16); sum += __shfl_xor(sum, 32);
        const float inv = 1.f / sum;
        bf16x8 pf[8];
#pragma unroll
        for (int kk = 0; kk < 8; ++kk) pf[kk] = pack8(s[2 * kk], s[2 * kk + 1]);
        WG_BAR();
#pragma unroll 1
        for (int pb = 0; pb < 2; ++pb) { v4u tmp[8];
#pragma unroll
            for (int i = 0; i < 8; ++i) { const int pc = F.tid + 512 * (pb * 8 + i), row = pc >> 5, ch = pc & 31; tmp[i] = *(const GAS v4u*)(KVC + (size_t)(b * 256 + row) * 2048 + 1024 + hd * 256 + ch * 8); }
#pragma unroll
            for (int i = 0; i < 8; ++i) { const int pc = F.tid + 512 * (pb * 8 + i), row = pc >> 5, ch = pc & 31; *(LAS v4u*)(img + row * CX_STR + ch * 16) = tmp[i]; } }
        WG_BAR();
#pragma unroll 1
        for (int dh = 0; dh < 2; ++dh) {
            f32x4 o[8];
#pragma unroll
            for (int d = 0; d < 8; ++d) o[d] = (f32x4){0.f, 0.f, 0.f, 0.f};
#pragma unroll
            for (int kk = 0; kk < 8; ++kk) { const LAS unsigned char* vb = img + (32 * kk + 4 * g + (q >> 2)) * CX_STR + (128 * dh + 4 * (q & 3)) * 2;
#pragma unroll
                for (int d = 0; d < 8; ++d) { const bf16x8 vf = cat8(tr_read(vb + d * 32), tr_read(vb + d * 32 + 16 * CX_STR)); o[d] = MFMA16(vf, pf[kk], o[d]); } }
#pragma unroll
            for (int d = 0; d < 8; ++d) {
                if (FP8_G6) *(GAS unsigned*)((unsigned char*)OC + (size_t)(t0 + q) * 1024 + hd * 256 + 128 * dh + 16 * d + 4 * g) = pg8::pk4_fp8(o[d][0] * inv, o[d][1] * inv, o[d][2] * inv, o[d][3] * inv);
                else { v2u wv; wv.x = cvt_pk_bf16(o[d][0] * inv, o[d][1] * inv); wv.y = cvt_pk_bf16(o[d][2] * inv, o[d][3] * inv);
                    *(GAS v2u*)(OC + (size_t)(t0 + q) * 1024 + hd * 256 + 128 * dh + 16 * d + 4 * g) = wv; } }
        }
        WG_BAR();
    }
}

__device__ __forceinline__ void router_phase(Frame& F) {
    const bf16* T = (const bf16*)(F.ws + WS_T); const bf16* WR = (const bf16*)(F.ws + WS_WR); const float* ssq = (const float*)(F.ws + WS_SSQ2);
    int* tok_e = (int*)(F.ws + WS_TOKE); int* tok_p = (int*)(F.ws + WS_TOKP); float* tok_w = (float*)(F.ws + WS_TOKW); int* rowmap = (int*)(F.ws + WS_ROWMAP);
    LAS int* hist = (LAS int*)(F.lds + TAB_TE); LAS int* base = hist + 32;
    const int lane = F.lane, q = lane & 15, g = lane >> 4;
    for (int tb = F.vcu; tb * 4 < M_TOK / 16; tb += F.G) {
        if (F.tid < 32) hist[F.tid] = 0;
        __syncthreads();
        const int tile = tb * 4 + F.wave; const bool live = F.wave < 4;
        int ei[4] = {0, 0, 0, 0}, lp[4] = {0, 0, 0, 0}; float wv[4] = {0.f, 0.f, 0.f, 0.f}; float rs = 0.f; const int t0 = tile * 16;
        if (live) {
            f32x4 a0 = (f32x4){0.f, 0.f, 0.f, 0.f}, a1 = a0;
#pragma unroll 8
            for (int ks = 0; ks < 32; ++ks) { const bf16x8 tf = *(const GAS bf16x8*)(T + (size_t)(t0 + q) * 1024 + 32 * ks + 8 * g);
                const bf16x8 w0 = *(const GAS bf16x8*)(WR + (size_t)q * 1024 + 32 * ks + 8 * g), w1 = *(const GAS bf16x8*)(WR + (size_t)(16 + q) * 1024 + 32 * ks + 8 * g);
                a0 = MFMA16(w0, tf, a0); a1 = MFMA16(w1, tf, a1); }
            rs = pg8::row_rstd(ssq, t0 + q); const float* br = F.in[I_BR];
            float lv[8];
#pragma unroll
            for (int r = 0; r < 4; ++r) { lv[r] = a0[r] * rs + br[4 * g + r]; lv[4 + r] = a1[r] * rs + br[16 + 4 * g + r]; }
            float ev[4];
#pragma unroll
            for (int k = 0; k < 4; ++k) {
                float bv = -INFINITY; int bi = 0;
#pragma unroll
                for (int r = 0; r < 8; ++r) { const int e = (r < 4 ? 0 : 16) + 4 * g + (r & 3); if (lv[r] > bv) { bv = lv[r]; bi = e; } }
#pragma unroll
                for (int o = 16; o <= 32; o <<= 1) { const float ov = __shfl_xor(bv, o); const int oi = __shfl_xor(bi, o); if (ov > bv || (ov == bv && oi < bi)) { bv = ov; bi = oi; } }
                ei[k] = bi; ev[k] = bv;
#pragma unroll
                for (int r = 0; r < 8; ++r) { const int e = (r < 4 ? 0 : 16) + 4 * g + (r & 3); if (e == bi) lv[r] = -INFINITY; }
            }
            float sum = 0.f;
#pragma unroll
            for (int k = 0; k < 4; ++k) { wv[k] = expf(ev[k] - ev[0]); sum += wv[k]; }
            const float inv = 1.f / sum;
#pragma unroll
            for (int k = 0; k < 4; ++k) wv[k] *= inv;
            if (g == 0) {
#pragma unroll
                for (int k = 0; k < 4; ++k) lp[k] = __hip_atomic_fetch_add(hist + ei[k], 1, __ATOMIC_RELAXED, __HIP_MEMORY_SCOPE_WORKGROUP); }
        }
        __syncthreads();
        if (F.tid < 32) { const int hcnt = hist[F.tid]; base[F.tid] = hcnt > 0 ? (int)__hip_atomic_fetch_add((unsigned*)(F.ctl + CW_CNT + 64 * F.tid), (unsigned)hcnt, RLX_AGENT) : 0; }
        __syncthreads();
        if (live && g == 0) { const int tok = t0 + q;
#pragma unroll
            for (int k = 0; k < 4; ++k) { const int pos = base[ei[k]] + lp[k];
                *(int2*)(rowmap + 2 * (ei[k] * 16384 + pos)) = make_int2(tok, __float_as_int(rs)); tok_e[tok * 4 + k] = ei[k]; tok_p[tok * 4 + k] = pos; tok_w[tok * 4 + k] = wv[k]; } }
        __syncthreads();
    }
}
__device__ __forceinline__ int moe_tables(Frame& F) {
    LAS int* tile_e = (LAS int*)(F.lds + TAB_TE); LAS int* tile_p0 = (LAS int*)(F.lds + TAB_TP0); LAS int* cnt_s = (LAS int*)(F.lds + TAB_CNT); LAS int* tb = (LAS int*)(F.lds + TAB_TB); LAS int* ntp = (LAS int*)(F.lds + TAB_NT);
    __syncthreads();
    if (F.tid < 32) cnt_s[F.tid] = (int)__hip_atomic_load((unsigned*)(F.ctl + CW_CNT + 64 * F.tid), RLX_AGENT);
    __syncthreads();
    if (F.tid == 0) { int j = 0; for (int e = 0; e < 32; ++e) { tb[e] = j; const int c = cnt_s[e]; for (int p = 0; p < c && j < 320; p += 256) { tile_e[j] = e; tile_p0[j] = p; ++j; } } ntp[0] = j; }
    __syncthreads();
    return ntp[0];
}
__device__ __forceinline__ void combine_phase(Frame& F) {
    const bf16* H2 = (const bf16*)(F.ws + WS_H2); const unsigned char* Y = (const unsigned char*)(F.ws + WS_Y);
    const int* tok_e = (const int*)(F.ws + WS_TOKE); const int* tok_p = (const int*)(F.ws + WS_TOKP); const float* tok_w = (const float*)(F.ws + WS_TOKW);
    LAS int* tb = (LAS int*)(F.lds + TAB_TB); const float* fw = F.in[I_FNW];
    const int lane = F.lane; const int gw = F.vcu * NWAVES + F.wave, NGW = F.G * NWAVES;
    constexpr int NT = 4;
    for (int tok0 = NT * gw; tok0 < M_TOK; tok0 += NT * NGW) {
        f32x4 v[NT][4]; size_t slot[NT][4]; float wk[NT][4];
#pragma unroll
        for (int t = 0; t < NT; ++t)
#pragma unroll
            for (int k = 0; k < 4; ++k) { const int tok = tok0 + t; const int e = tok_e[tok * 4 + k]; slot[t][k] = (size_t)tb[e] * 256 + tok_p[tok * 4 + k]; wk[t][k] = tok_w[tok * 4 + k]; }
        v2u hv[NT][4]; unsigned y[NT][4][4];
#pragma unroll
        for (int t = 0; t < NT; ++t)
#pragma unroll
            for (int j = 0; j < 4; ++j) hv[t][j] = *(const GAS v2u*)(H2 + (size_t)(tok0 + t) * 1024 + 4 * lane + 256 * j);
#pragma unroll
        for (int t = 0; t < NT; ++t)
#pragma unroll
            for (int k = 0; k < 4; ++k)
#pragma unroll
                for (int j = 0; j < 4; ++j) y[t][k][j] = *(const GAS unsigned*)(Y + slot[t][k] * 1024 + 4 * lane + 256 * j);
#pragma unroll
        for (int t = 0; t < NT; ++t) {
#pragma unroll
            for (int j = 0; j < 4; ++j) v[t][j] = (f32x4){bflo(hv[t][j].x), bfhi(hv[t][j].x), bflo(hv[t][j].y), bfhi(hv[t][j].y)};
#pragma unroll
            for (int k = 0; k < 4; ++k)
#pragma unroll
                for (int j = 0; j < 4; ++j) { const f32x2 lo = __builtin_amdgcn_cvt_pk_f32_fp8((int)y[t][k][j], false), hi = __builtin_amdgcn_cvt_pk_f32_fp8((int)y[t][k][j], true);
                    v[t][j][0] += wk[t][k] * lo[0]; v[t][j][1] += wk[t][k] * lo[1]; v[t][j][2] += wk[t][k] * hi[0]; v[t][j][3] += wk[t][k] * hi[1]; } }
#pragma unroll
        for (int t = 0; t < NT; ++t) { float s = 0.f;
#pragma unroll
            for (int j = 0; j < 4; ++j) s += (v[t][j][0] * v[t][j][0] + v[t][j][1] * v[t][j][1]) + (v[t][j][2] * v[t][j][2] + v[t][j][3] * v[t][j][3]);
            const float rstd = 1.f / sqrtf(wave_sum(s) * (1.f / 1024.f) + 1e-5f);
#pragma unroll
            for (int j = 0; j < 4; ++j) { const f32x4 g = *(const f32x4*)(fw + 4 * lane + 256 * j); *(GAS f32x4*)(F.out + (size_t)(tok0 + t) * 1024 + 4 * lane + 256 * j) = v[t][j] * rstd * g; } }
    }
}
#ifndef MK_NPH
#define MK_NPH 14
#endif
struct Args { const float* in[29]; float* out; unsigned char* ws; int ph_lo, ph_hi; };
__global__ void __launch_bounds__(NWAVES * 64, 2) mega_fwd(Args args) {
    extern __shared__ __attribute__((aligned(16))) unsigned char lds_raw[];
    Frame F;
    F.lds = (LAS unsigned char*)lds_raw;
    F.tid = threadIdx.x; F.lane = F.tid & 63; F.wave = __builtin_amdgcn_readfirstlane(F.tid >> 6);
    F.G = gridDim.x; { const int bx = blockIdx.x; F.vcu = (F.G % 8 == 0) ? (bx % 8) * (F.G / 8) + bx / 8 : bx; }
    F.ws = args.ws; F.ctl = (gu32*)(args.ws + WS_CTL); F.out = args.out;
    F.in = (const __attribute__((address_space(4))) fptr_t*)__builtin_amdgcn_kernarg_segment_ptr();
    for (int u = F.tid; u < (LDS_BYTES - TAB_OFF) / 4; u += NWAVES * 64) ((LAS unsigned*)(F.lds + TAB_OFF))[u] = 0u;
    __syncthreads();
    const int lo = args.ph_lo, hi = args.ph_hi;
    XcdBarrier bar; bar.bar = (unsigned*)(F.ctl + CW_BAR); bar.x = 0; bar.st = nullptr;
    if (hi - lo > 1) bar = xcd_barrier_post((unsigned*)(F.ctl + CW_BAR), (volatile LAS unsigned*)(F.lds + TAB_MISC) + 8);
#ifndef MK_PHMASK
#define MK_PHMASK 0x3fff
#endif
#define IN(k) (((MK_PHMASK >> (k)) & 1) && lo <= (k) && (k) < hi)
#define SEAM(k) do { if (IN(k) && IN((k) + 1)) xcd_barrier(bar); } while (0)
    const int c = (int)blockIdx.x;

    if (IN(0)) { p0_prologue(F); } SEAM(0);
    if (IN(1)) {
        { constexpr int ES = I8_G1 ? 1 : 2; typedef pg8::EpiP1<I8_G1 != 0> EpiT;
          pg8::SchedLin S{M_TOK / 256, N1 / 256, F.G, c, DM, (const bf16*)(F.ws + WS_W1T), DM, ES};
          EpiT E{(bf16*)(F.ws + WS_P1), P1C, (float*)(F.ws + WS_DT), F.in[I_BGATE], (const float*)(F.ws + WS_USC), (const float*)(F.ws + WS_CSC), (LAS float*)(F.lds + TAB_OFF + 8192)};
          pg8::gemm_phase<EpiT, pg8::SchedLin, true, ES, I8_G1 != 0>(F.lds, (const char*)(F.ws + WS_U), DM, S, E); }
        if (I8_G1) { pg8::SchedLin S{NBATCH * 256 / 256, 2048 / 256, F.G, (c + 128) % F.G, DM, (const bf16*)(F.ws + WS_WCKV), DM, 1};
          pg8::EpiI8 E{(bf16*)(F.ws + WS_KVC), 2048, (const float*)(F.ws + WS_MSC), (const float*)(F.ws + WS_KSC), (LAS float*)(F.lds + TAB_OFF + 8192)};
          pg8::gemm_phase<pg8::EpiI8, pg8::SchedLin, true, 1, true>(F.lds, (const char*)(F.ws + WS_MN), DM, S, E); }
        else { pg8::SchedLin S{NBATCH * 256 / 256, 2048 / 256, F.G, (c + 128) % F.G, DM, (const bf16*)(F.ws + WS_WCKV), DM};
          pg8::EpiBf16S E{(bf16*)(F.ws + WS_KVC), 2048, nullptr, 1.f, (LAS float*)(F.lds + TAB_OFF + 8192)};
          pg8::gemm_phase<pg8::EpiBf16S, pg8::SchedLin, true>(F.lds, (const char*)(F.ws + WS_MN), DM, S, E); }
    } SEAM(1);
    if (IN(2)) { swa_phase(F); ssd_states_phase(F); } SEAM(2);
    if (IN(3)) { ssd_scan_phase(F); } SEAM(3);
    if (IN(4)) { ssd_out_phase(F); } SEAM(4);
    if (IN(5)) {
        constexpr int ES = FP8_G2 ? 1 : 2; typedef pg8::EpiG2<ES, FP8_G3 != 0> EpiT;
        pg8::SchedLin S{M_TOK / 256, 1024 / 256, F.G, c, 3072, (const bf16*)(F.ws + WS_WCAT), 3072, ES};
        EpiT E{(const bf16*)(F.ws + WS_P1) + C_G, P1C, (void*)(F.ws + WS_MERGED), DM, (const float*)(F.ws + WS_SSQG), FP8_G2 ? 1.f / pg8::W8_SCALE : 1.f, (LAS float*)(F.lds + TAB_OFF + 1024)};
        pg8::gemm_phase<EpiT, pg8::SchedLin, false, ES>(F.lds, (const char*)(F.ws + WS_ACAT), 3072, S, E);
    } SEAM(5);
    if (IN(6)) {
        constexpr int ES = FP8_G3 ? 1 : 2;
        pg8::SchedLin S{M_TOK / 256, 4, F.G, c, DM, (const bf16*)(F.ws + WS_WOUT), DM, ES};
        pg8::EpiRes<false> E{(const void*)F.in[I_X], (bf16*)(F.ws + WS_H1), FP8_G4 ? nullptr : (bf16*)(F.ws + WS_HB), F.in[I_NCW], (float*)(F.ws + WS_SSQ1), FP8_G4 ? (unsigned char*)(F.ws + WS_HB) : nullptr, FP8_G3 ? 1.f / pg8::W8_SCALE : 1.f, (LAS float*)(F.lds + TAB_OFF + 8192)};
        pg8::gemm_phase<pg8::EpiRes<false>, pg8::SchedLin, false, ES>(F.lds, (const char*)(F.ws + WS_MERGED), DM, S, E);
    } SEAM(6);
    if (IN(7)) {
        constexpr int ES = FP8_G4 ? 1 : 2;
        pg8::SchedLin S{M_TOK / 256, 4, F.G, c, DM, (const bf16*)(F.ws + WS_WCQ), DM, ES};
        pg8::EpiBf16S E{(bf16*)(F.ws + WS_QC), DM, (const float*)(F.ws + WS_SSQ1), FP8_G4 ? 1.f / pg8::W8_SCALE : 1.f, (LAS float*)(F.lds + TAB_OFF + 8192)};
        pg8::gemm_phase<pg8::EpiBf16S, pg8::SchedLin, false, ES>(F.lds, (const char*)(F.ws + WS_HB), DM, S, E);
        VM_WAIT(); __syncthreads();
        for (int i = 0;; ++i) { int pm, pn; if (!pg8::static_deal(i, F.G, c, M_TOK / 256, 4, pm, pn)) break;
            const int ua = (pm >> 3) * 64 + pn * 16 + 2 * (pm & 7); cross_units(F, ua, ua + 2, 1); }
    } SEAM(7);
    if (IN(9)) {
        constexpr int ES = FP8_G6 ? 1 : 2;
        pg8::SchedLin S{M_TOK / 256, 4, F.G, c, DM, (const bf16*)(F.ws + WS_WCO), DM, ES};
        pg8::EpiRes<true> E{(const void*)(F.ws + WS_H1), (bf16*)(F.ws + WS_H2), (bf16*)(F.ws + WS_T), F.in[I_NFW], (float*)(F.ws + WS_SSQ2), (unsigned char*)(F.ws + WS_T8), FP8_G6 ? 1.f / pg8::W8_SCALE : 1.f, (LAS float*)(F.lds + TAB_OFF + 8192)};
        pg8::gemm_phase<pg8::EpiRes<true>, pg8::SchedLin, false, ES>(F.lds, (const char*)(F.ws + WS_OC), DM, S, E);
    } SEAM(9);
    if (IN(10)) { router_phase(F); } SEAM(10);
    if (IN(11)) {
        const int nt = moe_tables(F);
        pg8::SchedMoe S{nt, 8, F.G, c, DM, (const void*)(F.ws + WS_WGU), DM, (size_t)2048 * 1024, true, 1,
                        (const LAS int*)(F.lds + TAB_TE), (const LAS int*)(F.lds + TAB_TP0), (const LAS int*)(F.lds + TAB_CNT), (const int*)(F.ws + WS_ROWMAP)};
        pg8::EpiGU E{(unsigned char*)(F.ws + WS_ACT), F.in[I_BGU], (const int*)(F.ws + WS_ROWMAP), (const LAS int*)(F.lds + TAB_CNT), (LAS float*)(F.lds + TAB_OFF + 8192)};
        pg8::gemm_phase<pg8::EpiGU, pg8::SchedMoe, true, 1>(F.lds, (const char*)(F.ws + WS_T8), DM, S, E);
    } SEAM(11);
    if (IN(12)) {
        const int nt = moe_tables(F);
        pg8::SchedMoe S{nt, 4, F.G, c, DM, (const void*)(F.ws + WS_WDN), DM, (size_t)1024 * 1024, false, 1,
                        (const LAS int*)(F.lds + TAB_TE), (const LAS int*)(F.lds + TAB_TP0), (const LAS int*)(F.lds + TAB_CNT), (const int*)(F.ws + WS_ROWMAP)};
        pg8::EpiDN E{(unsigned char*)(F.ws + WS_Y), F.in[I_BDN], (LAS float*)(F.lds + TAB_OFF + 8192)};
        pg8::gemm_phase<pg8::EpiDN, pg8::SchedMoe, true, 1>(F.lds, (const char*)(F.ws + WS_ACT), DM, S, E);
    } SEAM(12);
    if (IN(13)) { (void)moe_tables(F); combine_phase(F); }
#undef IN
#undef SEAM
}

static int mega_grid() {
    static int grid = 0;
    if (grid == 0) {
        int dev = 0, cus = 0;
        if (hipGetDevice(&dev) != hipSuccess || hipDeviceGetAttribute(&cus, hipDeviceAttributeMultiprocessorCount, dev) != hipSuccess) { grid = -1; return grid; }
        if (hipFuncSetAttribute((const void*)mega_fwd, hipFuncAttributeMaxDynamicSharedMemorySize, LDS_BYTES) != hipSuccess) { fprintf(stderr, "hipFuncSetAttribute failed\n"); grid = -1; return grid; }
        int per_cu = 0;
        if (hipOccupancyMaxActiveBlocksPerMultiprocessor(&per_cu, (const void*)mega_fwd, NWAVES * 64, LDS_BYTES) != hipSuccess || per_cu < 1) { fprintf(stderr, "occupancy query: %d\n", per_cu); (void)hipGetLastError(); grid = -1; return grid; }
        grid = cus;
    }
    return grid;
}
static void mega_launch(hipStream_t stream, void* const* d_in, void* d_out, void* d_ws, int lo, int hi) {
    const int grid = mega_grid(); if (grid <= 0) return;
    Args a{}; for (int i = 0; i < 29; ++i) a.in[i] = (const float*)d_in[i];
    a.out = (float*)d_out; a.ws = (unsigned char*)d_ws; a.ph_lo = lo; a.ph_hi = hi;
    hipLaunchKernelGGL(mega_fwd, dim3(grid), dim3(NWAVES * 64), LDS_BYTES, stream, a);
}
#ifndef HYB
#define HYB 6
#endif
#ifndef MK_ONE_LAUNCH
#define MK_ONE_LAUNCH 0
#endif
extern "C" void kernel_launch(void* const* d_in, const int* in_sizes, int n_in, void* d_out, int out_size, void* d_ws, size_t ws_size, hipStream_t stream) {
    if (n_in != 29 || ws_size < ((size_t)1000 << 20) || out_size != M_TOK * DM) { fprintf(stderr, "kernel_launch: unexpected n_in %d / ws %zu / out %d\n", n_in, ws_size, out_size); return; }
    if (hipMemsetAsync((char*)d_ws + WS_CTL, 0, CTL_ZERO_BYTES, stream) != hipSuccess) return;
    constexpr int nph = HYB == 1 ? 2 : HYB == 2 ? 5 : HYB == 3 ? 6 : HYB == 4 ? 7 : HYB == 5 ? 10 : 14;
#if MK_ONE_LAUNCH
    mega_launch(stream, d_in, d_out, d_ws, 0, nph);
#else
    for (int p = 0; p < nph; ++p) { if (p == 8) continue;
        mega_launch(stream, d_in, d_out, d_ws, p, p + 1);
#ifdef MK_REPEAT
        if (p == MK_REPEAT) { if (p == 10) (void)hipMemsetAsync((char*)d_ws + WS_CTL + CW_CNT * 4, 0, 32 * 64 * 4, stream); mega_launch(stream, d_in, d_out, d_ws, p, p + 1); }
#endif
    }
#endif
#if HYB < 6
    nv::In in; const float** ip = (const float**)&in; for (int i = 0; i < 29; ++i) ip[i] = (const float*)d_in[i];
    unsigned char* ws = (unsigned char*)d_ws; float* nb = (float*)(ws + WS_NAIVE);
    for (int b = 0; b < 8; ++b) {
        const size_t r0 = (size_t)b * 2048;
        auto cvt = [&](const unsigned short* src, int sp, float* dst, int dp, int cols) { hipLaunchKernelGGL(nv::k_bf16_to_f32, dim3((2048 * cols + 255) / 256), dim3(256), 0, stream, src, sp, dst, dp, 2048, cols); };
        auto cpy = [&](const float* src, int sp, float* dst, int dp, int cols) { hipLaunchKernelGGL(nv::k_copy_f32, dim3((2048 * cols + 255) / 256), dim3(256), 0, stream, src, sp, dst, dp, 2048, cols); };
        const unsigned short* P1 = (const unsigned short*)(ws + WS_P1) + r0 * P1C;
#if HYB == 1
        cvt(P1, P1C, nb + nv::B_PROJ, 6432, 6400); cpy((const float*)(ws + WS_DT) + r0 * 32, 32, nb + nv::B_PROJ + 6400, 6432, 32); cvt(P1 + C_G, P1C, nb + nv::B_GATES, 2048, 2048);
#elif HYB == 2
        cvt((const unsigned short*)(ws + WS_ACAT) + r0 * 3072, 3072, nb + nv::B_U, 1024, 1024); hipLaunchKernelGGL(nv::k_ssm_unnorm_to_f32, dim3(2048 * 2048 / 256), dim3(256), 0, stream, (const unsigned short*)(ws + WS_ACAT) + r0 * 3072, (const float*)(ws + WS_SSQG) + r0 * 4, nb + nv::B_Y, 2048); cvt(P1 + C_G, P1C, nb + nv::B_GATES, 2048, 2048);
#elif HYB == 3
        cvt((const unsigned short*)(ws + WS_MERGED) + r0 * 1024, 1024, nb + nv::B_T1, 1024, 1024);
#elif HYB == 4
        cvt((const unsigned short*)(ws + WS_H1) + r0 * 1024, 1024, nb + nv::B_H1, 1024, 1024);
#elif HYB == 5
        cvt((const unsigned short*)(ws + WS_H2) + r0 * 1024, 1024, nb + nv::B_H2, 1024, 1024);
#endif
        nv::forward_batch(stream, in, nb, b, (float*)d_out, HYB);
    }
#endif
}
```

```cpp
#define HYB 6
#define MK_ONE_LAUNCH 1
#include <hip/hip_runtime.h>
#include <cstdio>
#include <cstdint>
#define GAS __attribute__((address_space(1)))
#define LAS __attribute__((address_space(3)))
typedef unsigned short bf16;
typedef unsigned v4u __attribute__((ext_vector_type(4)));
typedef unsigned v2u __attribute__((ext_vector_type(2)));
typedef float f32x4 __attribute__((ext_vector_type(4)));
typedef float f32x2 __attribute__((ext_vector_type(2)));
typedef short bf16x8 __attribute__((ext_vector_type(8)));
typedef short s16x4 __attribute__((ext_vector_type(4)));
typedef GAS unsigned gu32;
#define RLX_AGENT __ATOMIC_RELAXED, __HIP_MEMORY_SCOPE_AGENT
#define LDS_WAIT() asm volatile("s_waitcnt lgkmcnt(0)" ::: "memory")
#define VM_WAIT() asm volatile("s_waitcnt vmcnt(0)" ::: "memory")
__device__ __forceinline__ unsigned f2bf(float f) { unsigned u = __builtin_bit_cast(unsigned, f); return (u + 0x7fffu + ((u >> 16) & 1u)) >> 16; }
__device__ __forceinline__ unsigned pk2(float lo, float hi) { return f2bf(lo) | (f2bf(hi) << 16); }
__device__ __forceinline__ float bf2f(unsigned short b) { return __uint_as_float((unsigned)b << 16); }
__device__ __forceinline__ float bflo(unsigned w) { return __uint_as_float(w << 16); }
__device__ __forceinline__ float bfhi(unsigned w) { return __uint_as_float(w & 0xffff0000u); }
typedef __bf16 bf16x2_t __attribute__((ext_vector_type(2)));
__device__ __forceinline__ unsigned cvt_pk_bf16(float lo, float hi) { const f32x2 v = {lo, hi}; const bf16x2_t b = __builtin_convertvector(v, bf16x2_t); return __builtin_bit_cast(unsigned, b); }
__device__ __forceinline__ float wave_sum(float v) {
#pragma unroll
    for (int o = 1; o < 64; o <<= 1) v += __shfl_xor(v, o);
    return v;
}
#define XB_TMO      128
#define XB_XCNT(j)  (256  + 64 * (j))
#define XB_XSUB(j)  (1280 + 64 * (j))
#define XB_XGEN(j)  (2304 + 64 * (j))
#define XB_TOP      3328
#define XB_TOPGEN   3392
#define XCD_BAR_WORDS 3456
#define XB_SPIN_CAP (1u << 18)

__device__ __forceinline__ unsigned xb_ld(unsigned* p)              { return __hip_atomic_load(p, __ATOMIC_RELAXED, __HIP_MEMORY_SCOPE_AGENT); }
__device__ __forceinline__ unsigned xb_add(unsigned* p, unsigned v) { return __hip_atomic_fetch_add(p, v, __ATOMIC_RELAXED, __HIP_MEMORY_SCOPE_AGENT); }
__device__ __forceinline__ unsigned xb_xcc_id() { return (unsigned)__builtin_amdgcn_s_getreg((3 << 11) | 20) & 0xFu; }
#define XB_SPIN(cond, bar) do { unsigned _sp = 0; while (cond) { __builtin_amdgcn_s_sleep(1); \
    if ((++_sp & 255u) == 0u) { if (xb_ld(&(bar)[XB_TMO])) break; if (_sp > XB_SPIN_CAP) { atomicAdd(&(bar)[XB_TMO], 1u); break; } } } } while (0)

struct XcdBarrier {
    unsigned* bar; unsigned x;
    volatile LAS unsigned* st;
};

__device__ __forceinline__ XcdBarrier xcd_barrier_post(unsigned* bar, volatile LAS unsigned* st) {
    XcdBarrier b; b.bar = bar; b.x = xb_xcc_id(); b.st = st;
    if (threadIdx.x == 0) (void)xb_add(&bar[XB_XCNT(b.x)], 1u);
    return b;
}
__device__ __forceinline__ void xcd_barrier_complete(unsigned* bar, unsigned x, unsigned& nloc, unsigned& nx) {
    const unsigned G = gridDim.x * gridDim.y * gridDim.z;
    unsigned sum, cnt, mine, sp = 0u;
    for (;;) {
        sum = 0u; cnt = 0u; mine = 0u;
#pragma unroll
        for (unsigned j = 0; j < 16; ++j) { const unsigned c = xb_ld(&bar[XB_XCNT(j)]); sum += c; cnt += (c > 0u) ? 1u : 0u; mine = (j == x) ? c : mine; }
        if (sum == G) break;
        __builtin_amdgcn_s_sleep(1);
        if ((++sp & 255u) == 0u) { if (xb_ld(&bar[XB_TMO])) break; if (sp > XB_SPIN_CAP) { atomicAdd(&bar[XB_TMO], 1u); break; } }
    }
    nloc = mine > 0u ? mine : 1u; nx = cnt > 0u ? cnt : 1u;
}

__device__ __forceinline__ void xcd_barrier(const XcdBarrier& b, bool local = false) {
    asm volatile("s_waitcnt vmcnt(0)" ::: "memory");
    __syncthreads();
    if (threadIdx.x == 0) {
        unsigned* bar = b.bar;
        __builtin_amdgcn_s_waitcnt(0);
        unsigned nloc = b.st[0], nx = b.st[1];
        if (nloc == 0u) { xcd_barrier_complete(bar, b.x, nloc, nx); b.st[0] = nloc; b.st[1] = nx; }
        const unsigned old = xb_add(&bar[XB_XSUB(b.x)], 1u);
        const unsigned gen = old / nloc;
        if (old + 1u == (gen + 1u) * nloc) {
          if (!local) {
            __builtin_amdgcn_fence(__ATOMIC_RELEASE, "agent");
            asm volatile("s_waitcnt vmcnt(0)" ::: "memory");
            const unsigned og = xb_add(&bar[XB_TOP], 1u);
            const unsigned tg = og / nx;
            if (og + 1u == (tg + 1u) * nx) xb_add(&bar[XB_TOPGEN], 1u);
            else XB_SPIN(xb_ld(&bar[XB_TOPGEN]) == tg, bar);
          }
            __builtin_amdgcn_fence(__ATOMIC_ACQUIRE, "agent");
            xb_add(&bar[XB_XGEN(b.x)], 1u);
            asm volatile("s_waitcnt vmcnt(0)" ::: "memory");
        } else {
            XB_SPIN(xb_ld(&bar[XB_XGEN(b.x)]) == gen, bar);
            __builtin_amdgcn_fence(__ATOMIC_ACQUIRE, "agent");
            asm volatile("s_waitcnt vmcnt(0)" ::: "memory");
        }
    }
    __syncthreads();
}

__device__ __forceinline__ void panel_barrier(unsigned* pb, unsigned* tmo, int arrive, int wait, unsigned need) {
    asm volatile("s_waitcnt vmcnt(0)" ::: "memory");
    __syncthreads();
    if (threadIdx.x == 0) {
        (void)xb_add(pb + 16 * arrive, 1u);
        unsigned sp = 0;
        while (xb_ld(pb + 16 * wait) < need) { __builtin_amdgcn_s_sleep(1); if ((++sp & 255u) == 0u) { if (xb_ld(tmo)) break; if (sp > XB_SPIN_CAP) { atomicAdd(tmo, 1u); break; } } }
        __builtin_amdgcn_fence(__ATOMIC_ACQUIRE, "agent");
        asm volatile("s_waitcnt vmcnt(0)" ::: "memory");
    }
    __syncthreads();
}
namespace pg8 {
constexpr int BM = 256, BK = 64, HALF = 128, HTB = HALF * BK * 2  , STAGE_BYTES = 8 * HTB, NXCD = 8, WGM = 8;
__host__ __device__ __forceinline__ int lds_byte(int r, int c) { const int st = (r >> 4) * 2 + (c >> 5), rr = r & 15, cc = c & 31, ob = rr * 64 + cc * 2; return st * 1024 + (ob ^ (((ob >> 9) & 1) << 5)); }
__host__ __device__ __forceinline__ void stage_rc(int b, int& R, int& C) { const int st = b / 1024, sb = b % 1024, swz = sb ^ (((sb >> 9) & 1) << 5); R = (st >> 1) * 16 + swz / 64; C = (st & 1) * 32 + (swz % 64) / 2; }
__host__ __device__ __forceinline__ int perm32(int rho) { const int n = rho >> 4, i = rho & 15; return 8 * (i >> 2) + 4 * n + (i & 3); }

struct Unit { int pm, pn, e, p0; };
__device__ __forceinline__ void dma_dword(unsigned lds_wave, const void* g) {
    asm volatile("s_mov_b32 m0, %0\n\ts_nop 0\n\tglobal_load_lds_dword %1, off" :: "s"(__builtin_amdgcn_readfirstlane(lds_wave)), "v"(g) : "memory"); }
typedef int v8i __attribute__((ext_vector_type(8))); typedef int v4i __attribute__((ext_vector_type(4)));
__device__ __forceinline__ v8i cat_frag(bf16x8 a, bf16x8 b) { const v4i x = __builtin_bit_cast(v4i, a), y = __builtin_bit_cast(v4i, b); return (v8i){x[0], x[1], x[2], x[3], y[0], y[1], y[2], y[3]}; }
__device__ __forceinline__ unsigned pk4_fp8(float a, float b, float c, float d) {
    a = __builtin_amdgcn_fmed3f(a, -448.f, 448.f); b = __builtin_amdgcn_fmed3f(b, -448.f, 448.f); c = __builtin_amdgcn_fmed3f(c, -448.f, 448.f); d = __builtin_amdgcn_fmed3f(d, -448.f, 448.f);
    int w = 0; w = __builtin_amdgcn_cvt_pk_fp8_f32(a, b, w, false); w = __builtin_amdgcn_cvt_pk_fp8_f32(c, d, w, true); return (unsigned)w; }
constexpr float W8_SCALE = 32.f;

__device__ __forceinline__ bool static_deal(int i, int G, int c, int nM, int nN, int& pm, int& pn) {
    const int nwg = nM * nN; const long L = (long)i * G + c; if (L >= nwg) return false;
    int wgid = (int)L; { const int q = nwg / NXCD, r = nwg % NXCD, xcd = wgid % NXCD, off = wgid / NXCD; wgid = (xcd < r ? xcd * (q + 1) : r * (q + 1) + (xcd - r) * q) + off; }
    const int nig = WGM * nN, gid = wgid / nig, fm = gid * WGM, gsz = (nM - fm) < WGM ? (nM - fm) : WGM;
    pm = fm + ((wgid % nig) % gsz); pn = (wgid % nig) / gsz; return true;
}
struct SchedLin {
    int nM, nN, G, c, lda; const bf16* Bt; int K; int es = 2; int align8 = 0; int i_lo = 0, i_hi = 1 << 30;
    __device__ __forceinline__ bool next(int i, Unit& u) const { u.e = 0; u.p0 = 0;
        if (align8) { const int j = c / 8 - 16; if (i > 0 || j < 0 || j >= 8) return false; u.pm = c % 8; u.pn = j; return true; }
        return i + i_lo < i_hi && static_deal(i + i_lo, G, c, nM, nN, u.pm, u.pn); }
    __device__ __forceinline__ void a_fetch(const Unit& u, int (&raw)[2][2], unsigned& dv) const {
        int R[2], C[2]; stage_rc((int)threadIdx.x * 16, R[0], C[0]); stage_rc((int)threadIdx.x * 16 + 8192, R[1], C[1]); dv = 0u;
#pragma unroll
        for (int h = 0; h < 2; ++h)
#pragma unroll
            for (int i = 0; i < 2; ++i) raw[h][i] = u.pm * BM + h * HALF + R[i];
    }
    __device__ __forceinline__ void a_finish(const Unit& u, const int (&raw)[2][2], unsigned (&o)[2][2], unsigned dv) const {
        int R[2], C[2]; stage_rc((int)threadIdx.x * 16, R[0], C[0]); stage_rc((int)threadIdx.x * 16 + 8192, R[1], C[1]);
#pragma unroll
        for (int h = 0; h < 2; ++h)
#pragma unroll
            for (int i = 0; i < 2; ++i) o[h][i] = (unsigned)(raw[h][i] * lda * es + C[i] * 2);
    }
    __device__ __forceinline__ int b_off(const Unit& u) const { return u.pn * BM * K * es; }
    __device__ __forceinline__ const void* bt() const { return Bt; }
};
struct SchedMoe {
    int nM, nN, G, c, lda; const void* Bt; int K; size_t bstride; bool gather; int es;
    const LAS int* tile_e; const LAS int* tile_p0; const LAS int* cnt_s; const int* rowmap;
    const unsigned* dep; unsigned dep_n;
    __device__ __forceinline__ bool next(int i, Unit& u) const { if (!static_deal(i, G, c, nM, nN, u.pm, u.pn)) return false; u.e = tile_e[u.pm]; u.p0 = tile_p0[u.pm]; return true; }
    __device__ __forceinline__ void a_fetch(const Unit& u, int (&raw)[2][2], unsigned& dv) const {
        int R[2], C[2]; stage_rc((int)threadIdx.x * 16, R[0], C[0]); stage_rc((int)threadIdx.x * 16 + 8192, R[1], C[1]);
        dv = dep ? __hip_atomic_load(dep + 16 * u.pm, __ATOMIC_RELAXED, __HIP_MEMORY_SCOPE_AGENT) : 0u;
        const int ce = cnt_s[u.e];
#pragma unroll
        for (int h = 0; h < 2; ++h)
#pragma unroll
            for (int i = 0; i < 2; ++i) {
                if (gather) { const int pos = u.p0 + h * HALF + R[i]; raw[h][i] = pos < ce ? rowmap[2 * (u.e * 16384 + pos)] : 0; }
                else raw[h][i] = u.pm * BM + h * HALF + R[i]; }
    }
    __device__ __forceinline__ void a_finish(const Unit& u, const int (&raw)[2][2], unsigned (&o)[2][2], unsigned dv) const {
        int R[2], C[2]; stage_rc((int)threadIdx.x * 16, R[0], C[0]); stage_rc((int)threadIdx.x * 16 + 8192, R[1], C[1]);
        if (dep) { if (__builtin_amdgcn_readfirstlane(dv) < dep_n) {
            for (unsigned spins = 0; spins < (1u << 22); ++spins) { __builtin_amdgcn_s_sleep(4); if (__builtin_amdgcn_readfirstlane(__hip_atomic_load(dep + 16 * u.pm, __ATOMIC_RELAXED, __HIP_MEMORY_SCOPE_AGENT)) >= dep_n) break; } } }
#pragma unroll
        for (int h = 0; h < 2; ++h)
#pragma unroll
            for (int i = 0; i < 2; ++i) o[h][i] = (unsigned)(raw[h][i] * lda * es + C[i] * 2);
    }
    __device__ __forceinline__ int b_off(const Unit& u) const { return u.e * (int)bstride + u.pn * BM * K * es; }
    __device__ __forceinline__ const void* bt() const { return Bt; }
};

template <class Epi, class Sched, bool ALIGN_EPI, int ES = 2, bool I8 = false>
__device__ __forceinline__ void gemm_phase(LAS unsigned char* lds, const char* Abase, const int K, const Sched& S, const Epi& E) {
    const int tid = threadIdx.x, wid = __builtin_amdgcn_readfirstlane(tid >> 6), lane = tid & 63, wr = wid >> 2, wc = wid & 3, fr = lane & 15, fq = lane >> 4;
    const int nt = K * ES / (BK * 2);
    unsigned voffB[2];
#pragma unroll
    for (int i = 0; i < 2; ++i) { int R, C; stage_rc(tid * 16 + i * 8192, R, C); const int Rb = Epi::PERM ? ((R & ~31) + perm32(R & 31)) : R; voffB[i] = (unsigned)(Rb * K * ES + C * 2); }
    const int kstep = BK * 2;
    const int hstep = HALF * K * ES;
    const unsigned ldsw = (unsigned)wid * 1024u;
    const int aoff = lds_byte(wr * 64 + fr, fq * 8), boff = lds_byte(wc * 32 + fr, fq * 8);
    v4i rsA, rsB;
    { const unsigned long long pa = (unsigned long long)(const void*)Abase, pb = (unsigned long long)S.bt();
      rsA[0] = __builtin_amdgcn_readfirstlane((int)(unsigned)pa); rsA[1] = __builtin_amdgcn_readfirstlane((int)((pa >> 32) & 0xffffu)); rsA[2] = 0x7ffff000; rsA[3] = 0x00020000;
      rsB[0] = __builtin_amdgcn_readfirstlane((int)(unsigned)pb); rsB[1] = __builtin_amdgcn_readfirstlane((int)((pb >> 32) & 0xffffu)); rsB[2] = 0x7ffff000; rsB[3] = 0x00020000; }
    const unsigned ldsd = __builtin_amdgcn_readfirstlane((unsigned)(size_t)lds + ldsw);
#define PG8_SA(b, h) (((b) * 2 + (h)) * HTB)
#define PG8_SB(b, h) ((4 + (b) * 2 + (h)) * HTB)
#define PG8_DMA(rs, dst, voff, soff) asm volatile("s_mov_b32 m0, %0\n\ts_nop 0\n\tbuffer_load_dwordx4 %1, %2, %3 offen lds" :: "s"(dst), "v"(voff), "s"(rs), "s"(__builtin_amdgcn_readfirstlane(soff)) : "memory")
#define PG8_STAGE_A(bufoff, soff, voff) do { _Pragma("unroll") for (int _i = 0; _i < 2; ++_i) PG8_DMA(rsA, ldsd + (unsigned)((bufoff) + _i * 8192), (voff)[_i], (soff)); } while (0)
#define PG8_STAGE_B(bufoff, soff) do { _Pragma("unroll") for (int _i = 0; _i < 2; ++_i) PG8_DMA(rsB, ldsd + (unsigned)((bufoff) + _i * 8192), voffB[_i], (soff)); } while (0)
#define PG8_LDA(dst, b, h) do { _Pragma("unroll") for (int m = 0; m < 4; ++m) _Pragma("unroll") for (int k = 0; k < 2; ++k) dst[m][k] = *(const LAS bf16x8*)(lds + PG8_SA(b, h) + aoff + m * 2048 + k * 1024); } while (0)
#define PG8_LDB(dst, b, h) do { _Pragma("unroll") for (int n = 0; n < 2; ++n) _Pragma("unroll") for (int k = 0; k < 2; ++k) dst[n][k] = *(const LAS bf16x8*)(lds + PG8_SB(b, h) + boff + n * 2048 + k * 1024); } while (0)
#define PG8_MMA(ai, bj, At, Bt) do { __builtin_amdgcn_s_setprio(1); _Pragma("unroll") for (int m = 0; m < 4; ++m) _Pragma("unroll") for (int n = 0; n < 2; ++n) { \
        if constexpr (I8) { _Pragma("unroll") for (int k = 0; k < 2; ++k) acc[ai][bj][m][n] = __builtin_bit_cast(f32x4, __builtin_amdgcn_mfma_i32_16x16x64_i8(__builtin_bit_cast(v4i, Bt[n][k]), __builtin_bit_cast(v4i, At[m][k]), __builtin_bit_cast(v4i, acc[ai][bj][m][n]), 0, 0, 0)); } \
        else if constexpr (ES == 2) { _Pragma("unroll") for (int k = 0; k < 2; ++k) acc[ai][bj][m][n] = __builtin_amdgcn_mfma_f32_16x16x32_bf16(Bt[n][k], At[m][k], acc[ai][bj][m][n], 0, 0, 0); } \
        else acc[ai][bj][m][n] = __builtin_amdgcn_mfma_scale_f32_16x16x128_f8f6f4(cat_frag(Bt[n][0], Bt[n][1]), cat_frag(At[m][0], At[m][1]), acc[ai][bj][m][n], 0, 0, 0, 0x7f7f7f7f, 0, 0x7f7f7f7f); } \
        __builtin_amdgcn_s_setprio(0); } while (0)
#define PG8_WAIT_V(n) asm volatile("s_waitcnt vmcnt(" #n ")" ::: "memory")
#define PG8_WAIT_VR() do { if constexpr (Epi::NST == 0) PG8_WAIT_V(8); \
        else if constexpr (Epi::NST == 16) asm volatile("s_waitcnt vmcnt(24)\n\ts_cmp_lg_u32 %0, 0\n\ts_cbranch_scc1 .Lpg8w%=\n\ts_waitcnt vmcnt(8)\n.Lpg8w%=:" :: "s"(__builtin_amdgcn_readfirstlane(rel)) : "memory", "scc"); \
        else asm volatile("s_waitcnt vmcnt(16)\n\ts_cmp_lg_u32 %0, 0\n\ts_cbranch_scc1 .Lpg8w%=\n\ts_waitcnt vmcnt(8)\n.Lpg8w%=:" :: "s"(__builtin_amdgcn_readfirstlane(rel)) : "memory", "scc"); } while (0)
#define PG8_WAIT_L(n) asm volatile("s_waitcnt lgkmcnt(" #n ")" ::: "memory")
#define PG8_BAR __builtin_amdgcn_s_barrier()
#define PG8_SCHED __builtin_amdgcn_sched_barrier(0)
    Unit cur, nxt; int ui = 0; bool relu = false; int pubp = -1;
    if (!S.next(0, cur)) return;
    f32x4 acc[2][2][4][2];
#pragma unroll
    for (int a = 0; a < 2; ++a)
#pragma unroll
        for (int b = 0; b < 2; ++b)
#pragma unroll
            for (int m = 0; m < 4; ++m)
#pragma unroll
                for (int n = 0; n < 2; ++n) acc[a][b][m][n] = (f32x4){0.f, 0.f, 0.f, 0.f};
    bf16x8 At[4][2], B0[2][2], B1[2][2];
    unsigned cao[2][2], nao[2][2];
    { int raw[2][2]; unsigned dv; S.a_fetch(cur, raw, dv); S.a_finish(cur, raw, cao, dv); }
    int cB = S.b_off(cur);
    bool has_next = S.next(1, nxt); int nB = cB;
    if (has_next) { int raw[2][2]; unsigned dv; S.a_fetch(nxt, raw, dv); S.a_finish(nxt, raw, nao, dv); nB = S.b_off(nxt); }
    else {
#pragma unroll
        for (int h = 0; h < 2; ++h)
#pragma unroll
            for (int i = 0; i < 2; ++i) nao[h][i] = cao[h][i]; }
    float pa0 = 0.f, pb0 = 0.f; f32x4 ub0 = (f32x4){0.f, 0.f, 0.f, 0.f};
    if constexpr (Epi::PRE == 2) E.pre_dma(cur, tid, 0); else if constexpr (Epi::PRE == 1) E.pre_fetch(cur, tid, pa0, pb0);
    if constexpr (Epi::NSEG > 1) ub0 = E.unit_fetch(cur, tid);
    PG8_STAGE_B(PG8_SB(0, 0), cB); PG8_STAGE_B(PG8_SB(0, 1), cB + hstep); PG8_STAGE_A(PG8_SA(0, 0), 0, cao[0]); PG8_STAGE_A(PG8_SA(0, 1), 0, cao[1]);
    if (wr == 1) PG8_BAR;
    PG8_WAIT_V(2); PG8_BAR;
    PG8_STAGE_B(PG8_SB(1, 0), cB + kstep); PG8_STAGE_A(PG8_SA(1, 0), kstep, cao[0]); PG8_STAGE_B(PG8_SB(1, 1), cB + hstep + kstep); PG8_STAGE_A(PG8_SA(1, 1), kstep, cao[1]);
    PG8_WAIT_V(8); PG8_BAR;
    if constexpr (Epi::PRE == 1) E.pre_store(tid, pa0, pb0, 0);
    if constexpr (Epi::NSEG > 1) E.unit_store(tid, ub0);
    for (;;) {
        int t = 0;
#pragma unroll 1
        for (int seg = 0; seg < Epi::NSEG; ++seg) {
        const int t_end = (Epi::NSEG == 1) ? nt : Epi::MID_T + Epi::SEG_STEP * seg;
#pragma unroll 1
        for (; t < t_end; t += 2) {
            const bool last = (t == nt - 2);
            const int a1 = (t + 1) * kstep;
            const int a2 = last ? 0 : (t + 2) * kstep; const int b2 = last ? nB : cB + (t + 2) * kstep;
            const int a3 = a2 + kstep; const int b3 = b2 + kstep;
            PG8_LDB(B0, 0, 0); PG8_LDB(B1, 0, 1); PG8_SCHED; PG8_LDA(At, 0, 0); if (t != 0) PG8_STAGE_A(PG8_SA(1, 1), a1, cao[1]);
            int rel = 0; if constexpr (Epi::NST != 0) rel = __builtin_amdgcn_readfirstlane((relu && t == 0) ? 1 : 0);
            if (last) {
#pragma unroll
                for (int h = 0; h < 2; ++h)
#pragma unroll
                    for (int i = 0; i < 2; ++i) cao[h][i] = nao[h][i];
                if constexpr (Epi::PUB) { if (pubp >= 0 && tid == 0) E.publish(pubp); }
            }
            PG8_WAIT_VR(); PG8_WAIT_L(0); PG8_BAR; PG8_MMA(0, 0, At, B0); PG8_MMA(0, 1, At, B1); PG8_BAR; PG8_SCHED;
            PG8_LDA(At, 0, 1); PG8_STAGE_B(PG8_SB(0, 0), b2); PG8_STAGE_B(PG8_SB(0, 1), b2 + hstep); PG8_STAGE_A(PG8_SA(0, 0), a2, cao[0]);
            PG8_WAIT_VR(); PG8_WAIT_L(0); PG8_BAR; PG8_MMA(1, 0, At, B0); PG8_MMA(1, 1, At, B1); PG8_BAR; PG8_SCHED;
            PG8_LDB(B0, 1, 0); PG8_LDB(B1, 1, 1); PG8_SCHED; PG8_LDA(At, 1, 0); PG8_STAGE_A(PG8_SA(0, 1), a2, cao[1]);
            PG8_WAIT_VR(); PG8_WAIT_L(0); PG8_BAR; PG8_MMA(0, 0, At, B0); PG8_MMA(0, 1, At, B1); PG8_BAR; PG8_SCHED;
            PG8_LDA(At, 1, 1); PG8_STAGE_B(PG8_SB(1, 0), b3); PG8_STAGE_B(PG8_SB(1, 1), b3 + hstep); PG8_STAGE_A(PG8_SA(1, 0), a3, cao[0]);
            PG8_WAIT_V(8); PG8_WAIT_L(0); PG8_BAR; PG8_MMA(1, 0, At, B0); PG8_MMA(1, 1, At, B1); PG8_BAR; PG8_SCHED;
        }
        if constexpr (Epi::NSEG > 1) { E.mid(acc, cur, seg, wr, wc, fr, fq); }
        }
        PG8_STAGE_A(PG8_SA(1, 1), kstep, cao[1]);
        if constexpr (ALIGN_EPI) { if (wr == 0) PG8_BAR; }
        Unit nn; const bool hnn = has_next && S.next(ui + 2, nn); int nraw[2][2]; unsigned ndv = 0u;
        if (hnn) S.a_fetch(nn, nraw, ndv);
        float pa = 0.f, pb = 0.f;
        if constexpr (Epi::PRE == 2) { if (has_next) E.pre_dma(nxt, tid, (ui + 1) & 1); E(acc, cur, wr, wc, fr, fq, ui & 1); }
        else if constexpr (Epi::PRE == 1) { if (has_next) E.pre_fetch(nxt, tid, pa, pb); E(acc, cur, wr, wc, fr, fq, ui & 1); if (has_next) E.pre_store(tid, pa, pb, (ui + 1) & 1); }
        else E(acc, cur, wr, wc, fr, fq);
        if (!has_next) break;
#pragma unroll
        for (int a = 0; a < 2; ++a)
#pragma unroll
            for (int b = 0; b < 2; ++b)
#pragma unroll
                for (int m = 0; m < 4; ++m)
#pragma unroll
                    for (int n = 0; n < 2; ++n) acc[a][b][m][n] = (f32x4){0.f, 0.f, 0.f, 0.f};
        relu = E.full_stores(cur, wc); pubp = cur.pm; cur = nxt; cB = nB; ++ui;
        has_next = hnn;
        if (hnn) { S.a_finish(nn, nraw, nao, ndv); nB = S.b_off(nn); nxt = nn; }
        else {
#pragma unroll
            for (int h = 0; h < 2; ++h)
#pragma unroll
                for (int i = 0; i < 2; ++i) nao[h][i] = cao[h][i]; }
        if constexpr (Epi::NSEG > 1) { PG8_BAR; E.unit_store(tid, E.unit_fetch(cur, tid)); }
        if constexpr (ALIGN_EPI) { if (wr == 1) PG8_BAR; }
    }
    PG8_WAIT_V(0);
    if constexpr (!ALIGN_EPI) { if (wr == 0) PG8_BAR; }
    PG8_BAR;
    if constexpr (Epi::PUB) { if (tid == 0) E.publish(cur.pm); }
#undef PG8_SA
#undef PG8_SB
#undef PG8_STAGE_A
#undef PG8_STAGE_B
#undef PG8_DMA
#undef PG8_LDA
#undef PG8_LDB
#undef PG8_MMA
#undef PG8_WAIT_V
#undef PG8_WAIT_VR
#undef PG8_WAIT_L
#undef PG8_BAR
#undef PG8_SCHED
}

__device__ __forceinline__ float fsigmoid(float v) { return __builtin_amdgcn_rcpf(1.f + __builtin_amdgcn_exp2f(-1.4426950408889634f * v)); }
__device__ __forceinline__ float row_rstd(const float* ssq, int row) {
    const f32x4* p = (const f32x4*)(ssq + (size_t)row * 16); const f32x4 a = p[0], b = p[1], c = p[2], d = p[3];
    const float s = ((a.x + a.y) + (a.z + a.w)) + ((b.x + b.y) + (b.z + b.w)) + ((c.x + c.y) + (c.z + c.w)) + ((d.x + d.y) + (d.z + d.w));
    return 1.0f / sqrtf(s * (1.0f / 1024.0f) + 1e-5f);
}
template <bool I8> struct EpiP1 {
    static constexpr bool PERM = true; static constexpr int MID_T = 0, NSEG = 1, SEG_STEP = 0; static constexpr int PRE = 2; static constexpr bool PUB = false; static constexpr int NST = 16; __device__ __forceinline__ bool full_stores(const Unit& u, int wc) const { return u.pn != 33 || wc == 0; }
    bf16* O; int ldc; float* DT; const float* b_gate; const float* usc; const float* csc; LAS float* tab;
    __device__ __forceinline__ void pre_dma(const Unit& u, int tid, int par) const {
        const int w = __builtin_amdgcn_readfirstlane(tid >> 6); const unsigned tb = (unsigned)(size_t)tab + par * 3072;
        if constexpr (I8) {
            if (w < 4) { dma_dword(tb + w * 256, usc + u.pm * BM + tid);
                if (u.pn >= 25 && u.pn < 33) dma_dword(tb + 2048 + w * 256, b_gate + (tid >> 7) * 1024 + (u.pn - 25) * 128 + (tid & 127)); }
            else dma_dword(tb + 1024 + (w - 4) * 256, csc + u.pn * BM + tid - 256); }
        else { if (w < 4 && u.pn >= 25 && u.pn < 33) dma_dword(tb + 2048 + w * 256, b_gate + (tid >> 7) * 1024 + (u.pn - 25) * 128 + (tid & 127)); }
    }
    __device__ __forceinline__ static f32x4 val(const f32x4& a, const f32x4& cs, float rs) {
        if constexpr (I8) { const v4i i = __builtin_bit_cast(v4i, a); return (f32x4){(float)i[0], (float)i[1], (float)i[2], (float)i[3]} * cs * rs; } else return a; }
    __device__ __forceinline__ void operator()(const f32x4 (&acc)[2][2][4][2], const Unit& u, int wr, int wc, int fr, int fq, int par) const {
        int row0 = u.pm * BM + wr * 64 + fr; asm volatile("" : "+v"(row0));
        const int col0 = u.pn * BM + wc * 32 + 8 * fq; const LAS float* t = tab + par * 768;
        f32x4 cs[2][2]; float rsv[8];
#pragma unroll
        for (int bj = 0; bj < 2; ++bj)
#pragma unroll
            for (int n = 0; n < 2; ++n) cs[bj][n] = *(const LAS f32x4*)(t + 256 + wc * 32 + 8 * fq + bj * HALF + 4 * n);
#pragma unroll
        for (int i = 0; i < 8; ++i) rsv[i] = t[wr * 64 + fr + (i >> 2) * HALF + (i & 3) * 16];
        if (u.pn == 33) {
            if (wc == 0) {
#pragma unroll
                for (int ai = 0; ai < 2; ++ai)
#pragma unroll
                    for (int m = 0; m < 4; ++m)
#pragma unroll
                        for (int n = 0; n < 2; ++n) *(f32x4*)(DT + (size_t)(row0 + ai * HALF + m * 16) * 32 + 8 * fq + 4 * n) = val(acc[ai][0][m][n], cs[0][n], rsv[ai * 4 + m]); }
            return; }
        const bool act = u.pn >= 25, zt = u.pn >= 5 && u.pn < 13;
        const int gj = (u.pn - 25) * 128 + wc * 32 + 8 * fq;
        f32x4 bv[2][2];
#pragma unroll
        for (int bj = 0; bj < 2; ++bj)
#pragma unroll
            for (int n = 0; n < 2; ++n) bv[bj][n] = *(const LAS f32x4*)(t + 512 + bj * 128 + wc * 32 + 8 * fq + 4 * n);
#pragma unroll
        for (int ai = 0; ai < 2; ++ai)
#pragma unroll
            for (int m = 0; m < 4; ++m) { bf16* rowb = O + (size_t)(row0 + ai * HALF + m * 16) * ldc; const float rs = rsv[ai * 4 + m];
                f32x4 v[2][2];
#pragma unroll
                for (int bj = 0; bj < 2; ++bj) { v[bj][0] = val(acc[ai][bj][m][0], cs[bj][0], rs); v[bj][1] = val(acc[ai][bj][m][1], cs[bj][1], rs); }
                if (act) {
#pragma unroll
                    for (int n = 0; n < 2; ++n) { const f32x4 x0 = (v[0][n] + bv[0][n]) * -1.4426950408889634f, x1 = (v[1][n] + bv[1][n]) * -1.4426950408889634f; f32x4 e0, e1, r0, r1;
#pragma unroll
                        for (int k = 0; k < 4; ++k) { e0[k] = __builtin_amdgcn_exp2f(x0[k]); e1[k] = __builtin_amdgcn_exp2f(x1[k]); }
                        const f32x4 d0 = e0 + 1.f, d1 = e1 + 1.f;
#pragma unroll
                        for (int k = 0; k < 4; ++k) { r0[k] = __builtin_amdgcn_rcpf(d0[k]); r1[k] = __builtin_amdgcn_rcpf(d1[k]); }
                        v[0][n] = d1 * r0;
                        v[1][n] = r1; }
                }
                if (zt) {
#pragma unroll
                    for (int bj = 0; bj < 2; ++bj)
#pragma unroll
                        for (int n = 0; n < 2; ++n) { const f32x4 x = v[bj][n] * -1.4426950408889634f; f32x4 e, r;
#pragma unroll
                            for (int k = 0; k < 4; ++k) e[k] = __builtin_amdgcn_exp2f(x[k]);
                            const f32x4 d = e + 1.f;
#pragma unroll
                            for (int k = 0; k < 4; ++k) r[k] = __builtin_amdgcn_rcpf(d[k]);
                            v[bj][n] = v[bj][n] * r; } }
#pragma unroll
                for (int bj = 0; bj < 2; ++bj) { const f32x4 v0 = v[bj][0], v1 = v[bj][1];
                    v4u w; w.x = cvt_pk_bf16(v0[0], v0[1]); w.y = cvt_pk_bf16(v0[2], v0[3]); w.z = cvt_pk_bf16(v1[0], v1[1]); w.w = cvt_pk_bf16(v1[2], v1[3]);
                    *(v4u*)(rowb + (act ? 6400 + bj * 1024 + gj : col0 + bj * HALF)) = w; } }
    }
};
struct EpiBf16S {
    static constexpr bool PERM = true; static constexpr int MID_T = 0, NSEG = 1, SEG_STEP = 0; static constexpr int PRE = 1; static constexpr bool PUB = false; static constexpr int NST = 16; __device__ __forceinline__ bool full_stores(const Unit& u, int wc) const { return true; }
    bf16* O; int ldc; const float* ssq; float sc; LAS float* tab;
    __device__ __forceinline__ void pre_fetch(const Unit& u, int tid, float& a, float& b) const { a = sc; b = 0.f; if (ssq && tid < 256) a = row_rstd(ssq, u.pm * BM + tid) * sc; }
    __device__ __forceinline__ void pre_store(int tid, float a, float b, int par) const { if (tid < 256) tab[par * 768 + tid] = a; }
    __device__ __forceinline__ void operator()(const f32x4 (&acc)[2][2][4][2], const Unit& u, int wr, int wc, int fr, int fq, int par) const {
        int row0 = u.pm * BM + wr * 64 + fr; asm volatile("" : "+v"(row0)); const int col0 = u.pn * BM + wc * 32 + 8 * fq; const LAS float* t = tab + par * 768 + wr * 64 + fr;
#pragma unroll
        for (int ai = 0; ai < 2; ++ai)
#pragma unroll
            for (int m = 0; m < 4; ++m) { const int row = row0 + ai * HALF + m * 16; const float rs = t[ai * HALF + m * 16]; bf16* rowp = O + (size_t)row * ldc + col0;
#pragma unroll
                for (int bj = 0; bj < 2; ++bj) { const f32x4 v0 = acc[ai][bj][m][0] * rs, v1 = acc[ai][bj][m][1] * rs;
                    v4u w; w.x = cvt_pk_bf16(v0[0], v0[1]); w.y = cvt_pk_bf16(v0[2], v0[3]); w.z = cvt_pk_bf16(v1[0], v1[1]); w.w = cvt_pk_bf16(v1[2], v1[3]);
                    *(v4u*)(rowp + bj * HALF) = w; } }
    }
};
struct EpiI8 {
    static constexpr bool PERM = true; static constexpr int MID_T = 0, NSEG = 1, SEG_STEP = 0; static constexpr int PRE = 2; static constexpr bool PUB = false; static constexpr int NST = 16; __device__ __forceinline__ bool full_stores(const Unit& u, int wc) const { return true; }
    bf16* O; int ldc; const float* usc; const float* csc; LAS float* tab;
    __device__ __forceinline__ void pre_dma(const Unit& u, int tid, int par) const {
        const int w = __builtin_amdgcn_readfirstlane(tid >> 6); const unsigned tb = (unsigned)(size_t)tab + par * 3072;
        if (w < 4) dma_dword(tb + w * 256, usc + u.pm * BM + tid); else dma_dword(tb + 1024 + (w - 4) * 256, csc + u.pn * BM + tid - 256);
    }
    __device__ __forceinline__ void operator()(const f32x4 (&acc)[2][2][4][2], const Unit& u, int wr, int wc, int fr, int fq, int par) const {
        int row0 = u.pm * BM + wr * 64 + fr; asm volatile("" : "+v"(row0)); const int col0 = u.pn * BM + wc * 32 + 8 * fq; const LAS float* t = tab + par * 768;
        f32x4 cs[2][2];
#pragma unroll
        for (int bj = 0; bj < 2; ++bj)
#pragma unroll
            for (int n = 0; n < 2; ++n) cs[bj][n] = *(const LAS f32x4*)(t + 256 + wc * 32 + 8 * fq + bj * HALF + 4 * n);
#pragma unroll
        for (int ai = 0; ai < 2; ++ai)
#pragma unroll
            for (int m = 0; m < 4; ++m) { const int row = row0 + ai * HALF + m * 16; const float rs = t[wr * 64 + fr + ai * HALF + m * 16]; bf16* rowp = O + (size_t)row * ldc + col0;
#pragma unroll
                for (int bj = 0; bj < 2; ++bj) { const v4i i0 = __builtin_bit_cast(v4i, acc[ai][bj][m][0]), i1 = __builtin_bit_cast(v4i, acc[ai][bj][m][1]);
                    const f32x4 v0 = (f32x4){(float)i0[0], (float)i0[1], (float)i0[2], (float)i0[3]} * cs[bj][0] * rs, v1 = (f32x4){(float)i1[0], (float)i1[1], (float)i1[2], (float)i1[3]} * cs[bj][1] * rs;
                    v4u w; w.x = cvt_pk_bf16(v0[0], v0[1]); w.y = cvt_pk_bf16(v0[2], v0[3]); w.z = cvt_pk_bf16(v1[0], v1[1]); w.w = cvt_pk_bf16(v1[2], v1[3]);
                    *(v4u*)(rowp + bj * HALF) = w; } }
    }
};
template <int ES, bool O8> struct EpiG2 {
    static constexpr bool PERM = true; static constexpr int MID_T = 16 * ES / 2, NSEG = 5, SEG_STEP = 8 * ES / 2; static constexpr int PRE = 0; static constexpr bool PUB = false; static constexpr int NST = 0; __device__ __forceinline__ bool full_stores(const Unit& u, int wc) const { return false; }
    const bf16* gates; int ldg; void* O; int ldc; const float* ssqg; float sc; LAS float* ftab;
    __device__ __forceinline__ f32x4 unit_fetch(const Unit& u, int tid) const { return tid < 256 ? *(const f32x4*)(ssqg + (size_t)(u.pm * BM + tid) * 4) : (f32x4){1.f, 1.f, 1.f, 1.f}; }
    __device__ __forceinline__ void unit_store(int tid, const f32x4& sq) const {
        if (tid < 256) { const float q0 = sq[0] * (1.f / 512.f) + 1e-5f, q1 = sq[1] * (1.f / 512.f) + 1e-5f, q2 = sq[2] * (1.f / 512.f) + 1e-5f, q3 = sq[3] * (1.f / 512.f) + 1e-5f;
            ftab[tid] = sqrtf(q0); ftab[256 + tid] = sqrtf(q1 / q0); ftab[512 + tid] = sqrtf(q2 / q1); ftab[768 + tid] = sqrtf(q3 / q2); ftab[1024 + tid] = sc / sqrtf(q3); }
    }
    __device__ __forceinline__ void mid(f32x4 (&acc)[2][2][4][2], const Unit& u, int seg, int wr, int wc, int fr, int fq) const {
        int row0 = u.pm * BM + wr * 64 + fr; asm volatile("" : "+v"(row0)); const int col0 = u.pn * BM + wc * 32 + 8 * fq;
        const LAS float* rfp = ftab + seg * 256 + wr * 64 + fr;
        const bool gh = seg == 0 || seg == 4; const bf16* gbase = gates + col0 + (seg == 0 ? 0 : 1024);
#pragma unroll
        for (int pb = 0; pb < 1; ++pb) {
            v4u gv[4][2][2];
            if (gh) {
#pragma unroll
                for (int pp = 0; pp < 4; ++pp)
#pragma unroll
                    for (int mm = 0; mm < 2; ++mm)
#pragma unroll
                        for (int bj = 0; bj < 2; ++bj) { const int pr = pp; gv[pp][mm][bj] = *(const v4u*)(gbase + (size_t)(row0 + (pr >> 1) * HALF + (2 * (pr & 1) + mm) * 16) * ldg + bj * HALF); } }
#pragma unroll
            for (int pp = 0; pp < 4; ++pp) { const int pr = pp, ai = pr >> 1, m0 = 2 * (pr & 1);
                f32x4 fa[2][2], fb[2][2];
#pragma unroll
                for (int mm = 0; mm < 2; ++mm)
#pragma unroll
                    for (int bj = 0; bj < 2; ++bj) { const float f = rfp[ai * HALF + (m0 + mm) * 16]; fa[mm][bj] = (f32x4){f, f, f, f}; fb[mm][bj] = fa[mm][bj]; }
                if (gh) {
#pragma unroll
                    for (int mm = 0; mm < 2; ++mm)
#pragma unroll
                        for (int bj = 0; bj < 2; ++bj) { const v4u b = gv[pp][mm][bj];
                            fa[mm][bj] *= (f32x4){bflo(b.x), bfhi(b.x), bflo(b.y), bfhi(b.y)}; fb[mm][bj] *= (f32x4){bflo(b.z), bfhi(b.z), bflo(b.w), bfhi(b.w)}; }
                }
#pragma unroll
                for (int mm = 0; mm < 2; ++mm)
#pragma unroll
                    for (int bj = 0; bj < 2; ++bj) { acc[ai][bj][m0 + mm][0] *= fa[mm][bj]; acc[ai][bj][m0 + mm][1] *= fb[mm][bj]; }
                asm volatile("" : "+v"(acc[ai][0][m0][0]), "+v"(acc[ai][0][m0][1]), "+v"(acc[ai][1][m0][0]), "+v"(acc[ai][1][m0][1]), "+v"(acc[ai][0][m0 + 1][0]), "+v"(acc[ai][0][m0 + 1][1]), "+v"(acc[ai][1][m0 + 1][0]), "+v"(acc[ai][1][m0 + 1][1]) :: "memory");
            }
        }
    }
    __device__ __forceinline__ void operator()(const f32x4 (&acc)[2][2][4][2], const Unit& u, int wr, int wc, int fr, int fq) const {
        int row0 = u.pm * BM + wr * 64 + fr; asm volatile("" : "+v"(row0)); const int col0 = u.pn * BM + wc * 32 + 8 * fq;
#pragma unroll
        for (int ai = 0; ai < 2; ++ai)
#pragma unroll
            for (int m = 0; m < 4; ++m) { const size_t ro = (size_t)(row0 + ai * HALF + m * 16) * ldc + col0;
#pragma unroll
                for (int bj = 0; bj < 2; ++bj) { const f32x4 v0 = acc[ai][bj][m][0], v1 = acc[ai][bj][m][1];
                    if constexpr (O8) *(v2u*)((unsigned char*)O + ro + bj * HALF) = (v2u){pk4_fp8(v0[0], v0[1], v0[2], v0[3]), pk4_fp8(v1[0], v1[1], v1[2], v1[3])};
                    else { v4u w; w.x = cvt_pk_bf16(v0[0], v0[1]); w.y = cvt_pk_bf16(v0[2], v0[3]); w.z = cvt_pk_bf16(v1[0], v1[1]); w.w = cvt_pk_bf16(v1[2], v1[3]);
                        *(v4u*)((bf16*)O + ro + bj * HALF) = w; } } }
    }
};
template <bool BASE16> struct EpiRes {
    static constexpr bool PERM = true; static constexpr int MID_T = 0, NSEG = 1, SEG_STEP = 0; static constexpr int PRE = 1; static constexpr bool PUB = false; static constexpr int NST = 0; __device__ __forceinline__ bool full_stores(const Unit& u, int wc) const { return false; }
    const void* base; bf16* H; bf16* HB; const float* nw; float* ssq; unsigned char* T8; float sc; LAS float* tab;
    __device__ __forceinline__ void pre_fetch(const Unit& u, int tid, float& a, float& b) const { a = 0.f; b = 0.f; if (tid >= 256) a = nw[u.pn * BM + tid - 256]; }
    __device__ __forceinline__ void pre_store(int tid, float a, float b, int par) const { if (tid >= 256) tab[par * 768 + tid] = a; }
    __device__ __forceinline__ void operator()(const f32x4 (&acc)[2][2][4][2], const Unit& u, int wr, int wc, int fr, int fq, int par) const {
        int row0 = u.pm * BM + wr * 64 + fr; asm volatile("" : "+v"(row0)); const int col0 = u.pn * BM + wc * 32 + 8 * fq;
        f32x4 wv[2][2];
#pragma unroll
        for (int bj = 0; bj < 2; ++bj)
#pragma unroll
            for (int n = 0; n < 2; ++n) wv[bj][n] = *(const LAS f32x4*)(tab + par * 768 + 256 + wc * 32 + 8 * fq + bj * HALF + 4 * n);
        constexpr int MB = BASE16 ? 4 : 2;
#pragma unroll
        for (int ai = 0; ai < 2; ++ai)
#pragma unroll
        for (int mb = 0; mb < 4; mb += MB) {
            f32x4 b0[4][2], b1[4][2];
#pragma unroll
            for (int m = mb; m < mb + MB; ++m) { const size_t off = (size_t)(row0 + ai * HALF + m * 16) * 1024 + col0;
#pragma unroll
                for (int bj = 0; bj < 2; ++bj) {
                    if constexpr (BASE16) { const v4u q = *(const v4u*)((const bf16*)base + off + bj * HALF); b0[m][bj] = __builtin_bit_cast(f32x4, q); }
                    else { b0[m][bj] = *(const f32x4*)((const float*)base + off + bj * HALF); b1[m][bj] = *(const f32x4*)((const float*)base + off + bj * HALF + 4); } } }
            asm volatile("" ::: "memory");
#pragma unroll
            for (int m = mb; m < mb + MB; ++m) { const int row = row0 + ai * HALF + m * 16; const size_t off = (size_t)row * 1024 + col0; float s = 0.f;
#pragma unroll
                for (int bj = 0; bj < 2; ++bj) { f32x4 h0, h1;
                    if constexpr (BASE16) { const v4u q = __builtin_bit_cast(v4u, b0[m][bj]);
                        h0 = (f32x4){bflo(q.x), bfhi(q.x), bflo(q.y), bfhi(q.y)}; h1 = (f32x4){bflo(q.z), bfhi(q.z), bflo(q.w), bfhi(q.w)}; }
                    else { h0 = b0[m][bj]; h1 = b1[m][bj]; }
                    h0 += acc[ai][bj][m][0] * sc; h1 += acc[ai][bj][m][1] * sc;
                    s += ((h0[0] * h0[0] + h0[1] * h0[1]) + (h0[2] * h0[2] + h0[3] * h0[3])) + ((h1[0] * h1[0] + h1[1] * h1[1]) + (h1[2] * h1[2] + h1[3] * h1[3]));
                    *(v4u*)(H + off + bj * HALF) = (v4u){cvt_pk_bf16(h0[0], h0[1]), cvt_pk_bf16(h0[2], h0[3]), cvt_pk_bf16(h1[0], h1[1]), cvt_pk_bf16(h1[2], h1[3])};
                    const f32x4 w0 = h0 * wv[bj][0], w1 = h1 * wv[bj][1];
                    if (HB) *(v4u*)(HB + off + bj * HALF) = (v4u){cvt_pk_bf16(w0[0], w0[1]), cvt_pk_bf16(w0[2], w0[3]), cvt_pk_bf16(w1[0], w1[1]), cvt_pk_bf16(w1[2], w1[3])};
                    if (T8) *(v2u*)(T8 + off + bj * HALF) = (v2u){pk4_fp8(w0[0], w0[1], w0[2], w0[3]), pk4_fp8(w1[0], w1[1], w1[2], w1[3])}; }
                s += __shfl_xor(s, 16); s += __shfl_xor(s, 32);
                if (fq == 0) ssq[(size_t)row * 16 + u.pn * 4 + wc] = s; }
            asm volatile("" ::: "memory");
        }
    }
};
struct EpiGU {
    static constexpr bool PERM = true; static constexpr int MID_T = 0, NSEG = 1, SEG_STEP = 0; static constexpr int PRE = 2; static constexpr bool PUB = true;  static constexpr int NST = 8; __device__ __forceinline__ bool full_stores(const Unit& u, int wc) const { return true; }
    unsigned char* ACT8; const float* b_gu; const int* rowmap; const LAS int* cnt_s; LAS float* tab; unsigned* dep;
    __device__ __forceinline__ void publish(int pm) const { __hip_atomic_fetch_add(dep + 16 * pm, 1u, __ATOMIC_RELAXED, __HIP_MEMORY_SCOPE_AGENT); }
    __device__ __forceinline__ void pre_dma(const Unit& u, int tid, int par) const {
        const int w = __builtin_amdgcn_readfirstlane(tid >> 6); const unsigned tb = (unsigned)(size_t)tab + par * 3072;
        if (w < 4) { dma_dword(tb + w * 256, rowmap + 2 * (u.e * 16384 + u.p0 + tid) + 1);
            dma_dword(tb + 2048 + w * 256, b_gu + (size_t)u.e * 2048 + (tid >> 7) * 1024 + u.pn * 128 + (tid & 127)); }
    }
    __device__ __forceinline__ void operator()(const f32x4 (&acc)[2][2][4][2], const Unit& u, int wr, int wc, int fr, int fq, int par) const {
        int r0 = wr * 64 + fr; asm volatile("" : "+v"(r0)); const int cc = wc * 32 + 8 * fq; const LAS float* t = tab + par * 768;
        f32x4 bgv[2], buv[2];
#pragma unroll
        for (int n = 0; n < 2; ++n) { bgv[n] = *(const LAS f32x4*)(t + 512 + cc + 4 * n); buv[n] = *(const LAS f32x4*)(t + 512 + 128 + cc + 4 * n) + 1.f; }
        float rsv[8];
#pragma unroll
        for (int i = 0; i < 8; ++i) rsv[i] = t[r0 + (i >> 2) * HALF + (i & 3) * 16] * (1.f / W8_SCALE);
#pragma unroll
        for (int ai = 0; ai < 2; ++ai)
#pragma unroll
            for (int m = 0; m < 4; ++m) { const int rt = r0 + ai * HALF + m * 16; const float rs = rsv[ai * 4 + m]; unsigned w[2];
#pragma unroll
                for (int n = 0; n < 2; ++n) { const f32x4 g = acc[ai][0][m][n] * rs + bgv[n], u1 = acc[ai][1][m][n] * rs + buv[n];
                    const f32x4 gg = __builtin_elementwise_min(g, (f32x4){7.f, 7.f, 7.f, 7.f}); const f32x4 ex = gg * (-1.702f * 1.4426950408889634f);
                    f32x4 uu, e;
#pragma unroll
                    for (int k = 0; k < 4; ++k) { uu[k] = __builtin_amdgcn_fmed3f(u1[k], -6.f, 8.f); e[k] = __builtin_amdgcn_exp2f(ex[k]); }
                    const f32x4 d = e + 1.f; f32x4 r;
#pragma unroll
                    for (int k = 0; k < 4; ++k) r[k] = __builtin_amdgcn_rcpf(d[k]);
                    const f32x4 a = (uu * gg) * r;
                    int q = 0; q = __builtin_amdgcn_cvt_pk_fp8_f32(a[0], a[1], q, false); q = __builtin_amdgcn_cvt_pk_fp8_f32(a[2], a[3], q, true); w[n] = (unsigned)q; }
                __hip_atomic_store((unsigned long long*)(ACT8 + (size_t)(u.pm * BM + rt) * 1024 + u.pn * 128 + cc), (unsigned long long)w[0] | ((unsigned long long)w[1] << 32), __ATOMIC_RELAXED, __HIP_MEMORY_SCOPE_AGENT); }
    }
};
struct EpiDN {
    static constexpr bool PERM = true; static constexpr int MID_T = 0, NSEG = 1, SEG_STEP = 0; static constexpr int PRE = 2; static constexpr bool PUB = false; static constexpr int NST = 16; __device__ __forceinline__ bool full_stores(const Unit& u, int wc) const { return true; }
    unsigned char* Y; const float* b_dn; LAS float* tab;
    __device__ __forceinline__ void pre_dma(const Unit& u, int tid, int par) const {
        const int w = __builtin_amdgcn_readfirstlane(tid >> 6); const unsigned tb = (unsigned)(size_t)tab + par * 3072;
        if (w < 4) dma_dword(tb + 2048 + w * 256, b_dn + (size_t)u.e * 1024 + u.pn * BM + tid);
    }
    __device__ __forceinline__ void operator()(const f32x4 (&acc)[2][2][4][2], const Unit& u, int wr, int wc, int fr, int fq, int par) const {
        int row0 = u.pm * BM + wr * 64 + fr; asm volatile("" : "+v"(row0)); const int col0 = u.pn * BM + wc * 32 + 8 * fq; const LAS float* t = tab + par * 768 + 512 + wc * 32 + 8 * fq;
        f32x4 bv[2][2];
#pragma unroll
        for (int bj = 0; bj < 2; ++bj)
#pragma unroll
            for (int n = 0; n < 2; ++n) bv[bj][n] = *(const LAS f32x4*)(t + bj * HALF + 4 * n);
#pragma unroll
        for (int ai = 0; ai < 2; ++ai)
#pragma unroll
            for (int m = 0; m < 4; ++m) { unsigned char* rowp = Y + (size_t)(row0 + ai * HALF + m * 16) * 1024 + col0;
#pragma unroll
                for (int bj = 0; bj < 2; ++bj) { const f32x4 v0 = acc[ai][bj][m][0] * (1.f / W8_SCALE) + bv[bj][0], v1 = acc[ai][bj][m][1] * (1.f / W8_SCALE) + bv[bj][1];
                    *(v2u*)(rowp + bj * HALF) = (v2u){pk4_fp8(v0[0], v0[1], v0[2], v0[3]), pk4_fp8(v1[0], v1[1], v1[2], v1[3])}; } }
    }
};
}
#ifndef FP8_G2
#define FP8_G2 1
#endif
#ifndef FP8_G3
#define FP8_G3 0
#endif
#ifndef FP8_G4
#define FP8_G4 1
#endif
#ifndef FP8_G6
#define FP8_G6 1
#endif
#ifndef I8_G1
#define I8_G1 1
#endif
#ifndef MK_SUBREP
#define MK_SUBREP 0
#endif
constexpr int NWAVES = 8;
constexpr int M_TOK = 16384, SEQ = 2048, NBATCH = 8, DM = 1024;
constexpr int P1C = 8448;
constexpr int C_Q = 0, C_K = 1024, C_V = 1152, C_Z = 1280, C_X = 3328, C_G = 6400;
constexpr int N1 = 8704;
constexpr size_t MiB = 1u << 20;
constexpr size_t WS_CTL = 0, CTL_ZERO_BYTES = 1 * MiB;
constexpr size_t WS_W1T = 1 * MiB, WS_WCKV = 18 * MiB, WS_WCAT = 22 * MiB, WS_WOUT = 28 * MiB, WS_WCQ = 30 * MiB, WS_WCO = 32 * MiB, WS_WR = 34 * MiB, WS_WGU = 35 * MiB, WS_WDN = 163 * MiB;
constexpr size_t WS_P1 = 228 * MiB, WS_DT = 492 * MiB, WS_KVC = 494 * MiB, WS_ACAT = 502 * MiB, WS_ST = 598 * MiB, WS_PREV = 662 * MiB, WS_U = 726 * MiB, WS_MN = 758 * MiB;
constexpr size_t WS_H1 = 762 * MiB, WS_HB = 826 * MiB, WS_MISC = 858 * MiB;
constexpr size_t WS_T8 = WS_ACAT + 48 * MiB  , WS_QC = WS_ACAT + 64 * MiB  , WS_MERGED = WS_U, WS_OC = WS_HB + 16 * MiB  , WS_H2 = 960 * MiB  ,
    WS_ACT = 880 * MiB  , WS_Y = WS_P1 + 144 * MiB;
constexpr size_t WS_SSQ1 = WS_MISC, WS_SSQ2 = WS_MISC + 1 * MiB, WS_TOKE = WS_MISC + 2 * MiB, WS_TOKP = WS_TOKE + 256 * 1024, WS_TOKW = WS_TOKP + 256 * 1024, WS_CDEC = WS_TOKW + 256 * 1024, WS_ROWMAP = WS_MISC + 3 * MiB  , WS_SSQG = WS_MISC + 7 * MiB, WS_USC = WS_MISC + 7 * MiB + 512 * 1024  , WS_CSC = WS_MISC + 7 * MiB + 768 * 1024  , WS_MSC = WS_MISC + 7 * MiB + 832 * 1024  , WS_KSC = WS_MISC + 7 * MiB + 896 * 1024  ;
constexpr size_t WS_NAIVE = 880 * MiB;
static_assert(FP8_G2 && FP8_G4 && FP8_G6, "the workspace map above assumes the fp8 formats of ACAT, HB and OC");
constexpr int CW_TMO = 0, CW_BAR = 4096, CW_CNT = 16384, CW_DEP = 65536, CW_XCC = 73728, CW_PB = 81920;
constexpr int SCR_BYTES = 139264;
constexpr int TAB_OFF = SCR_BYTES;
constexpr int LDS_BYTES = SCR_BYTES + 16384;
constexpr int TAB_MISC = TAB_OFF;
constexpr int TAB_DT = TAB_OFF + 1024, TAB_ACUM = TAB_OFF + 1024 + 4096;
constexpr int TAB_TE = TAB_OFF + 1024, TAB_TP0 = TAB_TE + 1280, TAB_CNT = TAB_TP0 + 1280, TAB_TB = TAB_CNT + 128, TAB_NT = TAB_TB + 128;

typedef const float* fptr_t;
struct Frame {
    LAS unsigned char* lds; gu32* ctl; int tid, lane, wave, vcu, G;
    unsigned char* ws;
    const __attribute__((address_space(4))) fptr_t* in;
    float* out;
};
enum { I_X = 0, I_MEM, I_NMIXW, I_WIN, I_WGATE, I_BGATE, I_SINKS, I_CONVW, I_CONVB, I_DTB, I_ALOG, I_DSKIP, I_SSMNW, I_WAO, I_WSO, I_WOUT, I_NCW, I_NMW, I_WCQ, I_WCKV, I_WCO, I_NFW, I_WR, I_BR, I_WGU, I_BGU, I_WDN, I_BDN, I_FNW };

__device__ __forceinline__ bool ssd_unit(const Frame& F, int k, int& u) {
    if (F.G == 256) { if (k >= 2) return false; u = (F.vcu >> 5) * 64 + (F.vcu & 31) + 32 * k; return true; }
    u = F.vcu + k * F.G; return u < 512;
}
__device__ __forceinline__ void tr_item(const float* W, int ldw, int k0, int n0, bf16* dst, int ldt, LAS float* scr, int lane, const float* kscale = nullptr) {
    f32x4 t[8]; const int kq = lane >> 3, c = lane & 7;
#pragma unroll
    for (int i = 0; i < 8; ++i) { t[i] = *(const GAS f32x4*)(W + (size_t)(k0 + 8 * kq + i) * ldw + n0 + 4 * c); if (kscale) t[i] *= kscale[k0 + 8 * kq + i]; }
#pragma unroll
    for (int j = 0; j < 4; ++j)
        *(GAS v4u*)(dst + (size_t)(4 * c + j) * ldt + 8 * kq) = (v4u){pk2(t[0][j], t[1][j]), pk2(t[2][j], t[3][j]), pk2(t[4][j], t[5][j]), pk2(t[6][j], t[7][j])};
}
__device__ __forceinline__ void tr_item8(const float* W, int ldw, int k0, int n0, unsigned char* dst, int ldt, LAS float* scr, int lane, float sc, const float* kscale = nullptr) {
    f32x4 t[8]; const int kq = lane >> 3, c = lane & 7;
#pragma unroll
    for (int i = 0; i < 8; ++i) { t[i] = *(const GAS f32x4*)(W + (size_t)(k0 + 8 * kq + i) * ldw + n0 + 4 * c); t[i] *= kscale ? sc * kscale[k0 + 8 * kq + i] : sc; }
#pragma unroll
    for (int j = 0; j < 4; ++j)
        *(GAS v2u*)(dst + (size_t)(4 * c + j) * ldt + 8 * kq) = (v2u){pg8::pk4_fp8(t[0][j], t[1][j], t[2][j], t[3][j]), pg8::pk4_fp8(t[4][j], t[5][j], t[6][j], t[7][j])};
}
__device__ __forceinline__ void rms_row_to_bf16(const float* xrow, const float* w, bf16* orow, int lane) {
    const GAS f32x4* xr = (const GAS f32x4*)xrow + lane; const GAS f32x4* wr_ = (const GAS f32x4*)w + lane;
    f32x4 v[4]; float s = 0.f;
#pragma unroll
    for (int j = 0; j < 4; ++j) { v[j] = xr[64 * j]; s += (v[j].x * v[j].x + v[j].y * v[j].y) + (v[j].z * v[j].z + v[j].w * v[j].w); }
    const float rstd = 1.f / sqrtf(wave_sum(s) * (1.f / 1024.f) + 1e-5f);
    GAS unsigned long long* o8 = (GAS unsigned long long*)orow + lane;
#pragma unroll
    for (int j = 0; j < 4; ++j) { const f32x4 g = wr_[64 * j]; o8[64 * j] = (unsigned long long)pk2(v[j].x * rstd * g.x, v[j].y * rstd * g.y) | ((unsigned long long)pk2(v[j].z * rstd * g.z, v[j].w * rstd * g.w) << 32); }
}
__device__ __forceinline__ unsigned pk4_i8(float a, float b, float c, float d) {
    return ((unsigned)(int)a & 0xffu) | (((unsigned)(int)b & 0xffu) << 8) | (((unsigned)(int)c & 0xffu) << 16) | ((unsigned)(int)d << 24); }
__device__ __forceinline__ void rms_load(const float* xrow, int lane, f32x4 (&v)[4]) {
    const GAS f32x4* xr = (const GAS f32x4*)xrow + lane;
#pragma unroll
    for (int j = 0; j < 4; ++j) v[j] = xr[64 * j];
}
__device__ __forceinline__ void rms_finish_i8(f32x4 (&v)[4], const float* w, unsigned char* orow, float* osc, int lane) {
    const GAS f32x4* wr_ = (const GAS f32x4*)w + lane; float s = 0.f;
#pragma unroll
    for (int j = 0; j < 4; ++j) s += (v[j].x * v[j].x + v[j].y * v[j].y) + (v[j].z * v[j].z + v[j].w * v[j].w);
    const float rstd = 1.f / sqrtf(wave_sum(s) * (1.f / 1024.f) + 1e-5f); float mx = 0.f;
#pragma unroll
    for (int j = 0; j < 4; ++j) { const f32x4 g = wr_[64 * j]; v[j] = v[j] * rstd * g; mx = fmaxf(fmaxf(fmaxf(fabsf(v[j].x), fabsf(v[j].y)), fmaxf(fabsf(v[j].z), fabsf(v[j].w))), mx); }
#pragma unroll
    for (int o = 1; o < 64; o <<= 1) mx = fmaxf(mx, __shfl_xor(mx, o));
    const float isc = mx > 0.f ? 127.f / mx : 0.f;
#pragma unroll
    for (int j = 0; j < 4; ++j) ((GAS unsigned*)orow)[lane + 64 * j] = pk4_i8(rintf(v[j].x * isc), rintf(v[j].y * isc), rintf(v[j].z * isc), rintf(v[j].w * isc));
    if (lane == 0) *osc = mx * (1.f / 127.f);
}
__device__ __forceinline__ void rms_row_to_i8(const float* xrow, const float* w, unsigned char* orow, float* osc, int lane) {
    const GAS f32x4* xr = (const GAS f32x4*)xrow + lane; const GAS f32x4* wr_ = (const GAS f32x4*)w + lane;
    f32x4 v[4]; float s = 0.f;
#pragma unroll
    for (int j = 0; j < 4; ++j) { v[j] = xr[64 * j]; s += (v[j].x * v[j].x + v[j].y * v[j].y) + (v[j].z * v[j].z + v[j].w * v[j].w); }
    const float rstd = 1.f / sqrtf(wave_sum(s) * (1.f / 1024.f) + 1e-5f); float mx = 0.f;
#pragma unroll
    for (int j = 0; j < 4; ++j) { const f32x4 g = wr_[64 * j]; v[j] = v[j] * rstd * g; mx = fmaxf(fmaxf(fmaxf(fabsf(v[j].x), fabsf(v[j].y)), fmaxf(fabsf(v[j].z), fabsf(v[j].w))), mx); }
#pragma unroll
    for (int o = 1; o < 64; o <<= 1) mx = fmaxf(mx, __shfl_xor(mx, o));
    const float isc = mx > 0.f ? 127.f / mx : 0.f;
#pragma unroll
    for (int j = 0; j < 4; ++j) ((GAS unsigned*)orow)[lane + 64 * j] = pk4_i8(rintf(v[j].x * isc), rintf(v[j].y * isc), rintf(v[j].z * isc), rintf(v[j].w * isc));
    if (lane == 0) *osc = mx * (1.f / 127.f);
}
__device__ __forceinline__ void w1t_colblock_i8(Frame& F, const float* W, int ldw, int n0, unsigned char* dst  , float* csc  ) {
    LAS float* cmax = (LAS float*)(F.lds + TAB_OFF + 1024);
    const int lane = F.lane, kq = lane >> 3, c4 = (lane & 7) * 4, kb0 = 2 * F.wave;
    f32x4 t[2][8]; f32x4 mx = (f32x4){0.f, 0.f, 0.f, 0.f};
#pragma unroll
    for (int b = 0; b < 2; ++b)
#pragma unroll
        for (int i = 0; i < 8; ++i) t[b][i] = *(const GAS f32x4*)(W + (size_t)(64 * (kb0 + b) + 8 * kq + i) * ldw + n0 + c4);
#pragma unroll
    for (int b = 0; b < 2; ++b)
#pragma unroll
        for (int i = 0; i < 8; ++i) { mx[0] = fmaxf(mx[0], fabsf(t[b][i][0])); mx[1] = fmaxf(mx[1], fabsf(t[b][i][1])); mx[2] = fmaxf(mx[2], fabsf(t[b][i][2])); mx[3] = fmaxf(mx[3], fabsf(t[b][i][3])); }
#pragma unroll
    for (int o = 8; o < 64; o <<= 1) { mx[0] = fmaxf(mx[0], __shfl_xor(mx[0], o)); mx[1] = fmaxf(mx[1], __shfl_xor(mx[1], o)); mx[2] = fmaxf(mx[2], __shfl_xor(mx[2], o)); mx[3] = fmaxf(mx[3], __shfl_xor(mx[3], o)); }
    if (lane < 8) *(LAS f32x4*)(cmax + F.wave * 32 + c4) = mx;
    LDS_WAIT(); __syncthreads();
#pragma unroll
    for (int wv = 0; wv < 8; ++wv) { const f32x4 o = *(const LAS f32x4*)(cmax + wv * 32 + c4); mx[0] = fmaxf(mx[0], o[0]); mx[1] = fmaxf(mx[1], o[1]); mx[2] = fmaxf(mx[2], o[2]); mx[3] = fmaxf(mx[3], o[3]); }
    f32x4 isc;
#pragma unroll
    for (int k = 0; k < 4; ++k) isc[k] = mx[k] > 0.f ? 127.f / mx[k] : 0.f;
    if (F.wave == 0 && lane < 8) *(f32x4*)(csc + c4) = mx * (1.f / 127.f);
#pragma unroll
    for (int b = 0; b < 2; ++b)
#pragma unroll
        for (int j = 0; j < 4; ++j)
            *(GAS v2u*)(dst + (size_t)(c4 + j) * 1024 + 64 * (kb0 + b) + 8 * kq) =
                (v2u){pk4_i8(rintf(t[b][0][j] * isc[j]), rintf(t[b][1][j] * isc[j]), rintf(t[b][2][j] * isc[j]), rintf(t[b][3][j] * isc[j])),
                      pk4_i8(rintf(t[b][4][j] * isc[j]), rintf(t[b][5][j] * isc[j]), rintf(t[b][6][j] * isc[j]), rintf(t[b][7][j] * isc[j]))};
    LDS_WAIT(); __syncthreads();
}
__device__ __forceinline__ int gate_row(int nb) { const int col = 32 * nb, half = col >> 10, j = col & 1023; return 6400 + (j >> 7) * 256 + half * 128 + (j & 127); }
__device__ __forceinline__ void wdn_item(Frame& F, int r, LAS float* scr) {
    const int e = r / 512, rr = r % 512, kb = rr / 32, nb = rr % 32;
    tr_item8(F.in[I_WDN] + (size_t)e * 1024 * 1024, 1024, 64 * kb, 32 * nb, (unsigned char*)(F.ws + WS_WDN) + (size_t)e * 1024 * 1024 + (size_t)(32 * nb) * 1024 + 64 * kb, 1024, scr, F.lane, pg8::W8_SCALE);
}
__device__ __forceinline__ void wgu_item(Frame& F, int r, LAS float* scr) {
    const int e = r / 1024, rr = r % 1024, kb = rr / 64, nb = rr % 64; const int n0 = 32 * nb, up = n0 >= 1024 ? 1 : 0, j = n0 & 1023, drow = (j >> 7) * 256 + up * 128 + (j & 127);
    tr_item8(F.in[I_WGU] + (size_t)e * 1024 * 2048, 2048, 64 * kb, n0, (unsigned char*)(F.ws + WS_WGU) + (size_t)e * 2048 * 1024 + (size_t)drow * 1024 + 64 * kb, 1024, scr, F.lane, pg8::W8_SCALE);
}
constexpr int LATE1 = 6, LATE2 = 9, WDN_LATE1 = 64 * 8 * LATE1, WDN_LATE2 = 32 * 8 * LATE2, WDN_LATE = WDN_LATE1 + WDN_LATE2;
__device__ __forceinline__ void wdn_late_items(Frame& F, int c) {
    if (F.G != 256 || c / 8 < 24) return;
    LAS float* scr = (LAS float*)(F.lds + F.wave * 16384);
    const int b64 = (c / 8 - 24) * 8 + (c % 8);
    for (int k = 0; k < LATE1; ++k) wdn_item(F, 32 * 16 * 32 - WDN_LATE + (b64 * 8 + F.wave) * LATE1 + k, scr);
}
__device__ __forceinline__ void wdn_late_items2(Frame& F, int idx  ) {
    if (F.G != 256) return;
    LAS float* scr = (LAS float*)(F.lds + F.wave * 16384);
    for (int k = 0; k < LATE2; ++k) wdn_item(F, 32 * 16 * 32 - WDN_LATE2 + (idx * 8 + F.wave) * LATE2 + k, scr);
}
constexpr int MOE_ITEMS = 32 * 16 * 64 + 32 * 16 * 32;
struct MoeItem { const float* src; int ldw; unsigned char* dst; };
__device__ __forceinline__ MoeItem moe_item(Frame& F, int it) {
    if (it < 32 * 16 * 64) { const int e = it / 1024, rr = it % 1024, kb = rr / 64, nb = rr % 64; const int n0 = 32 * nb, up = n0 >= 1024 ? 1 : 0, j = n0 & 1023, drow = (j >> 7) * 256 + up * 128 + (j & 127);
        return MoeItem{F.in[I_WGU] + (size_t)e * 1024 * 2048 + (size_t)(64 * kb) * 2048 + n0, 2048, (unsigned char*)(F.ws + WS_WGU) + (size_t)e * 2048 * 1024 + (size_t)drow * 1024 + 64 * kb}; }
    const int r = it - 32 * 16 * 64, e = r / 512, rr = r % 512, kb = rr / 32, nb = rr % 32;
    return MoeItem{F.in[I_WDN] + (size_t)e * 1024 * 1024 + (size_t)(64 * kb) * 1024 + 32 * nb, 1024, (unsigned char*)(F.ws + WS_WDN) + (size_t)e * 1024 * 1024 + (size_t)(32 * nb) * 1024 + 64 * kb};
}
__device__ __forceinline__ void moe_load(const MoeItem& m, int lane, f32x4 (&t)[8]) {
    const int kq = lane >> 3, c = lane & 7;
#pragma unroll
    for (int i = 0; i < 8; ++i) t[i] = *(const GAS f32x4*)(m.src + (size_t)(8 * kq + i) * m.ldw + 4 * c);
}
__device__ __forceinline__ void moe_finish(const MoeItem& m, int lane, const f32x4 (&t)[8], LAS float* scr) {
    const int kq = lane >> 3, c = lane & 7;
#pragma unroll
    for (int j = 0; j < 4; ++j)
        *(GAS v2u*)(m.dst + (size_t)(4 * c + j) * 1024 + 8 * kq) = (v2u){pg8::pk4_fp8(t[0][j] * pg8::W8_SCALE, t[1][j] * pg8::W8_SCALE, t[2][j] * pg8::W8_SCALE, t[3][j] * pg8::W8_SCALE),
                                                                        pg8::pk4_fp8(t[4][j] * pg8::W8_SCALE, t[5][j] * pg8::W8_SCALE, t[6][j] * pg8::W8_SCALE, t[7][j] * pg8::W8_SCALE)};
}
__device__ __forceinline__ void moe_convert_burst(Frame& F) {
    LAS float* scr = (LAS float*)(F.lds + F.wave * 16384);
    const int gw = F.vcu * NWAVES + F.wave, NGW = F.G * NWAVES, N = MOE_ITEMS - WDN_LATE;
    if (gw >= N) return;
    int lane = F.lane; asm volatile("" : "+v"(lane));
    MoeItem a0, a1, a2; f32x4 t0[8], t1[8], t2[8];
    int i = gw;
    a0 = moe_item(F, i); moe_load(a0, lane, t0);
    a1 = moe_item(F, min(i + NGW, N - 1)); moe_load(a1, lane, t1);
    for (;;) {
        a2 = moe_item(F, min(i + 2 * NGW, N - 1)); moe_load(a2, lane, t2);
        moe_finish(a0, lane, t0, scr);
        if (i + NGW >= N) break;
        a0 = moe_item(F, min(i + 3 * NGW, N - 1)); moe_load(a0, lane, t0);
        moe_finish(a1, lane, t1, scr);
        if (i + 2 * NGW >= N) break;
        a1 = moe_item(F, min(i + 4 * NGW, N - 1)); moe_load(a1, lane, t1);
        moe_finish(a2, lane, t2, scr);
        if (i + 3 * NGW >= N) break;
        i += 3 * NGW;
    }
}
__device__ __forceinline__ void p0_prologue(Frame& F) {
    LAS float* scr = (LAS float*)(F.lds + F.wave * 16384);
    const int gw = F.vcu * NWAVES + F.wave, NGW = F.G * NWAVES;
    bf16* W1T = (bf16*)(F.ws + WS_W1T); bf16* WCAT = (bf16*)(F.ws + WS_WCAT);
    constexpr int I1 = 16 * 200, I2 = 16, I3 = 16 * 64, I4 = 16 * 64, I5 = 16 * 32, I6 = 32 * 32, I7 = 16 * 32, I10 = 16, I11 = 32 * 16 * 64, I12 = 32 * 16 * 32;
    constexpr int NITEMS = (I8_G1 ? 0 : I1 + I2 + I3 + I4) + I5 + I6 + 3 * I7 + I10 + I11 + I12;
    const int n_items = NITEMS - (F.G == 256 ? I11 + I12 : 0);
    for (int it = gw; it < n_items; it += NGW) {
        int r = it;
        if (I8_G1) r += I1 + I2 + I3;
        if (r < I1) { const int kb = r / 200, nb = r % 200; tr_item(F.in[I_WIN], 6432, 64 * kb, 32 * nb, W1T + (size_t)(32 * nb) * 1024 + 64 * kb, 1024, scr, F.lane); continue; } r -= I1;
        if (r < I2) { const int kb = r; tr_item(F.in[I_WIN], 6432, 64 * kb, 6400, W1T + (size_t)8448 * 1024 + 64 * kb, 1024, scr, F.lane); continue; } r -= I2;
        if (r < I3) { const int kb = r / 64, nb = r % 64; tr_item(F.in[I_WGATE], 2048, 64 * kb, 32 * nb, W1T + (size_t)gate_row(nb) * 1024 + 64 * kb, 1024, scr, F.lane); continue; } r -= I3;
        if (I8_G1) r += I4;
        if (r < I4) { const int kb = r / 64, nb = r % 64; tr_item(F.in[I_WCKV], 2048, 64 * kb, 32 * nb, (bf16*)(F.ws + WS_WCKV) + (size_t)(32 * nb) * 1024 + 64 * kb, 1024, scr, F.lane); continue; } r -= I4;
        if (r < I5) { const int kb = r / 32, nb = r % 32;
            if (FP8_G2) tr_item8(F.in[I_WAO], 1024, 64 * kb, 32 * nb, (unsigned char*)WCAT + (size_t)(32 * nb) * 3072 + 64 * kb, 3072, scr, F.lane, pg8::W8_SCALE);
            else tr_item(F.in[I_WAO], 1024, 64 * kb, 32 * nb, WCAT + (size_t)(32 * nb) * 3072 + 64 * kb, 3072, scr, F.lane);
            continue; } r -= I5;
        if (r < I6) { const int kb = r / 32, nb = r % 32;
            if (FP8_G2) tr_item8(F.in[I_WSO], 1024, 64 * kb, 32 * nb, (unsigned char*)WCAT + (size_t)(32 * nb) * 3072 + 1024 + 64 * kb, 3072, scr, F.lane, pg8::W8_SCALE, F.in[I_SSMNW]);
            else tr_item(F.in[I_WSO], 1024, 64 * kb, 32 * nb, WCAT + (size_t)(32 * nb) * 3072 + 1024 + 64 * kb, 3072, scr, F.lane, F.in[I_SSMNW]);
            continue; } r -= I6;
        if (r < I7) { const int kb = r / 32, nb = r % 32;
            if (FP8_G3) tr_item8(F.in[I_WOUT], 1024, 64 * kb, 32 * nb, (unsigned char*)(F.ws + WS_WOUT) + (size_t)(32 * nb) * 1024 + 64 * kb, 1024, scr, F.lane, pg8::W8_SCALE);
            else tr_item(F.in[I_WOUT], 1024, 64 * kb, 32 * nb, (bf16*)(F.ws + WS_WOUT) + (size_t)(32 * nb) * 1024 + 64 * kb, 1024, scr, F.lane);
            continue; } r -= I7;
        if (r < I7) { const int kb = r / 32, nb = r % 32;
            if (FP8_G4) tr_item8(F.in[I_WCQ], 1024, 64 * kb, 32 * nb, (unsigned char*)(F.ws + WS_WCQ) + (size_t)(32 * nb) * 1024 + 64 * kb, 1024, scr, F.lane, pg8::W8_SCALE);
            else tr_item(F.in[I_WCQ], 1024, 64 * kb, 32 * nb, (bf16*)(F.ws + WS_WCQ) + (size_t)(32 * nb) * 1024 + 64 * kb, 1024, scr, F.lane);
            continue; } r -= I7;
        if (r < I7) { const int kb = r / 32, nb = r % 32;
            if (FP8_G6) tr_item8(F.in[I_WCO], 1024, 64 * kb, 32 * nb, (unsigned char*)(F.ws + WS_WCO) + (size_t)(32 * nb) * 1024 + 64 * kb, 1024, scr, F.lane, pg8::W8_SCALE);
            else tr_item(F.in[I_WCO], 1024, 64 * kb, 32 * nb, (bf16*)(F.ws + WS_WCO) + (size_t)(32 * nb) * 1024 + 64 * kb, 1024, scr, F.lane);
            continue; } r -= I7;
        if (r < I10) { const int kb = r; tr_item(F.in[I_WR], 32, 64 * kb, 0, (bf16*)(F.ws + WS_WR) + 64 * kb, 1024, scr, F.lane, F.in[I_NFW]); continue; } r -= I10;
        if (r < I11) { wgu_item(F, r, scr); continue; } r -= I11;
        wdn_item(F, r, scr);
    }
    if (I8_G1) {
        unsigned char* W8 = (unsigned char*)(F.ws + WS_W1T); float* csc = (float*)(F.ws + WS_CSC);
        __syncthreads();
        for (int task = F.G - 1 - F.vcu; task < 265 + 64; task += F.G) {
            if (task >= 265) { const int nb = task - 265; w1t_colblock_i8(F, F.in[I_WCKV], 2048, 32 * nb, (unsigned char*)(F.ws + WS_WCKV) + (size_t)(32 * nb) * 1024, (float*)(F.ws + WS_KSC) + 32 * nb); }
            else if (task < 201) { const int drow = task < 200 ? 32 * task : 8448; w1t_colblock_i8(F, F.in[I_WIN], 6432, 32 * task, W8 + (size_t)drow * 1024, csc + drow); }
            else { const int nb = task - 201, drow = gate_row(nb); w1t_colblock_i8(F, F.in[I_WGATE], 2048, 32 * nb, W8 + (size_t)drow * 1024, csc + drow); } }
        for (int i = F.vcu * 512 + F.tid; i < 14336; i += F.G * 512) ((GAS v4u*)(W8 + (size_t)8480 * 1024))[i] = (v4u){0u, 0u, 0u, 0u};
        for (int i = F.vcu * 512 + F.tid; i < 224; i += F.G * 512) csc[8480 + i] = 0.f;
        {
          const float* X = F.in[I_X]; const float* gw_ = F.in[I_NMIXW]; unsigned char* U8 = (unsigned char*)(F.ws + WS_U); float* usc = (float*)(F.ws + WS_USC);
          f32x4 va[4], vb[4]; int m = gw;
          if (m < M_TOK) { rms_load(X + (size_t)m * DM, F.lane, va);
              for (;;) {
                  rms_load(X + (size_t)min(m + NGW, M_TOK - 1) * DM, F.lane, vb);
                  rms_finish_i8(va, gw_, U8 + (size_t)m * DM, usc + m, F.lane);
                  if (m + NGW >= M_TOK) break;
                  rms_load(X + (size_t)min(m + 2 * NGW, M_TOK - 1) * DM, F.lane, va);
                  rms_finish_i8(vb, gw_, U8 + (size_t)(m + NGW) * DM, usc + m + NGW, F.lane);
                  if (m + 2 * NGW >= M_TOK) break;
                  m += 2 * NGW; } } }
    } else {
    for (int i = F.vcu * 512 + F.tid; i < 28672; i += F.G * 512) ((GAS v4u*)(W1T + (size_t)8480 * 1024))[i] = (v4u){0u, 0u, 0u, 0u};
    for (int m = gw; m < M_TOK; m += NGW) rms_row_to_bf16(F.in[I_X] + (size_t)m * DM, F.in[I_NMIXW], (bf16*)(F.ws + WS_U) + (size_t)m * DM, F.lane);
    }
    for (int m = gw; m < NBATCH * 256; m += NGW) {
        if (I8_G1) rms_row_to_i8(F.in[I_MEM] + (size_t)m * DM, F.in[I_NMW], (unsigned char*)(F.ws + WS_MN) + (size_t)m * DM, (float*)(F.ws + WS_MSC) + m, F.lane);
        else rms_row_to_bf16(F.in[I_MEM] + (size_t)m * DM, F.in[I_NMW], (bf16*)(F.ws + WS_MN) + (size_t)m * DM, F.lane); }
}

__device__ __forceinline__ s16x4 tr_read(const LAS unsigned char* p) { return __builtin_bit_cast(s16x4, __builtin_amdgcn_ds_read_tr16_b64_v4i16((LAS s16x4*)p)); }
__device__ __forceinline__ bf16x8 cat8(s16x4 a, s16x4 b) { return (bf16x8){a[0], a[1], a[2], a[3], b[0], b[1], b[2], b[3]}; }
__device__ __forceinline__ bf16x8 pack8(f32x4 a, f32x4 b) { v4u w; w.x = cvt_pk_bf16(a[0], a[1]); w.y = cvt_pk_bf16(a[2], a[3]); w.z = cvt_pk_bf16(b[0], b[1]); w.w = cvt_pk_bf16(b[2], b[3]); return __builtin_bit_cast(bf16x8, w); }
#define MFMA16(a, b, c) __builtin_amdgcn_mfma_f32_16x16x32_bf16((a), (b), (c), 0, 0, 0)
#define WG_BAR() do { asm volatile("s_waitcnt vmcnt(0) lgkmcnt(0)" ::: "memory"); __builtin_amdgcn_s_barrier(); asm volatile("" ::: "memory"); } while (0)
#define LDS_BAR() do { asm volatile("s_waitcnt lgkmcnt(0)" ::: "memory"); __builtin_amdgcn_s_barrier(); asm volatile("" ::: "memory"); } while (0)
constexpr float LOG2E = 1.4426950408889634f;

constexpr int SWA_STR = 144, SWA_IMG = 272 * SWA_STR;
__device__ __forceinline__ void swa_phase(Frame& F) {
    const bf16* P1 = (const bf16*)(F.ws + WS_P1); bf16* ACAT = (bf16*)(F.ws + WS_ACAT);
    LAS unsigned char* Kimg = F.lds; LAS unsigned char* Vimg = F.lds + SWA_IMG;
    const int lane = F.lane, w = F.wave, q = lane & 15, g = lane >> 4;
    for (int u = F.vcu; u < 256; u += F.G) {
        const int b = u >> 5, kvh = (u >> 4) & 1, n = u & 15;
        for (int pc = F.tid; pc < 2 * 272 * 8; pc += 512) {
            const int img = pc >= 272 * 8 ? 1 : 0, p2 = pc - img * 272 * 8, row = p2 >> 3, ch = p2 & 7; const int s = (n - 1) * 128 + row;
            v4u v = (v4u){0u, 0u, 0u, 0u};
            if (row < 256 && s >= 0) v = *(const GAS v4u*)(P1 + (size_t)(b * SEQ + s) * P1C + (img ? C_V : C_K) + kvh * 64 + ch * 8);
            *(LAS v4u*)((img ? Vimg : Kimg) + row * SWA_STR + ch * 16) = v; }
        WG_BAR();
        const int h = kvh * 8 + w; const float slope2 = exp2f(-0.5f * (float)(h + 1)) * LOG2E, sink2 = F.in[I_SINKS][h] * LOG2E;
        f32x4 bias[9];
#pragma unroll
        for (int j = 0; j < 9; ++j)
#pragma unroll
            for (int r = 0; r < 4; ++r) { const int dist = 128 + q - 16 * j - 4 * g - r; const float bv = -slope2 * (float)dist;
                bias[j][r] = (j == 0) ? (dist < 128 ? bv : -INFINITY) : ((j == 8) ? (dist >= 0 ? bv : -INFINITY) : bv); }
        __builtin_amdgcn_sched_barrier(0);
        bf16x8 qn[2];
#pragma unroll
        for (int ks = 0; ks < 2; ++ks) qn[ks] = *(const GAS bf16x8*)(P1 + (size_t)(b * SEQ + n * 128 + q) * P1C + C_Q + h * 64 + 32 * ks + 8 * g);
        __builtin_amdgcn_sched_barrier(0);
#pragma unroll 1
        for (int i = 0; i < 8; ++i) {
            const int t0 = b * SEQ + n * 128 + 16 * i;
            bf16x8 qf[2]; qf[0] = qn[0]; qf[1] = qn[1];
            { const int tn = i < 7 ? t0 + 16 : t0;
#pragma unroll
              for (int ks = 0; ks < 2; ++ks) qn[ks] = *(const GAS bf16x8*)(P1 + (size_t)(tn + q) * P1C + C_Q + h * 64 + 32 * ks + 8 * g); }
            f32x4 s[10];
#pragma unroll
            for (int j = 0; j < 9; ++j) { s[j] = (f32x4){0.f, 0.f, 0.f, 0.f};
#pragma unroll
                for (int ks = 0; ks < 2; ++ks) { const bf16x8 kf = *(const LAS bf16x8*)(Kimg + (16 * (i + j) + q) * SWA_STR + (32 * ks + 8 * g) * 2); s[j] = MFMA16(kf, qf[ks], s[j]); } }
            s[9] = (f32x4){0.f, 0.f, 0.f, 0.f};
            __builtin_amdgcn_sched_barrier(0);
            float mx = sink2;
#pragma unroll
            for (int j = 0; j < 9; ++j) { const bool dead = (n == 0) && (i + j < 8);
#pragma unroll
                for (int r = 0; r < 4; ++r) { const float v = dead ? -INFINITY : s[j][r] * (0.125f * LOG2E) + bias[j][r]; s[j][r] = v; mx = fmaxf(mx, v); } }
            mx = fmaxf(mx, __shfl_xor(mx, 16)); mx = fmaxf(mx, __shfl_xor(mx, 32));
            float sum = 0.f;
#pragma unroll
            for (int j = 0; j < 9; ++j)
#pragma unroll
                for (int r = 0; r < 4; ++r) { const float p = __builtin_amdgcn_exp2f(s[j][r] - mx); s[j][r] = p; sum += p; }
            sum += __shfl_xor(sum, 16); sum += __shfl_xor(sum, 32); sum += __builtin_amdgcn_exp2f(sink2 - mx);
            const float inv = 1.f / sum;
            __builtin_amdgcn_sched_barrier(0);
            f32x4 o[4];
#pragma unroll
            for (int dt = 0; dt < 4; ++dt) o[dt] = (f32x4){0.f, 0.f, 0.f, 0.f};
#pragma unroll
            for (int kk = 0; kk < 5; ++kk) { const bf16x8 pf = pack8(s[2 * kk], s[2 * kk + 1]);
                const LAS unsigned char* vb = Vimg + (16 * (i + 2 * kk) + 4 * g + (q >> 2)) * SWA_STR + (4 * (q & 3)) * 2;
#pragma unroll
                for (int dt = 0; dt < 4; ++dt) { const bf16x8 vf = cat8(tr_read(vb + dt * 32), tr_read(vb + dt * 32 + 16 * SWA_STR)); o[dt] = MFMA16(vf, pf, o[dt]); } }
#pragma unroll
            for (int dt = 0; dt < 4; ++dt) {
                if (FP8_G2) *(GAS unsigned*)((unsigned char*)ACAT + (size_t)(t0 + q) * 3072 + h * 64 + 16 * dt + 4 * g) = pg8::pk4_fp8(o[dt][0] * inv, o[dt][1] * inv, o[dt][2] * inv, o[dt][3] * inv);
                else { v2u wv; wv.x = cvt_pk_bf16(o[dt][0] * inv, o[dt][1] * inv); wv.y = cvt_pk_bf16(o[dt][2] * inv, o[dt][3] * inv);
                    *(GAS v2u*)(ACAT + (size_t)(t0 + q) * 3072 + h * 64 + 16 * dt + 4 * g) = wv; } }
        }
        LDS_BAR();
    }
}

__device__ __forceinline__ void ssd_tables(Frame& F, int b, int c, int g) {
    const float* DT = (const float*)(F.ws + WS_DT); LAS float* dt_s = (LAS float*)(F.lds + TAB_DT); LAS float* ac_s = (LAS float*)(F.lds + TAB_ACUM);
    const int hh = F.wave, h = 8 * g + hh, lane = F.lane; const float A = -expf(F.in[I_ALOG][h]) * LOG2E, dtb = F.in[I_DTB][h];
    const int tok = b * SEQ + c * 128 + 2 * lane;
    float d0 = DT[(size_t)tok * 32 + h] + dtb, d1 = DT[(size_t)(tok + 1) * 32 + h] + dtb;
    d0 = d0 > 20.f ? d0 : 0.6931471805599453f * __builtin_amdgcn_logf(1.f + __builtin_amdgcn_exp2f(d0 * LOG2E)); d1 = d1 > 20.f ? d1 : 0.6931471805599453f * __builtin_amdgcn_logf(1.f + __builtin_amdgcn_exp2f(d1 * LOG2E));
    const float a0 = d0 * A, a1 = d1 * A; float run = a0 + a1;
#pragma unroll
    for (int o = 1; o < 64; o <<= 1) { const float t = __shfl_up(run, o); if (lane >= o) run += t; }
    dt_s[hh * 128 + 2 * lane] = d0; dt_s[hh * 128 + 2 * lane + 1] = d1; ac_s[hh * 128 + 2 * lane] = run - a1; ac_s[hh * 128 + 2 * lane + 1] = run;
}
template <int NR>
__device__ __forceinline__ void conv_load(const bf16* P1, int b, int s0, int c0, v4u (&x)[NR + 3]) {
    const bf16* base = P1 + (size_t)(b * SEQ) * P1C + C_X + c0;
#pragma unroll
    for (int i = 0; i < NR + 3; ++i) { const int ss = s0 - 3 + i; x[i] = (v4u){0u, 0u, 0u, 0u}; if (ss >= 0) x[i] = *(const GAS v4u*)(base + (size_t)ss * P1C); }
}
template <int NR, class Emit>
__device__ __forceinline__ void conv_apply(const v4u (&x)[NR + 3], const float* cw, const float* cb, int c0, Emit&& emit) {
    float wt[4][8], bs[8];
    { const f32x4 b0 = *(const f32x4*)(cb + c0), b1 = *(const f32x4*)(cb + c0 + 4); bs[0] = b0[0]; bs[1] = b0[1]; bs[2] = b0[2]; bs[3] = b0[3]; bs[4] = b1[0]; bs[5] = b1[1]; bs[6] = b1[2]; bs[7] = b1[3]; }
#pragma unroll
    for (int j = 0; j < 4; ++j) { const f32x4 w0 = *(const f32x4*)(cw + j * 3072 + c0), w1 = *(const f32x4*)(cw + j * 3072 + c0 + 4);
        wt[j][0] = w0[0]; wt[j][1] = w0[1]; wt[j][2] = w0[2]; wt[j][3] = w0[3]; wt[j][4] = w1[0]; wt[j][5] = w1[1]; wt[j][6] = w1[2]; wt[j][7] = w1[3]; }
#pragma unroll
    for (int r = 0; r < NR; ++r) { float a[8];
#pragma unroll
        for (int k = 0; k < 8; ++k) a[k] = bs[k];
#pragma unroll
        for (int j = 0; j < 4; ++j) { const v4u xv = x[r + j];
            a[0] += wt[j][0] * bflo(xv.x); a[1] += wt[j][1] * bfhi(xv.x); a[2] += wt[j][2] * bflo(xv.y); a[3] += wt[j][3] * bfhi(xv.y); a[4] += wt[j][4] * bflo(xv.z); a[5] += wt[j][5] * bfhi(xv.z); a[6] += wt[j][6] * bflo(xv.w); a[7] += wt[j][7] * bfhi(xv.w); }
#pragma unroll
        for (int k = 0; k < 8; ++k) a[k] = a[k] * pg8::fsigmoid(a[k]);
        emit(r, a); }
}
template <int NR, class Emit>
__device__ __forceinline__ void conv_rows(const bf16* P1, const float* cw, const float* cb, int b, int s0, int c0, Emit&& emit) {
    v4u x[NR + 3]; conv_load<NR>(P1, b, s0, c0, x); conv_apply<NR>(x, cw, cb, c0, emit);
}
__device__ __forceinline__ v4u pack8u(const float (&v)[8], float sc) { return (v4u){cvt_pk_bf16(v[0] * sc, v[1] * sc), cvt_pk_bf16(v[2] * sc, v[3] * sc), cvt_pk_bf16(v[4] * sc, v[5] * sc), cvt_pk_bf16(v[6] * sc, v[7] * sc)}; }

constexpr int SB_STR = 272, SX_STR = 528;
__device__ __forceinline__ void ssd_states_phase(Frame& F) {
    const bf16* P1 = (const bf16*)(F.ws + WS_P1); bf16* ST = (bf16*)(F.ws + WS_ST); float* CDEC = (float*)(F.ws + WS_CDEC);
    const float* cw = F.in[I_CONVW]; const float* cb = F.in[I_CONVB];
    LAS unsigned char* Bimg = F.lds; LAS unsigned char* Ximg = F.lds + 128 * SB_STR;
    LAS float* dt_s = (LAS float*)(F.lds + TAB_DT); LAS float* ac_s = (LAS float*)(F.lds + TAB_ACUM);
    const int lane = F.lane, w = F.wave, q = lane & 15, g4 = lane >> 4;
    for (int uk = 0;; ++uk) { int u; if (!ssd_unit(F, uk, u)) break;
        const int b = u >> 6, c = (u >> 2) & 15, g = u & 3;
        if (c == 15) { wdn_late_items2(F, b * 4 + g); continue; }
        ssd_tables(F, b, c, g);
        { const int ch = F.tid & 15, l0 = (F.tid >> 4) * 4;
          conv_rows<4>(P1, cw, cb, b, c * 128 + l0, 2048 + 128 * g + 8 * ch, [&](int r, const float (&v)[8]) { *(LAS v4u*)(Bimg + (l0 + r) * SB_STR + ch * 16) = pack8u(v, 1.f); }); }
        WG_BAR();
        if (F.tid < 8) CDEC[(b * 16 + c) * 32 + 8 * g + F.tid] = __builtin_amdgcn_exp2f(ac_s[F.tid * 128 + 127]);
#pragma unroll 1
        for (int half = 0; half < 2; ++half) {
            { const int ch = F.tid & 31, l0 = (F.tid >> 5) * 8, hh = half * 4 + (ch >> 3); const float aend = ac_s[hh * 128 + 127];
              conv_rows<8>(P1, cw, cb, b, c * 128 + l0, 512 * g + 256 * half + 8 * ch, [&](int r, const float (&v)[8]) {
                  const float sc = dt_s[hh * 128 + l0 + r] * __builtin_amdgcn_exp2f(aend - ac_s[hh * 128 + l0 + r]);
                  *(LAS v4u*)(Ximg + (l0 + r) * SX_STR + ch * 16) = pack8u(v, sc); }); }
            WG_BAR();
            const int hl = w >> 1, nt0 = (w & 1) * 4;
            f32x4 acc[4][4];
#pragma unroll
            for (int a = 0; a < 4; ++a)
#pragma unroll
                for (int p = 0; p < 4; ++p) acc[a][p] = (f32x4){0.f, 0.f, 0.f, 0.f};
#pragma unroll
            for (int ks = 0; ks < 4; ++ks) {
                const int lrow = 32 * ks + 8 * g4 + (q >> 2);
                bf16x8 bf[4], xf[4];
#pragma unroll
                for (int a = 0; a < 4; ++a) { const LAS unsigned char* p = Bimg + lrow * SB_STR + (16 * (nt0 + a) + 4 * (q & 3)) * 2; bf[a] = cat8(tr_read(p), tr_read(p + 4 * SB_STR)); }
#pragma unroll
                for (int p4 = 0; p4 < 4; ++p4) { const LAS unsigned char* p = Ximg + lrow * SX_STR + (64 * hl + 16 * p4 + 4 * (q & 3)) * 2; xf[p4] = cat8(tr_read(p), tr_read(p + 4 * SX_STR)); }
#pragma unroll
                for (int a = 0; a < 4; ++a)
#pragma unroll
                    for (int p4 = 0; p4 < 4; ++p4) acc[a][p4] = MFMA16(bf[a], xf[p4], acc[a][p4]);
            }
            bf16* stp = ST + ((size_t)((b * 16 + c) * 32 + 8 * g + half * 4 + hl)) * 8192;
#pragma unroll
            for (int a = 0; a < 4; ++a)
#pragma unroll
                for (int p4 = 0; p4 < 4; ++p4) { v2u wv; wv.x = cvt_pk_bf16(acc[a][p4][0], acc[a][p4][1]); wv.y = cvt_pk_bf16(acc[a][p4][2], acc[a][p4][3]);
                    *(GAS v2u*)(stp + (16 * p4 + q) * 128 + 16 * (nt0 + a) + 4 * g4) = wv; }
            LDS_BAR();
        }
    }
}
__device__ __forceinline__ void ssd_scan_phase(Frame& F) {
    const bf16* ST = (const bf16*)(F.ws + WS_ST); bf16* PREV = (bf16*)(F.ws + WS_PREV); const float* CDEC = (const float*)(F.ws + WS_CDEC);
    int u0 = 0, u1 = 0; const bool h0 = ssd_unit(F, 0, u0), h1 = ssd_unit(F, 1, u1) && F.G == 256;
    if (h0 && h1) {
        const int ita = u0 * 512 + F.tid, itb = u1 * 512 + F.tid;
        const int ba = ita >> 15, ha = (ita >> 10) & 31, bb = itb >> 15, hb = (itb >> 10) & 31;
        v4u sa[15], sb[15]; float da[15], db[15];
#pragma unroll
        for (int c = 0; c < 15; ++c) { sa[c] = *(const GAS v4u*)(ST + ((size_t)((ba * 16 + c) * 32 + ha)) * 8192 + (ita & 1023) * 8); da[c] = CDEC[(ba * 16 + c) * 32 + ha]; }
#pragma unroll
        for (int c = 0; c < 15; ++c) { sb[c] = *(const GAS v4u*)(ST + ((size_t)((bb * 16 + c) * 32 + hb)) * 8192 + (itb & 1023) * 8); db[c] = CDEC[(bb * 16 + c) * 32 + hb]; }
        asm volatile("" ::: "memory");
#pragma unroll
        for (int pass = 0; pass < 2; ++pass) { float carry[8];
#pragma unroll
            for (int k = 0; k < 8; ++k) carry[k] = 0.f;
            const int bq = pass ? bb : ba, hq = pass ? hb : ha, eq = pass ? (itb & 1023) : (ita & 1023);
#pragma unroll
            for (int c = 0; c < 16; ++c) { const size_t off = ((size_t)((bq * 16 + c) * 32 + hq)) * 8192 + eq * 8;
                *(GAS v4u*)(PREV + off) = (v4u){cvt_pk_bf16(carry[0], carry[1]), cvt_pk_bf16(carry[2], carry[3]), cvt_pk_bf16(carry[4], carry[5]), cvt_pk_bf16(carry[6], carry[7])};
                if (c < 15) { const float dec = pass ? db[c] : da[c]; const v4u s = pass ? sb[c] : sa[c];
                    carry[0] = carry[0] * dec + bflo(s.x); carry[1] = carry[1] * dec + bfhi(s.x); carry[2] = carry[2] * dec + bflo(s.y); carry[3] = carry[3] * dec + bfhi(s.y);
                    carry[4] = carry[4] * dec + bflo(s.z); carry[5] = carry[5] * dec + bfhi(s.z); carry[6] = carry[6] * dec + bflo(s.w); carry[7] = carry[7] * dec + bfhi(s.w); } } }
        return;
    }
    for (int uk = 0;; ++uk) { int u; if (!ssd_unit(F, uk, u)) break; const int it = u * 512 + F.tid;
        const int b = it >> 15, h = (it >> 10) & 31, e8 = it & 1023; float carry[8];
        v4u sv[15]; float dv[15];
#pragma unroll
        for (int c = 0; c < 15; ++c) { sv[c] = *(const GAS v4u*)(ST + ((size_t)((b * 16 + c) * 32 + h)) * 8192 + e8 * 8); dv[c] = CDEC[(b * 16 + c) * 32 + h]; }
        asm volatile("" ::: "memory");
#pragma unroll
        for (int k = 0; k < 8; ++k) carry[k] = 0.f;
#pragma unroll
        for (int c = 0; c < 16; ++c) { const size_t off = ((size_t)((b * 16 + c) * 32 + h)) * 8192 + e8 * 8;
            *(GAS v4u*)(PREV + off) = (v4u){cvt_pk_bf16(carry[0], carry[1]), cvt_pk_bf16(carry[2], carry[3]), cvt_pk_bf16(carry[4], carry[5]), cvt_pk_bf16(carry[6], carry[7])};
            if (c < 15) { const float dec = dv[c]; const v4u s = sv[c];
                carry[0] = carry[0] * dec + bflo(s.x); carry[1] = carry[1] * dec + bfhi(s.x); carry[2] = carry[2] * dec + bflo(s.y); carry[3] = carry[3] * dec + bfhi(s.y);
                carry[4] = carry[4] * dec + bflo(s.z); carry[5] = carry[5] * dec + bfhi(s.z); carry[6] = carry[6] * dec + bflo(s.w); carry[7] = carry[7] * dec + bfhi(s.w); } }
    }
}
constexpr int SXF_STR = 1040;
__device__ __forceinline__ void ssd_out_phase(Frame& F) {
    const bf16* P1 = (const bf16*)(F.ws + WS_P1); const bf16* PREV = (const bf16*)(F.ws + WS_PREV); bf16* ACAT = (bf16*)(F.ws + WS_ACAT);
    const float* cw = F.in[I_CONVW]; const float* cb = F.in[I_CONVB];
    LAS unsigned char* Bimg = F.lds; LAS unsigned char* Cimg = F.lds + 128 * SB_STR; LAS unsigned char* Ximg = F.lds;
    LAS float* dt_s = (LAS float*)(F.lds + TAB_DT); LAS float* ac_s = (LAS float*)(F.lds + TAB_ACUM);
    const int lane = F.lane, w = F.wave, q = lane & 15, g4 = lane >> 4;
    for (int uk = 0;; ++uk) { int u; if (!ssd_unit(F, uk, u)) break;
        const int b = u >> 6, c = (u >> 2) & 15, g = u & 3;
        ssd_tables(F, b, c, g);
        { const int ch = F.tid & 31, l0 = (F.tid >> 5) * 8; LAS unsigned char* img = ch >= 16 ? Cimg : Bimg;
          conv_rows<8>(P1, cw, cb, b, c * 128 + l0, 2048 + (ch >= 16 ? 512 : 0) + 128 * g + 8 * (ch & 15), [&](int r, const float (&v)[8]) { *(LAS v4u*)(img + (l0 + r) * SB_STR + (ch & 15) * 16) = pack8u(v, 1.f); }); }
        const int lq = 16 * w + q; const int tok = b * SEQ + c * 128 + lq;
        const bf16* pvu = PREV + ((size_t)((b * 16 + c) * 32 + 8 * g)) * 8192;
        const bf16* zb = P1 + (size_t)tok * P1C + C_Z + 512 * g + 4 * g4;
        asm volatile("s_waitcnt lgkmcnt(0)" ::: "memory"); __builtin_amdgcn_s_barrier(); asm volatile("" ::: "memory");
        bf16x8 cfr[4];
#pragma unroll
        for (int ks = 0; ks < 4; ++ks) cfr[ks] = *(const LAS bf16x8*)(Cimg + (16 * w + q) * SB_STR + (32 * ks + 8 * g4) * 2);
        f32x4 cbt[8];
#pragma unroll
        for (int st = 0; st < 8; ++st) { cbt[st] = (f32x4){0.f, 0.f, 0.f, 0.f};
            if (st <= w) {
#pragma unroll
                for (int ks = 0; ks < 4; ++ks) { const bf16x8 bfr = *(const LAS bf16x8*)(Bimg + (16 * st + q) * SB_STR + (32 * ks + 8 * g4) * 2); cbt[st] = MFMA16(bfr, cfr[ks], cbt[st]); } } }
        v2u zc[4];
#pragma unroll
        for (int p4 = 0; p4 < 4; ++p4) zc[p4] = *(const GAS v2u*)(zb + 16 * p4);
        float ssq = 0.f; float Dh = F.in[I_DSKIP][8 * g];
        LAS unsigned char* PrevL = F.lds + 128 * SX_STR;
#pragma unroll 1
        for (int half = 0; half < 2; ++half) {
            int tl = F.tid; asm volatile("" : "+v"(tl));
            const int xch = tl & 31, xl0 = (tl >> 5) * 8;
            v4u pv[8];
#pragma unroll
            for (int i = 0; i < 8; ++i) { const int id = tl + 512 * i; pv[i] = *(const GAS v4u*)(pvu + (size_t)(4 * half + (id >> 10)) * 8192 + (id & 1023) * 8); }
            v4u x0[11]; conv_load<8>(P1, b, c * 128 + xl0, 512 * g + 256 * half + 8 * xch, x0);
            asm volatile("s_waitcnt lgkmcnt(0)" ::: "memory"); __builtin_amdgcn_s_barrier(); asm volatile("" ::: "memory");
            conv_apply<8>(x0, cw, cb, 512 * g + 256 * half + 8 * xch, [&](int r, const float (&v)[8]) { *(LAS v4u*)(Ximg + (xl0 + r) * SX_STR + xch * 16) = pack8u(v, 1.f); });
#pragma unroll
            for (int i = 0; i < 8; ++i) { const int id = tl + 512 * i; *(LAS v4u*)(PrevL + (id >> 10) * (64 * SB_STR) + ((id & 1023) >> 4) * SB_STR + (id & 15) * 16) = pv[i]; }
            asm volatile("s_waitcnt lgkmcnt(0)" ::: "memory"); __builtin_amdgcn_s_barrier(); asm volatile("" ::: "memory");
#pragma unroll 1
            for (int hl = 0; hl < 4; ++hl) {
                const int hh = 4 * half + hl; const float al = ac_s[hh * 128 + lq];
                const int hn = hh < 7 ? hh + 1 : 7;
                v2u zn[4];
#pragma unroll
                for (int p4 = 0; p4 < 4; ++p4) zn[p4] = *(const GAS v2u*)(zb + 64 * hn + 16 * p4);
                const float Dn = F.in[I_DSKIP][8 * g + hn];
                f32x4 y[4];
#pragma unroll
                for (int p4 = 0; p4 < 4; ++p4) y[p4] = (f32x4){0.f, 0.f, 0.f, 0.f};
                const LAS unsigned char* pl = PrevL + hl * (64 * SB_STR) + q * SB_STR + 16 * g4;
#pragma unroll
                for (int ks = 0; ks < 4; ++ks) { bf16x8 pf[4];
#pragma unroll
                    for (int p4 = 0; p4 < 4; ++p4) pf[p4] = *(const LAS bf16x8*)(pl + (16 * p4) * SB_STR + 64 * ks);
#pragma unroll
                    for (int p4 = 0; p4 < 4; ++p4) y[p4] = MFMA16(pf[p4], cfr[ks], y[p4]); }
                const float ea = __builtin_amdgcn_exp2f(al);
#pragma unroll
                for (int p4 = 0; p4 < 4; ++p4) y[p4] *= ea;
#pragma unroll
                for (int kk = 0; kk < 4; ++kk) {
                    if (2 * kk <= w) {
                        f32x4 m0, m1;
                        { const int st = 2 * kk; const f32x4 as = *(const LAS f32x4*)(ac_s + hh * 128 + 16 * st + 4 * g4), ds = *(const LAS f32x4*)(dt_s + hh * 128 + 16 * st + 4 * g4);
#pragma unroll
                            for (int r = 0; r < 4; ++r) { const int s = 16 * st + 4 * g4 + r; m0[r] = s <= lq ? cbt[st][r] * __builtin_amdgcn_exp2f(al - as[r]) * ds[r] : 0.f; } }
                        { const int st = 2 * kk + 1; const f32x4 as = *(const LAS f32x4*)(ac_s + hh * 128 + 16 * st + 4 * g4), ds = *(const LAS f32x4*)(dt_s + hh * 128 + 16 * st + 4 * g4);
#pragma unroll
                            for (int r = 0; r < 4; ++r) { const int s = 16 * st + 4 * g4 + r; m1[r] = (st <= w && s <= lq) ? cbt[st][r] * __builtin_amdgcn_exp2f(al - as[r]) * ds[r] : 0.f; } }
                        const bf16x8 mf = pack8(m0, m1);
                        const LAS unsigned char* xb = Ximg + (32 * kk + 4 * g4 + (q >> 2)) * SX_STR + (64 * hl + 4 * (q & 3)) * 2;
#pragma unroll
                        for (int p4 = 0; p4 < 4; ++p4) { const bf16x8 xf = cat8(tr_read(xb + p4 * 32), tr_read(xb + p4 * 32 + 16 * SX_STR)); y[p4] = MFMA16(xf, mf, y[p4]); }
                    }
                }
#pragma unroll
                for (int p4 = 0; p4 < 4; ++p4) { const int ch = 64 * hh + 16 * p4 + 4 * g4;
                    const v2u xv = *(const LAS v2u*)(Ximg + lq * SX_STR + (64 * hl + 16 * p4 + 4 * g4) * 2); const v2u zv = zc[p4];
                    const float v0 = (y[p4][0] + bflo(xv.x) * Dh) * bflo(zv.x), v1 = (y[p4][1] + bfhi(xv.x) * Dh) * bfhi(zv.x), v2 = (y[p4][2] + bflo(xv.y) * Dh) * bflo(zv.y), v3 = (y[p4][3] + bfhi(xv.y) * Dh) * bfhi(zv.y);
                    ssq += (v0 * v0 + v1 * v1) + (v2 * v2 + v3 * v3);
                    if (FP8_G2) *(GAS unsigned*)((unsigned char*)ACAT + (size_t)tok * 3072 + 1024 + 512 * g + ch) = pg8::pk4_fp8(v0, v1, v2, v3);
                    else { v2u o; o.x = cvt_pk_bf16(v0, v1); o.y = cvt_pk_bf16(v2, v3);
                        *(GAS v2u*)(ACAT + (size_t)tok * 3072 + 1024 + 512 * g + ch) = o; } }
#pragma unroll
                for (int p4 = 0; p4 < 4; ++p4) zc[p4] = zn[p4];
                Dh = Dn;
            }
        }
        ssq += __shfl_xor(ssq, 16); ssq += __shfl_xor(ssq, 32);
        if (g4 == 0) ((float*)(F.ws + WS_SSQG))[(size_t)tok * 4 + g] = ssq;
        LDS_BAR();
    }
}

constexpr int CX_STR = 528;
__device__ __forceinline__ void cross_units(Frame& F, int u_begin, int u_end, int u_step) {
    const bf16* QC = (const bf16*)(F.ws + WS_QC); const bf16* KVC = (const bf16*)(F.ws + WS_KVC); bf16* OC = (bf16*)(F.ws + WS_OC);
    LAS unsigned char* img = F.lds; const int lane = F.lane, w = F.wave, q = lane & 15, g = lane >> 4;
    for (int u = u_begin; u + 1 < u_end; u += 2) {
        const int b = u >> 6, hd = (u >> 4) & 3, qb = u & 15; const int t0 = b * SEQ + qb * 128 + 16 * w;
#pragma unroll 1
        for (int pb = 0; pb < 2; ++pb) { v4u tmp[8];
#pragma unroll
            for (int i = 0; i < 8; ++i) { const int pc = F.tid + 512 * (pb * 8 + i), row = pc >> 5, ch = pc & 31; tmp[i] = *(const GAS v4u*)(KVC + (size_t)(b * 256 + row) * 2048 + hd * 256 + ch * 8); }
#pragma unroll
            for (int i = 0; i < 8; ++i) { const int pc = F.tid + 512 * (pb * 8 + i), row = pc >> 5, ch = pc & 31; *(LAS v4u*)(img + row * CX_STR + ch * 16) = tmp[i]; } }
        bf16x8 qf[2][8];
#pragma unroll
        for (int ks = 0; ks < 8; ++ks) qf[0][ks] = *(const GAS bf16x8*)(QC + (size_t)(t0 + q) * 1024 + hd * 256 + 32 * ks + 8 * g);
        WG_BAR();
        bf16x8 pf[2][8]; float inv[2];
#pragma unroll
        for (int U = 0; U < 2; ++U) {
            f32x4 s[16];
#pragma unroll
            for (int kt = 0; kt < 16; ++kt) { s[kt] = (f32x4){0.f, 0.f, 0.f, 0.f};
#pragma unroll
                for (int ks = 0; ks < 8; ++ks) { const bf16x8 kf = *(const LAS bf16x8*)(img + (16 * kt + q) * CX_STR + (32 * ks + 8 * g) * 2); s[kt] = MFMA16(kf, qf[U][ks], s[kt]); } }
            if (U == 0) {
#pragma unroll
                for (int ks = 0; ks < 8; ++ks) qf[1][ks] = *(const GAS bf16x8*)(QC + (size_t)(t0 + 128 + q) * 1024 + hd * 256 + 32 * ks + 8 * g); }
            float mx = -INFINITY;
#pragma unroll
            for (int kt = 0; kt < 16; ++kt)
#pragma unroll
                for (int r = 0; r < 4; ++r) { s[kt][r] *= 0.0625f * LOG2E; mx = fmaxf(mx, s[kt][r]); }
            mx = fmaxf(mx, __shfl_xor(mx, 16)); mx = fmaxf(mx, __shfl_xor(mx, 32));
            float sum = 0.f;
#pragma unroll
            for (int kt = 0; kt < 16; ++kt)
#pragma unroll
                for (int r = 0; r < 4; ++r) { const float p = __builtin_amdgcn_exp2f(s[kt][r] - mx); s[kt][r] = p; sum += p; }
            sum += __shfl_xor(sum, 16); sum += __shfl_xor(sum, 32);
            inv[U] = 1.f / sum;
#pragma unroll
            for (int kk = 0; kk < 8; ++kk) pf[U][kk] = pack8(s[2 * kk], s[2 * kk + 1]);
            asm volatile("" ::: "memory");
        }
        WG_BAR();
#pragma unroll 1
        for (int pb = 0; pb < 2; ++pb) { v4u tmp[8];
#pragma unroll
            for (int i = 0; i < 8; ++i) { const int pc = F.tid + 512 * (pb * 8 + i), row = pc >> 5, ch = pc & 31; tmp[i] = *(const GAS v4u*)(KVC + (size_t)(b * 256 + row) * 2048 + 1024 + hd * 256 + ch * 8); }
#pragma unroll
            for (int i = 0; i < 8; ++i) { const int pc = F.tid + 512 * (pb * 8 + i), row = pc >> 5, ch = pc & 31; *(LAS v4u*)(img + row * CX_STR + ch * 16) = tmp[i]; } }
        WG_BAR();
#pragma unroll
        for (int U = 0; U < 2; ++U) {
#pragma unroll 1
            for (int dh = 0; dh < 2; ++dh) {
                f32x4 o[8];
#pragma unroll
                for (int d = 0; d < 8; ++d) o[d] = (f32x4){0.f, 0.f, 0.f, 0.f};
#pragma unroll
                for (int kk = 0; kk < 8; ++kk) { const LAS unsigned char* vb = img + (32 * kk + 4 * g + (q >> 2)) * CX_STR + (128 * dh + 4 * (q & 3)) * 2;
#pragma unroll
                    for (int d = 0; d < 8; ++d) { const bf16x8 vf = cat8(tr_read(vb + d * 32), tr_read(vb + d * 32 + 16 * CX_STR)); o[d] = MFMA16(vf, pf[U][kk], o[d]); } }
                const float iv = inv[U];
#pragma unroll
                for (int d = 0; d < 8; ++d) {
                    if (FP8_G6) *(GAS unsigned*)((unsigned char*)OC + (size_t)(t0 + 128 * U + q) * 1024 + hd * 256 + 128 * dh + 16 * d + 4 * g) = pg8::pk4_fp8(o[d][0] * iv, o[d][1] * iv, o[d][2] * iv, o[d][3] * iv);
                    else { v2u wv; wv.x = cvt_pk_bf16(o[d][0] * iv, o[d][1] * iv); wv.y = cvt_pk_bf16(o[d][2] * iv, o[d][3] * iv);
                        *(GAS v2u*)(OC + (size_t)(t0 + 128 * U + q) * 1024 + hd * 256 + 128 * dh + 16 * d + 4 * g) = wv; } }
            }
        }
        LDS_BAR();
    }
}

__device__ __forceinline__ void router_phase(Frame& F) {
    const bf16* T = (const bf16*)(F.ws + WS_H2); const bf16* WR        = (const bf16*)(F.ws + WS_WR); const float* ssq = (const float*)(F.ws + WS_SSQ2);
    int* tok_e = (int*)(F.ws + WS_TOKE); int* tok_p = (int*)(F.ws + WS_TOKP); float* tok_w = (float*)(F.ws + WS_TOKW); int* rowmap = (int*)(F.ws + WS_ROWMAP);
    LAS int* hist = (LAS int*)(F.lds + TAB_TE); LAS int* base = hist + 32;
    const int lane = F.lane, q = lane & 15, g = lane >> 4;
    constexpr int WR_STR = 2064;
    { v4u t[8];
#pragma unroll
      for (int i = 0; i < 8; ++i) { const int pc = F.tid + 512 * i; t[i] = *(const GAS v4u*)(WR + (size_t)(pc >> 7) * 1024 + (pc & 127) * 8); }
#pragma unroll
      for (int i = 0; i < 8; ++i) { const int pc = F.tid + 512 * i; *(LAS v4u*)(F.lds + (pc >> 7) * WR_STR + (pc & 127) * 16) = t[i]; } }
    for (int tb = F.vcu; tb * 4 < M_TOK / 16; tb += F.G) {
        if (F.tid < 32) hist[F.tid] = 0;
        LDS_WAIT(); __syncthreads();
        const int tile = tb * 4 + F.wave; const bool live = F.wave < 4;
        int ei[4] = {0, 0, 0, 0}, lp[4] = {0, 0, 0, 0}; float wv[4] = {0.f, 0.f, 0.f, 0.f}; float rs = 0.f; const int t0 = tile * 16;
        if (live) {
            f32x4 a0 = (f32x4){0.f, 0.f, 0.f, 0.f}, a1 = a0;
            bf16x8 tf[32];
#pragma unroll
            for (int ks = 0; ks < 32; ++ks) tf[ks] = *(const GAS bf16x8*)(T + (size_t)(t0 + q) * 1024 + 32 * ks + 8 * g);
#pragma unroll
            for (int ks = 0; ks < 32; ++ks) { const bf16x8 w0 = *(const LAS bf16x8*)(F.lds + q * WR_STR + (32 * ks + 8 * g) * 2), w1 = *(const LAS bf16x8*)(F.lds + (16 + q) * WR_STR + (32 * ks + 8 * g) * 2);
                a0 = MFMA16(w0, tf[ks], a0); a1 = MFMA16(w1, tf[ks], a1); }
            rs = pg8::row_rstd(ssq, t0 + q); const float* br = F.in[I_BR];
            float lv[8];
#pragma unroll
            for (int r = 0; r < 4; ++r) { lv[r] = a0[r] * rs + br[4 * g + r]; lv[4 + r] = a1[r] * rs + br[16 + 4 * g + r]; }
            float ev[4];
#pragma unroll
            for (int k = 0; k < 4; ++k) {
                float bv = -INFINITY; int bi = 0;
#pragma unroll
                for (int r = 0; r < 8; ++r) { const int e = (r < 4 ? 0 : 16) + 4 * g + (r & 3); if (lv[r] > bv) { bv = lv[r]; bi = e; } }
#pragma unroll
                for (int o = 16; o <= 32; o <<= 1) { const float ov = __shfl_xor(bv, o); const int oi = __shfl_xor(bi, o); if (ov > bv || (ov == bv && oi < bi)) { bv = ov; bi = oi; } }
                ei[k] = bi; ev[k] = bv;
#pragma unroll
                for (int r = 0; r < 8; ++r) { const int e = (r < 4 ? 0 : 16) + 4 * g + (r & 3); if (e == bi) lv[r] = -INFINITY; }
            }
            float sum = 0.f;
#pragma unroll
            for (int k = 0; k < 4; ++k) { wv[k] = expf(ev[k] - ev[0]); sum += wv[k]; }
            const float inv = 1.f / sum;
#pragma unroll
            for (int k = 0; k < 4; ++k) wv[k] *= inv;
            if (g == 0) {
#pragma unroll
                for (int k = 0; k < 4; ++k) lp[k] = __hip_atomic_fetch_add(hist + ei[k], 1, __ATOMIC_RELAXED, __HIP_MEMORY_SCOPE_WORKGROUP); }
        }
        __syncthreads();
        if (F.tid < 32) { const int hcnt = hist[F.tid]; base[F.tid] = hcnt > 0 ? (int)__hip_atomic_fetch_add((unsigned*)(F.ctl + CW_CNT + 64 * F.tid), (unsigned)hcnt, RLX_AGENT) : 0; }
        __syncthreads();
        if (live && g == 0) { const int tok = t0 + q;
#pragma unroll
            for (int k = 0; k < 4; ++k) { const int pos = base[ei[k]] + lp[k];
                *(int2*)(rowmap + 2 * (ei[k] * 16384 + pos)) = make_int2(tok, __float_as_int(rs)); tok_e[tok * 4 + k] = ei[k]; tok_p[tok * 4 + k] = pos; tok_w[tok * 4 + k] = wv[k]; } }
        __syncthreads();
    }
}
__device__ __forceinline__ int moe_tables(Frame& F) {
    LAS int* tile_e = (LAS int*)(F.lds + TAB_TE); LAS int* tile_p0 = (LAS int*)(F.lds + TAB_TP0); LAS int* cnt_s = (LAS int*)(F.lds + TAB_CNT); LAS int* tb = (LAS int*)(F.lds + TAB_TB); LAS int* ntp = (LAS int*)(F.lds + TAB_NT);
    __syncthreads();
    if (F.tid < 64) {
        const int e = F.tid; const int cn = e < 32 ? (int)__hip_atomic_load((unsigned*)(F.ctl + CW_CNT + 64 * (e & 31)), RLX_AGENT) : 0;
        const int nt = (cn + 255) >> 8; int incl = nt;
#pragma unroll
        for (int o = 1; o < 32; o <<= 1) { const int t = __shfl_up(incl, o); if ((e & 31) >= o) incl += t; }
        const int base = incl - nt;
        if (e < 32) { cnt_s[e] = cn; tb[e] = base; for (int k = 0; k < nt; ++k) { const int j = base + k; if (j < 320) { tile_e[j] = e; tile_p0[j] = 256 * k; } } }
        if (e == 31) ntp[0] = incl < 320 ? incl : 320;
    }
    __syncthreads();
    return ntp[0];
}
__device__ __forceinline__ void combine_phase(Frame& F) {
    const bf16* H2 = (const bf16*)(F.ws + WS_H2); const unsigned char* Y = (const unsigned char*)(F.ws + WS_Y);
    const int* tok_e = (const int*)(F.ws + WS_TOKE); const int* tok_p = (const int*)(F.ws + WS_TOKP); const float* tok_w = (const float*)(F.ws + WS_TOKW);
    LAS int* tb = (LAS int*)(F.lds + TAB_TB); const float* fw = F.in[I_FNW];
    const int lane = F.lane; const int gw = F.vcu * NWAVES + F.wave, NGW = F.G * NWAVES;
    constexpr int NT = 4;
    int ne[NT][4], np[NT][4]; float nw[NT][4];
#pragma unroll
    for (int t = 0; t < NT; ++t)
#pragma unroll
        for (int k = 0; k < 4; ++k) { const int tok = min(NT * gw + t, M_TOK - 1); ne[t][k] = tok_e[tok * 4 + k]; np[t][k] = tok_p[tok * 4 + k]; nw[t][k] = tok_w[tok * 4 + k]; }
    for (int tok0 = NT * gw; tok0 < M_TOK; tok0 += NT * NGW) {
        f32x4 v[NT][4]; size_t slot[NT][4]; float wk[NT][4];
#pragma unroll
        for (int t = 0; t < NT; ++t)
#pragma unroll
            for (int k = 0; k < 4; ++k) { slot[t][k] = (size_t)tb[ne[t][k]] * 256 + np[t][k]; wk[t][k] = nw[t][k]; }
#pragma unroll
        for (int t = 0; t < NT; ++t)
#pragma unroll
            for (int k = 0; k < 4; ++k) { const int tok = min(tok0 + NT * NGW + t, M_TOK - 1); ne[t][k] = tok_e[tok * 4 + k]; np[t][k] = tok_p[tok * 4 + k]; nw[t][k] = tok_w[tok * 4 + k]; }
        v2u hv[NT][4]; unsigned y[NT][4][4];
#pragma unroll
        for (int t = 0; t < NT; ++t)
#pragma unroll
            for (int j = 0; j < 4; ++j) hv[t][j] = *(const GAS v2u*)(H2 + (size_t)(tok0 + t) * 1024 + 4 * lane + 256 * j);
#pragma unroll
        for (int t = 0; t < NT; ++t)
#pragma unroll
            for (int k = 0; k < 4; ++k)
#pragma unroll
                for (int j = 0; j < 4; ++j) y[t][k][j] = *(const GAS unsigned*)(Y + slot[t][k] * 1024 + 4 * lane + 256 * j);
#pragma unroll
        for (int t = 0; t < NT; ++t) {
#pragma unroll
            for (int j = 0; j < 4; ++j) v[t][j] = (f32x4){bflo(hv[t][j].x), bfhi(hv[t][j].x), bflo(hv[t][j].y), bfhi(hv[t][j].y)};
#pragma unroll
            for (int k = 0; k < 4; ++k)
#pragma unroll
                for (int j = 0; j < 4; ++j) { const f32x2 lo = __builtin_amdgcn_cvt_pk_f32_fp8((int)y[t][k][j], false), hi = __builtin_amdgcn_cvt_pk_f32_fp8((int)y[t][k][j], true);
                    v[t][j][0] += wk[t][k] * lo[0]; v[t][j][1] += wk[t][k] * lo[1]; v[t][j][2] += wk[t][k] * hi[0]; v[t][j][3] += wk[t][k] * hi[1]; } }
#pragma unroll
        for (int t = 0; t < NT; ++t) { float s = 0.f;
#pragma unroll
            for (int j = 0; j < 4; ++j) s += (v[t][j][0] * v[t][j][0] + v[t][j][1] * v[t][j][1]) + (v[t][j][2] * v[t][j][2] + v[t][j][3] * v[t][j][3]);
            const float rstd = 1.f / sqrtf(wave_sum(s) * (1.f / 1024.f) + 1e-5f);
#pragma unroll
            for (int j = 0; j < 4; ++j) { const f32x4 g = *(const f32x4*)(fw + 4 * lane + 256 * j); *(GAS f32x4*)(F.out + (size_t)(tok0 + t) * 1024 + 4 * lane + 256 * j) = v[t][j] * rstd * g; } }
    }
}
#ifndef MK_NPH
#define MK_NPH 14
#endif
struct Args { const float* in[29]; float* out; unsigned char* ws; int ph_lo, ph_hi; };
__global__ void __launch_bounds__(NWAVES * 64, 2) mega_fwd(Args args) {
    extern __shared__ __attribute__((aligned(16))) unsigned char lds_raw[];
    Frame F;
    F.lds = (LAS unsigned char*)lds_raw;
    F.tid = threadIdx.x; F.lane = F.tid & 63; F.wave = __builtin_amdgcn_readfirstlane(F.tid >> 6);
    F.G = gridDim.x; { const int bx = blockIdx.x; F.vcu = (F.G % 8 == 0) ? (bx % 8) * (F.G / 8) + bx / 8 : bx; }
    F.ws = args.ws; F.ctl = (gu32*)(args.ws + WS_CTL); F.out = args.out;
    F.in = (const __attribute__((address_space(4))) fptr_t*)__builtin_amdgcn_kernarg_segment_ptr();
    for (int u = F.tid; u < (LDS_BYTES - TAB_OFF) / 4; u += NWAVES * 64) ((LAS unsigned*)(F.lds + TAB_OFF))[u] = 0u;
    __syncthreads();
    const int lo = args.ph_lo, hi = args.ph_hi;
    XcdBarrier bar; bar.bar = (unsigned*)(F.ctl + CW_BAR); bar.x = 0; bar.st = nullptr;
    if (hi - lo > 1) { bar = xcd_barrier_post((unsigned*)(F.ctl + CW_BAR), (volatile LAS unsigned*)(F.lds + TAB_MISC) + 8);
        if (F.tid == 0) __hip_atomic_store((unsigned*)(F.ctl + CW_XCC) + blockIdx.x, bar.x + 1u, RLX_AGENT); }
#ifndef MK_PHMASK
#define MK_PHMASK 0x3fff
#endif
#define IN(k) (((MK_PHMASK >> (k)) & 1) && lo <= (k) && (k) < hi)
#define RELANE() do { int t_ = F.tid; asm volatile("" : "+v"(t_)); F.lane = t_ & 63; } while (0)
#define SEAM(k) do { if (IN(k) && IN((k) + 1)) xcd_barrier(bar); RELANE(); } while (0)
#define SEAML(k) do { if (IN(k) && IN((k) + 1)) xcd_barrier(bar, fast); RELANE(); } while (0)
#define SEAMP(k, wait_pm, gen) do { if (IN(k) && IN((k) + 1)) { if (fast) panel_barrier((unsigned*)(F.ctl + CW_PB), (unsigned*)(F.ctl + CW_BAR) + XB_TMO, my_pm, (wait_pm), 4u * (gen)); else xcd_barrier(bar, false); } RELANE(); } while (0)
    const int c = (int)blockIdx.x;

    if (IN(0)) { p0_prologue(F); } SEAM(0);
    bool fast = false;
    if (IN(0) && IN(1) && F.G == 256) {
        int ok = 1;
        if (F.tid < 256) { const unsigned mine = __hip_atomic_load((unsigned*)(F.ctl + CW_XCC) + F.tid, RLX_AGENT), cls = __hip_atomic_load((unsigned*)(F.ctl + CW_XCC) + (F.tid & 7), RLX_AGENT); ok = (mine != 0u && mine == cls) ? 1 : 0; }
        fast = __syncthreads_and(ok) != 0;
    }
    int my_pm = 0; { int pn_; (void)pg8::static_deal(0, F.G, c, M_TOK / 256, 4, my_pm, pn_); }
    if (IN(1)) {
        { constexpr int ES = I8_G1 ? 1 : 2; typedef pg8::EpiP1<I8_G1 != 0> EpiT;
          pg8::SchedLin S{M_TOK / 256, N1 / 256, F.G, c, DM, (const bf16*)(F.ws + WS_W1T), DM, ES};
          EpiT E{(bf16*)(F.ws + WS_P1), P1C, (float*)(F.ws + WS_DT), F.in[I_BGATE], (const float*)(F.ws + WS_USC), (const float*)(F.ws + WS_CSC), (LAS float*)(F.lds + TAB_OFF + 8192)};
          const int split = F.G == 256 ? (c / 8 + 3 * (c % 8)) % 9 : 1 << 30;
#pragma unroll 1
          for (int part = 0; part < 2; ++part) {
              S.i_lo = part ? split : 0; S.i_hi = part ? 1 << 30 : split;
              pg8::gemm_phase<EpiT, pg8::SchedLin, true, ES, I8_G1 != 0>(F.lds, (const char*)(F.ws + WS_U), DM, S, E);
              if (part == 0 && F.G == 256) { moe_convert_burst(F); __syncthreads(); }
          } }
        if (I8_G1) { pg8::SchedLin S{NBATCH * 256 / 256, 2048 / 256, F.G, F.G == 256 ? c : (c + 128) % F.G, DM, (const bf16*)(F.ws + WS_WCKV), DM, 1, F.G == 256 ? 1 : 0};
          pg8::EpiI8 E{(bf16*)(F.ws + WS_KVC), 2048, (const float*)(F.ws + WS_MSC), (const float*)(F.ws + WS_KSC), (LAS float*)(F.lds + TAB_OFF + 8192)};
          pg8::gemm_phase<pg8::EpiI8, pg8::SchedLin, true, 1, true>(F.lds, (const char*)(F.ws + WS_MN), DM, S, E); }
        else { pg8::SchedLin S{NBATCH * 256 / 256, 2048 / 256, F.G, (c + 128) % F.G, DM, (const bf16*)(F.ws + WS_WCKV), DM};
          pg8::EpiBf16S E{(bf16*)(F.ws + WS_KVC), 2048, nullptr, 1.f, (LAS float*)(F.lds + TAB_OFF + 8192)};
          pg8::gemm_phase<pg8::EpiBf16S, pg8::SchedLin, true>(F.lds, (const char*)(F.ws + WS_MN), DM, S, E); }
        wdn_late_items(F, c);
    } SEAML(1);
    if (IN(2)) { swa_phase(F); ssd_states_phase(F); } SEAML(2);
    if (IN(3)) { ssd_scan_phase(F); } SEAML(3);
    if (IN(4)) { ssd_out_phase(F); } SEAML(4);
    if (IN(5)) {
        constexpr int ES = FP8_G2 ? 1 : 2; typedef pg8::EpiG2<ES, FP8_G3 != 0> EpiT;
        pg8::SchedLin S{M_TOK / 256, 1024 / 256, F.G, c, 3072, (const bf16*)(F.ws + WS_WCAT), 3072, ES};
        EpiT E{(const bf16*)(F.ws + WS_P1) + C_G, P1C, (void*)(F.ws + WS_MERGED), DM, (const float*)(F.ws + WS_SSQG), FP8_G2 ? 1.f / pg8::W8_SCALE : 1.f, (LAS float*)(F.lds + TAB_OFF + 1024)};
        pg8::gemm_phase<EpiT, pg8::SchedLin, false, ES>(F.lds, (const char*)(F.ws + WS_ACAT), 3072, S, E);
    } SEAMP(5, my_pm, 1);
    if (IN(6)) {
        constexpr int ES = FP8_G3 ? 1 : 2;
        pg8::SchedLin S{M_TOK / 256, 4, F.G, c, DM, (const bf16*)(F.ws + WS_WOUT), DM, ES};
        pg8::EpiRes<false> E{(const void*)F.in[I_X], (bf16*)(F.ws + WS_H1), FP8_G4 ? nullptr : (bf16*)(F.ws + WS_HB), F.in[I_NCW], (float*)(F.ws + WS_SSQ1), FP8_G4 ? (unsigned char*)(F.ws + WS_HB) : nullptr, FP8_G3 ? 1.f / pg8::W8_SCALE : 1.f, (LAS float*)(F.lds + TAB_OFF + 8192)};
        pg8::gemm_phase<pg8::EpiRes<false>, pg8::SchedLin, false, ES>(F.lds, (const char*)(F.ws + WS_MERGED), DM, S, E);
    } SEAMP(6, my_pm, 2);
    if (IN(7)) {
        constexpr int ES = FP8_G4 ? 1 : 2;
        pg8::SchedLin S{M_TOK / 256, 4, F.G, c, DM, (const bf16*)(F.ws + WS_WCQ), DM, ES};
        pg8::EpiBf16S E{(bf16*)(F.ws + WS_QC), DM, (const float*)(F.ws + WS_SSQ1), FP8_G4 ? 1.f / pg8::W8_SCALE : 1.f, (LAS float*)(F.lds + TAB_OFF + 8192)};
        pg8::gemm_phase<pg8::EpiBf16S, pg8::SchedLin, false, ES>(F.lds, (const char*)(F.ws + WS_HB), DM, S, E);
        VM_WAIT(); __syncthreads();
        for (int i = 0;; ++i) { int pm, pn; if (!pg8::static_deal(i, F.G, c, M_TOK / 256, 4, pm, pn)) break;
            const int ua = (pm >> 3) * 64 + pn * 16 + 2 * (pm & 7); cross_units(F, ua, ua + 2, 1); }
    } SEAMP(7, my_pm, 3);
    if (IN(9)) {
        constexpr int ES = FP8_G6 ? 1 : 2;
        pg8::SchedLin S{M_TOK / 256, 4, F.G, c, DM, (const bf16*)(F.ws + WS_WCO), DM, ES};
        pg8::EpiRes<true> E{(const void*)(F.ws + WS_H1), (bf16*)(F.ws + WS_H2), nullptr  , F.in[I_NFW], (float*)(F.ws + WS_SSQ2), (unsigned char*)(F.ws + WS_T8), FP8_G6 ? 1.f / pg8::W8_SCALE : 1.f, (LAS float*)(F.lds + TAB_OFF + 8192)};
        pg8::gemm_phase<pg8::EpiRes<true>, pg8::SchedLin, false, ES>(F.lds, (const char*)(F.ws + WS_OC), DM, S, E);
    } SEAMP(9, F.vcu >> 2, 4);
    if (IN(10)) { router_phase(F); } SEAM(10);
    int nt_moe = -1;
    if (IN(11)) {
        const int nt = moe_tables(F); nt_moe = nt;
        pg8::SchedMoe S{nt, 8, F.G, c, DM, (const void*)(F.ws + WS_WGU), DM, (size_t)2048 * 1024, true, 1,
                        (const LAS int*)(F.lds + TAB_TE), (const LAS int*)(F.lds + TAB_TP0), (const LAS int*)(F.lds + TAB_CNT), (const int*)(F.ws + WS_ROWMAP), nullptr, 0u};
        pg8::EpiGU E{(unsigned char*)(F.ws + WS_ACT), F.in[I_BGU], (const int*)(F.ws + WS_ROWMAP), (const LAS int*)(F.lds + TAB_CNT), (LAS float*)(F.lds + TAB_OFF + 8192), (unsigned*)(F.ctl + CW_DEP)};
        pg8::gemm_phase<pg8::EpiGU, pg8::SchedMoe, true, 1>(F.lds, (const char*)(F.ws + WS_T8), DM, S, E);
    }
    if (IN(12)) {
        const int nt = nt_moe >= 0 ? nt_moe : moe_tables(F);
        pg8::SchedMoe S{nt, 4, F.G, (F.G % 16 == 0) ? (c + F.G / 2) % F.G : c, DM, (const void*)(F.ws + WS_WDN), DM, (size_t)1024 * 1024, false, 1,
                        (const LAS int*)(F.lds + TAB_TE), (const LAS int*)(F.lds + TAB_TP0), (const LAS int*)(F.lds + TAB_CNT), (const int*)(F.ws + WS_ROWMAP), (const unsigned*)(F.ctl + CW_DEP), 8u};
        pg8::EpiDN E{(unsigned char*)(F.ws + WS_Y), F.in[I_BDN], (LAS float*)(F.lds + TAB_OFF + 8192)};
        pg8::gemm_phase<pg8::EpiDN, pg8::SchedMoe, true, 1>(F.lds, (const char*)(F.ws + WS_ACT), DM, S, E);
    } SEAM(12);
    if (IN(13)) { if (nt_moe < 0) (void)moe_tables(F); combine_phase(F); }
#undef IN
#undef SEAM
}

static int mega_grid() {
    static int grid = 0;
    if (grid == 0) {
        int dev = 0, cus = 0;
        if (hipGetDevice(&dev) != hipSuccess || hipDeviceGetAttribute(&cus, hipDeviceAttributeMultiprocessorCount, dev) != hipSuccess) { grid = -1; return grid; }
        if (hipFuncSetAttribute((const void*)mega_fwd, hipFuncAttributeMaxDynamicSharedMemorySize, LDS_BYTES) != hipSuccess) { fprintf(stderr, "hipFuncSetAttribute failed\n"); grid = -1; return grid; }
        int per_cu = 0;
        if (hipOccupancyMaxActiveBlocksPerMultiprocessor(&per_cu, (const void*)mega_fwd, NWAVES * 64, LDS_BYTES) != hipSuccess || per_cu < 1) { fprintf(stderr, "occupancy query: %d\n", per_cu); (void)hipGetLastError(); grid = -1; return grid; }
        grid = cus;
    }
    return grid;
}
static void mega_launch(hipStream_t stream, void* const* d_in, void* d_out, void* d_ws, int lo, int hi) {
    const int grid = mega_grid(); if (grid <= 0) return;
    Args a{}; for (int i = 0; i < 29; ++i) a.in[i] = (const float*)d_in[i];
    a.out = (float*)d_out; a.ws = (unsigned char*)d_ws; a.ph_lo = lo; a.ph_hi = hi;
    hipLaunchKernelGGL(mega_fwd, dim3(grid), dim3(NWAVES * 64), LDS_BYTES, stream, a);
}
#ifndef HYB
#define HYB 6
#endif
#ifndef MK_ONE_LAUNCH
#define MK_ONE_LAUNCH 0
#endif
extern "C" void kernel_launch(void* const* d_in, const int* in_sizes, int n_in, void* d_out, int out_size, void* d_ws, size_t ws_size, hipStream_t stream) {
    if (n_in != 29 || ws_size < ((size_t)1000 << 20) || out_size != M_TOK * DM) { fprintf(stderr, "kernel_launch: unexpected n_in %d / ws %zu / out %d\n", n_in, ws_size, out_size); return; }
    if (hipMemsetAsync((char*)d_ws + WS_CTL, 0, CTL_ZERO_BYTES, stream) != hipSuccess) return;
    constexpr int nph = HYB == 1 ? 2 : HYB == 2 ? 5 : HYB == 3 ? 6 : HYB == 4 ? 7 : HYB == 5 ? 10 : 14;
#if MK_ONE_LAUNCH
    mega_launch(stream, d_in, d_out, d_ws, 0, nph);
#else
    for (int p = 0; p < nph; ++p) { if (p == 8) continue;
        mega_launch(stream, d_in, d_out, d_ws, p, p + 1);
#ifdef MK_REPEAT
        if (p == MK_REPEAT) { if (p == 10) (void)hipMemsetAsync((char*)d_ws + WS_CTL + CW_CNT * 4, 0, 32 * 64 * 4, stream); mega_launch(stream, d_in, d_out, d_ws, p, p + 1); }
#endif
    }
#endif
#if HYB < 6
    nv::In in; const float** ip = (const float**)&in; for (int i = 0; i < 29; ++i) ip[i] = (const float*)d_in[i];
    unsigned char* ws = (unsigned char*)d_ws; float* nb = (float*)(ws + WS_NAIVE);
    for (int b = 0; b < 8; ++b) {
        const size_t r0 = (size_t)b * 2048;
        auto cvt = [&](const unsigned short* src, int sp, float* dst, int dp, int cols) { hipLaunchKernelGGL(nv::k_bf16_to_f32, dim3((2048 * cols + 255) / 256), dim3(256), 0, stream, src, sp, dst, dp, 2048, cols); };
        auto cpy = [&](const float* src, int sp, float* dst, int dp, int cols) { hipLaunchKernelGGL(nv::k_copy_f32, dim3((2048 * cols + 255) / 256), dim3(256), 0, stream, src, sp, dst, dp, 2048, cols); };
        const unsigned short* P1 = (const unsigned short*)(ws + WS_P1) + r0 * P1C;
#if HYB == 1
        cvt(P1, P1C, nb + nv::B_PROJ, 6432, 6400); cpy((const float*)(ws + WS_DT) + r0 * 32, 32, nb + nv::B_PROJ + 6400, 6432, 32); cvt(P1 + C_G, P1C, nb + nv::B_GATES, 2048, 2048);
#elif HYB == 2
        cvt((const unsigned short*)(ws + WS_ACAT) + r0 * 3072, 3072, nb + nv::B_U, 1024, 1024); hipLaunchKernelGGL(nv::k_ssm_unnorm_to_f32, dim3(2048 * 2048 / 256), dim3(256), 0, stream, (const unsigned short*)(ws + WS_ACAT) + r0 * 3072, (const float*)(ws + WS_SSQG) + r0 * 4, nb + nv::B_Y, 2048); cvt(P1 + C_G, P1C, nb + nv::B_GATES, 2048, 2048);
#elif HYB == 3
        cvt((const unsigned short*)(ws + WS_MERGED) + r0 * 1024, 1024, nb + nv::B_T1, 1024, 1024);
#elif HYB == 4
        cvt((const unsigned short*)(ws + WS_H1) + r0 * 1024, 1024, nb + nv::B_H1, 1024, 1024);
#elif HYB == 5
        cvt((const unsigned short*)(ws + WS_H2) + r0 * 1024, 1024, nb + nv::B_H2, 1024, 1024);
#endif
        nv::forward_batch(stream, in, nb, b, (float*)d_out, HYB);
    }
#endif
}
```
